# Optimizing an MI355X kernel written in HIP

```python
import jax, jax.numpy as jnp
from jax import lax
import numpy as np

D_MODEL = 1024
BATCH = 2
SEQ = 8192
DEPTH = 4

D_MIX = 2 * D_MODEL
SSD_HEADS = 16
SSD_INNER = D_MIX // 2
SSD_HEAD_DIM = SSD_INNER // SSD_HEADS
SSD_GROUPS = 2
SSD_STATE = 128
SSD_XBC = SSD_INNER + 2 * SSD_GROUPS * SSD_STATE
SSD_CHUNK = 128
HG_HEADS = 4
HG_WIDTH = D_MIX // 4
HG_DK = HG_WIDTH // HG_HEADS
HG_CHUNK = 64
ML_HEADS = 4
ML_WIDTH = D_MIX // 4
ML_DH = ML_WIDTH // ML_HEADS
ML_CHUNK = 64
CONV_WIDTH = 5
D_FF_DENSE = 256 * ((8 * D_MODEL // 3 + 255) // 256)
N_EXPERTS = 8
TOP_K = 2
D_FF_EXPERT = 7 * D_MODEL // 2
MOE_BLOCK = 256
LN_EPS = 1e-5
RMS_EPS = 1e-6
MASK_NEG = -1e4
PROJ_SIZES = (SSD_INNER, SSD_XBC, 2 * SSD_HEADS,
              HG_WIDTH, 2 * HG_WIDTH, HG_WIDTH, HG_WIDTH,
              2 * ML_WIDTH, ML_WIDTH, ML_WIDTH, 2 * ML_HEADS, 2 * ML_HEADS)
D_PROJ = sum(PROJ_SIZES)

kernel_name = "bidir_hybrid_ssd_hgrn2_mlstm_moe"


def _split_points():
    pts, acc = [], 0
    for s in PROJ_SIZES[:-1]:
        acc += s
        pts.append(acc)
    return pts


def _flip(t):
    return jnp.flip(t, axis=1)


def layer_norm(x, g, b):
    xf = x.astype(jnp.float32)
    mu = jnp.mean(xf, -1, keepdims=True)
    xc = xf - mu
    var = jnp.mean(jnp.square(xc), -1, keepdims=True)
    return (xc * lax.rsqrt(var + LN_EPS) * g.astype(jnp.float32) + b.astype(jnp.float32)).astype(x.dtype)


def group_rms_norm(x, w, n_groups):
    shp = x.shape
    xg = x.reshape(shp[:-1] + (n_groups, shp[-1] // n_groups))
    xg = xg * lax.rsqrt(jnp.mean(jnp.square(xg), -1, keepdims=True) + RMS_EPS)
    return xg.reshape(shp) * w


def group_layer_norm(x, w, n_groups):
    shp = x.shape
    xg = x.reshape(shp[:-1] + (n_groups, shp[-1] // n_groups))
    xc = xg - jnp.mean(xg, -1, keepdims=True)
    xg = xc * lax.rsqrt(jnp.mean(jnp.square(xc), -1, keepdims=True) + LN_EPS)
    return xg.reshape(shp) * w


def centred_depthwise_conv(x, w, b):
    pad = w.shape[0] // 2
    y = lax.conv_general_dilated(x, w[:, None, :], window_strides=(1,), padding=[(pad, pad)],
                                 dimension_numbers=('NWC', 'WIO', 'NWC'),
                                 feature_group_count=x.shape[-1])
    return y + b


def ssd_scan(xh, dt, A, Bm, Cm):
    b, L, H, P = xh.shape
    G, N = Bm.shape[-2:]
    R = H // G
    nc = L // SSD_CHUNK
    X = (xh * dt[..., None]).reshape(b, nc, SSD_CHUNK, G, R, P)
    a = (dt * A).reshape(b, nc, SSD_CHUNK, G, R)
    Bc = Bm.reshape(b, nc, SSD_CHUNK, G, N)
    Cc = Cm.reshape(b, nc, SSD_CHUNK, G, N)
    a_cs = jnp.cumsum(a, axis=2)
    acs_t = jnp.moveaxis(a_cs, 2, -1)
    seg = acs_t[..., :, None] - acs_t[..., None, :]
    tri = jnp.tril(jnp.ones((SSD_CHUNK, SSD_CHUNK), bool))
    decay = jnp.exp(jnp.where(tri, seg, MASK_NEG))
    cb = jnp.einsum('bclgn,bcsgn->bcgls', Cc, Bc)
    y_diag = jnp.einsum('bcgrls,bcsgrp->bclgrp', cb[:, :, :, None] * decay, X)
    x_to_end = X * jnp.exp(a_cs[:, :, -1:] - a_cs)[..., None]
    chunk_states = jnp.einsum('bclgn,bclgrp->bcgrpn', Bc, x_to_end)
    chunk_decay = jnp.exp(a_cs[:, :, -1])

    def step(state, inp):
        st, dec = inp
        return state * dec[..., None, None] + st, state

    init = jnp.zeros((b, G, R, P, N), X.dtype)
    _, prev = lax.scan(step, init, (jnp.moveaxis(chunk_states, 1, 0), jnp.moveaxis(chunk_decay, 1, 0)))
    prev = jnp.moveaxis(prev, 0, 1)
    y_off = jnp.einsum('bclgn,bcgrpn->bclgrp', Cc, prev) * jnp.exp(a_cs)[..., None]
    return (y_diag + y_off).reshape(b, L, H, P)


def ssd_mixer(z, xbc, dt_raw, conv_w, conv_b, dt_bias, a_log, d_skip, norm_w):
    xbc = jax.nn.silu(centred_depthwise_conv(xbc, conv_w, conv_b))
    xs, Bm, Cm = jnp.split(xbc, [SSD_INNER, SSD_INNER + SSD_GROUPS * SSD_STATE], axis=-1)
    b, L, _ = xs.shape
    xh = xs.reshape(b, L, SSD_HEADS, SSD_HEAD_DIM)
    Bm = Bm.reshape(b, L, SSD_GROUPS, SSD_STATE)
    Cm = Cm.reshape(b, L, SSD_GROUPS, SSD_STATE)
    dt = jax.nn.softplus(dt_raw.reshape(b, L, 2, SSD_HEADS) + dt_bias)
    A = -jnp.exp(a_log)
    y_f = ssd_scan(xh, dt[:, :, 0], A[0], Bm, Cm)
    y_b = _flip(ssd_scan(_flip(xh), _flip(dt[:, :, 1]), A[1], _flip(Bm), _flip(Cm)))
    y = (y_f + y_b + xh * d_skip[:, None]).reshape(b, L, SSD_INNER)
    return group_rms_norm(y * jax.nn.silu(z), norm_w, SSD_GROUPS)


def hgrn2_scan(q, k, v, g):
    b, L, H, K = q.shape
    V = v.shape[-1]
    nc = L // HG_CHUNK

    def to_chunks(t):
        return t.reshape(b, nc, HG_CHUNK, H, t.shape[-1]).transpose(1, 0, 3, 2, 4)

    tri = jnp.tril(jnp.ones((HG_CHUNK, HG_CHUNK), bool))

    def step(S, inp):
        qc, kc, vc, gc = inp
        G = jnp.cumsum(gc, axis=2)
        rel = G[:, :, :, None, :] - G[:, :, None, :, :]
        rel = jnp.exp(jnp.where(tri[:, :, None], rel, MASK_NEG))
        att = jnp.einsum('bhtk,bhsk,bhtsk->bhts', qc, kc, rel)
        o = jnp.einsum('bhts,bhsv->bhtv', att, vc) + jnp.einsum('bhtk,bhkv->bhtv', qc * jnp.exp(G), S)
        G_last = G[:, :, -1:]
        S = S * jnp.exp(G_last[:, :, 0])[..., None] + jnp.einsum('bhsk,bhsv->bhkv', kc * jnp.exp(G_last - G), vc)
        return S, o

    S0 = jnp.zeros((b, H, K, V), q.dtype)
    _, o = lax.scan(step, S0, (to_chunks(q), to_chunks(k), to_chunks(v), to_chunks(g)))
    return o.transpose(1, 0, 3, 2, 4).reshape(b, L, H, V)


def hgrn2_mixer(q, f_raw, i, g_out, lb, norm_w):
    b, L, _ = q.shape
    qh = jax.nn.silu(q).reshape(b, L, HG_HEADS, HG_DK)
    vh = i.reshape(b, L, HG_HEADS, HG_DK)
    lbh = lb.reshape(HG_HEADS, HG_DK)
    fr = f_raw.reshape(b, L, 2, HG_HEADS, HG_DK)

    def gates(f):
        key = (1.0 - lbh) * jax.nn.sigmoid(-f)
        log_f = jnp.log1p(-key)
        return key, log_f

    k_f, g_f = gates(fr[:, :, 0])
    k_b, g_b = gates(fr[:, :, 1])
    o_f = hgrn2_scan(qh, k_f, vh, g_f)
    o_b = _flip(hgrn2_scan(_flip(qh), _flip(k_b), _flip(vh), _flip(g_b)))
    o = (o_f + o_b).reshape(b, L, HG_WIDTH)
    return group_rms_norm(o, norm_w, HG_HEADS) * jax.nn.silu(g_out)


def mlstm_scan(q, k, v, log_i, log_f):
    b, L, H, D = q.shape
    nc = L // ML_CHUNK

    def to_chunks(t):
        return t.reshape(b, nc, ML_CHUNK, H, D).transpose(1, 0, 3, 2, 4)

    def gate_chunks(t):
        return t.reshape(b, nc, ML_CHUNK, H).transpose(1, 0, 3, 2)

    tri = jnp.tril(jnp.ones((ML_CHUNK, ML_CHUNK), bool))

    def step(carry, inp):
        C, n, m = carry
        qc, kc, vc, ic, fc = inp
        bcum = jnp.cumsum(fc, axis=-1)
        dmat = jnp.where(tri, bcum[..., :, None] - bcum[..., None, :] + ic[..., None, :], MASK_NEG)
        a_inter = bcum + m[..., None]
        m_t = jnp.maximum(jnp.max(dmat, -1), a_inter)
        w_intra = jnp.exp(jnp.where(tri, dmat - m_t[..., None], MASK_NEG))
        w_inter = jnp.exp(a_inter - m_t)
        s = jnp.einsum('bhtd,bhsd->bhts', qc, kc) * w_intra
        num = jnp.einsum('bhts,bhsd->bhtd', s, vc) + w_inter[..., None] * jnp.einsum('bhtk,bhkv->bhtv', qc, C)
        den = jnp.sum(s, -1) + w_inter * jnp.einsum('bhtk,bhk->bht', qc, n)
        h = num / jnp.maximum(jnp.abs(den), jnp.exp(-m_t))[..., None]
        b_last = bcum[..., -1]
        log_w = b_last[..., None] - bcum + ic
        m_new = jnp.maximum(b_last + m, jnp.max(log_w, -1))
        w_s = jnp.exp(log_w - m_new[..., None])
        dec = jnp.exp(b_last + m - m_new)
        C = dec[..., None, None] * C + jnp.einsum('bhsk,bhsv->bhkv', kc * w_s[..., None], vc)
        n = dec[..., None] * n + jnp.einsum('bhsk,bhs->bhk', kc, w_s)
        return (C, n, m_new), h

    init = (jnp.zeros((b, H, D, D), q.dtype), jnp.zeros((b, H, D), q.dtype), jnp.zeros((b, H), q.dtype))
    _, h = lax.scan(step, init, (to_chunks(q), to_chunks(k), to_chunks(v), gate_chunks(log_i), gate_chunks(log_f)))
    return h.transpose(1, 0, 3, 2, 4).reshape(b, L, H, D)


def mlstm_mixer(qk, v, o_raw, ig_raw, fg_raw, conv_w, conv_b, ig_bias, fg_bias, norm_w):
    b, L, _ = v.shape
    qk = jax.nn.silu(centred_depthwise_conv(qk, conv_w, conv_b))
    q, k = jnp.split(qk, 2, axis=-1)
    qh = q.reshape(b, L, ML_HEADS, ML_DH) * (ML_DH ** -0.5)
    kh = k.reshape(b, L, ML_HEADS, ML_DH)
    vh = v.reshape(b, L, ML_HEADS, ML_DH)
    log_i = ig_raw.reshape(b, L, 2, ML_HEADS) + ig_bias
    log_f = jax.nn.log_sigmoid(fg_raw.reshape(b, L, 2, ML_HEADS) + fg_bias)
    h_f = mlstm_scan(qh, kh, vh, log_i[:, :, 0], log_f[:, :, 0])
    h_b = _flip(mlstm_scan(_flip(qh), _flip(kh), _flip(vh), _flip(log_i[:, :, 1]), _flip(log_f[:, :, 1])))
    h = (h_f + h_b).reshape(b, L, ML_WIDTH)
    return group_layer_norm(h, norm_w, ML_HEADS) * jax.nn.sigmoid(o_raw)


def swiglu(x, w1, w3, w2):
    return jnp.dot(jax.nn.silu(jnp.dot(x, w1)) * jnp.dot(x, w3), w2)


def moe_swiglu(x, router_w, w1, w3, w2):
    b, L, D = x.shape
    T = b * L
    xf = x.reshape(T, D)
    logits = jnp.dot(xf, router_w).astype(jnp.float32)
    top_vals, top_idx = lax.top_k(logits, TOP_K)
    gates = jax.nn.softmax(top_vals, axis=-1).astype(x.dtype)
    expert_ids = top_idx.reshape(-1).astype(jnp.int32)
    token_ids = jnp.repeat(jnp.arange(T, dtype=jnp.int32), TOP_K)
    flat_gates = gates.reshape(-1)
    order = jnp.argsort(expert_ids)
    sorted_e = expert_ids[order]
    counts = jnp.zeros((N_EXPERTS,), jnp.int32).at[expert_ids].add(1)
    padded = (counts + MOE_BLOCK - 1) // MOE_BLOCK * MOE_BLOCK
    start = jnp.cumsum(counts) - counts
    ends = jnp.cumsum(padded)
    pstart = ends - padded
    rank = jnp.arange(T * TOP_K, dtype=jnp.int32) - start[sorted_e]
    dest = pstart[sorted_e] + rank
    n_blocks = -(-(T * TOP_K) // MOE_BLOCK) + N_EXPERTS
    n_rows = n_blocks * MOE_BLOCK
    row_token = jnp.zeros((n_rows,), jnp.int32).at[dest].set(token_ids[order])
    row_gate = jnp.zeros((n_rows,), x.dtype).at[dest].set(flat_gates[order])
    block_start = jnp.arange(n_blocks, dtype=jnp.int32) * MOE_BLOCK
    block_expert = jnp.minimum(jnp.searchsorted(ends, block_start, side='right'), N_EXPERTS - 1)
    xs = xf[row_token].reshape(n_blocks, MOE_BLOCK, D)

    def expert_block(args):
        xb, e = args
        return jnp.dot(jax.nn.silu(jnp.dot(xb, w1[e])) * jnp.dot(xb, w3[e]), w2[e])

    ys = lax.map(expert_block, (xs, block_expert)).reshape(n_rows, D)
    out = jnp.zeros((T, D), x.dtype).at[row_token].add(ys * row_gate[:, None])
    return out.reshape(b, L, D)


def setup_inputs(seed: int = 0) -> dict:
    key = jax.random.key(seed)
    ks = jax.random.split(key, 40)
    f32 = jnp.float32
    nrm = lambda k, shape, scale: jax.random.normal(k, shape, f32) * scale
    beta = (8.0 * DEPTH) ** -0.25
    n_dense = (DEPTH + 1) // 2
    n_moe = DEPTH // 2
    dt0 = jnp.exp(jax.random.uniform(ks[6], (DEPTH, 2, SSD_HEADS), f32, np.log(1e-3), np.log(1e-1)))
    fg_base = jnp.linspace(3.0, 6.0, ML_HEADS, dtype=f32)
    return {
        'x': nrm(ks[0], (BATCH, SEQ, D_MODEL), 1.0),
        'ln_in_g': 1.0 + nrm(ks[1], (D_MODEL,), 0.02),
        'ln_in_b': nrm(ks[2], (D_MODEL,), 0.02),
        'w_in': nrm(ks[3], (DEPTH, D_MODEL, D_PROJ), D_MODEL ** -0.5),
        'ssd_conv_w': nrm(ks[4], (DEPTH, CONV_WIDTH, SSD_XBC), CONV_WIDTH ** -0.5),
        'ssd_conv_b': nrm(ks[5], (DEPTH, SSD_XBC), 0.02),
        'ssd_dt_bias': dt0 + jnp.log(-jnp.expm1(-dt0)),
        'ssd_a_log': jnp.log(jax.random.uniform(ks[7], (DEPTH, 2, SSD_HEADS), f32, 1.0, 16.0)),
        'ssd_d': 1.0 + nrm(ks[8], (DEPTH, SSD_HEADS), 0.1),
        'ssd_norm_w': 1.0 + nrm(ks[9], (DEPTH, SSD_INNER), 0.02),
        'hg_lb_logits': nrm(ks[10], (DEPTH, HG_WIDTH), 0.1),
        'hg_norm_w': 1.0 + nrm(ks[11], (DEPTH, HG_WIDTH), 0.02),
        'ml_conv_w': nrm(ks[12], (DEPTH, CONV_WIDTH, 2 * ML_WIDTH), CONV_WIDTH ** -0.5),
        'ml_conv_b': nrm(ks[13], (DEPTH, 2 * ML_WIDTH), 0.02),
        'ml_ig_bias': nrm(ks[14], (DEPTH, 2, ML_HEADS), 0.1),
        'ml_fg_bias': fg_base + nrm(ks[15], (DEPTH, 2, ML_HEADS), 0.1),
        'ml_norm_w': 1.0 + nrm(ks[16], (DEPTH, ML_WIDTH), 0.02),
        'w_out': nrm(ks[17], (DEPTH, D_MIX, D_MODEL), D_MIX ** -0.5 * beta),
        'ln1_g': 1.0 + nrm(ks[18], (DEPTH, D_MODEL), 0.02),
        'ln1_b': nrm(ks[19], (DEPTH, D_MODEL), 0.02),
        'ln2_g': 1.0 + nrm(ks[20], (DEPTH, D_MODEL), 0.02),
        'ln2_b': nrm(ks[21], (DEPTH, D_MODEL), 0.02),
        'ffn_w1': nrm(ks[22], (n_dense, D_MODEL, D_FF_DENSE), D_MODEL ** -0.5),
        'ffn_w3': nrm(ks[23], (n_dense, D_MODEL, D_FF_DENSE), D_MODEL ** -0.5),
        'ffn_w2': nrm(ks[24], (n_dense, D_FF_DENSE, D_MODEL), D_FF_DENSE ** -0.5 * beta),
        'moe_router': nrm(ks[25], (n_moe, D_MODEL, N_EXPERTS), D_MODEL ** -0.5),
        'moe_w1': nrm(ks[26], (n_moe, N_EXPERTS, D_MODEL, D_FF_EXPERT), D_MODEL ** -0.5),
        'moe_w3': nrm(ks[27], (n_moe, N_EXPERTS, D_MODEL, D_FF_EXPERT), D_MODEL ** -0.5),
        'moe_w2': nrm(ks[28], (n_moe, N_EXPERTS, D_FF_EXPERT, D_MODEL), D_FF_EXPERT ** -0.5 * beta),
    }


def reference(x, ln_in_g, ln_in_b, w_in, ssd_conv_w, ssd_conv_b, ssd_dt_bias, ssd_a_log, ssd_d,
              ssd_norm_w, hg_lb_logits, hg_norm_w, ml_conv_w, ml_conv_b, ml_ig_bias, ml_fg_bias,
              ml_norm_w, w_out, ln1_g, ln1_b, ln2_g, ln2_b, ffn_w1, ffn_w3, ffn_w2,
              moe_router, moe_w1, moe_w3, moe_w2):
    f32 = lambda t: t.astype(jnp.float32)
    alpha = (2.0 * DEPTH) ** 0.25
    lb_soft = jax.nn.softmax(f32(hg_lb_logits), axis=0)
    lb_all = jnp.cumsum(lb_soft, axis=0) - lb_soft[0]
    pts = _split_points()
    h = layer_norm(x, ln_in_g, ln_in_b)
    for l in range(DEPTH):
        proj = f32(jnp.dot(h, w_in[l]))
        (z, xbc, dt_raw, hq, hf, hi, hg, mqk, mv, mo, mig, mfg) = jnp.split(proj, pts, axis=-1)
        y_ssd = ssd_mixer(z, xbc, dt_raw, f32(ssd_conv_w[l]), f32(ssd_conv_b[l]), f32(ssd_dt_bias[l]),
                          f32(ssd_a_log[l]), f32(ssd_d[l]), f32(ssd_norm_w[l]))
        y_hg = hgrn2_mixer(hq, hf, hi, hg, lb_all[l], f32(hg_norm_w[l]))
        y_ml = mlstm_mixer(mqk, mv, mo, mig, mfg, f32(ml_conv_w[l]), f32(ml_conv_b[l]),
                           f32(ml_ig_bias[l]), f32(ml_fg_bias[l]), f32(ml_norm_w[l]))
        mix = jnp.concatenate([y_ssd, y_hg, y_ml], axis=-1).astype(h.dtype)
        h = layer_norm(alpha * h + jnp.dot(mix, w_out[l]), ln1_g[l], ln1_b[l])
        if l % 2 == 0:
            f = swiglu(h, ffn_w1[l // 2], ffn_w3[l // 2], ffn_w2[l // 2])
        else:
            f = moe_swiglu(h, moe_router[l // 2], moe_w1[l // 2], moe_w3[l // 2], moe_w2[l // 2])
        h = layer_norm(alpha * h + f, ln2_g[l], ln2_b[l])
    return h
```

```cpp
#include <hip/hip_runtime.h>
#include <cstdio>
#include <cstdint>

#ifndef MK_ONE_LAUNCH
#define MK_ONE_LAUNCH 1
#endif

#define LAS __attribute__((address_space(3)))
#define GAS __attribute__((address_space(1)))
typedef unsigned short bf16;
typedef short bf16x8 __attribute__((ext_vector_type(8)));
typedef float f32x4 __attribute__((ext_vector_type(4)));
typedef float f32x2 __attribute__((ext_vector_type(2)));
typedef unsigned u32x4 __attribute__((ext_vector_type(4)));
typedef unsigned u32x2 __attribute__((ext_vector_type(2)));

constexpr int T = 16384, SEQ = 8192, D = 1024, DEPTH = 4, DPROJ = 7216, NMAIN = 7168, DMIX = 2048;
constexpr int DFF_D = 2816, DFF_E = 3584, NEXP = 8, NGATE = 48;
constexpr int NWAVES = 8, NTHR = 512;
constexpr float ALPHA = 1.681792830507429f;
constexpr float LN_EPS = 1e-5f, RMS_EPS = 1e-6f;
constexpr int MOE_ROWS = 34816;

constexpr size_t MiB = 1u << 20;
constexpr size_t WS_CTL = 0, CTL_ZERO_BYTES = 1 * MiB;
constexpr size_t WS_HF32 = 1 * MiB, WS_HBF = 65 * MiB, WS_GATES = 97 * MiB, WS_ROUTE = 100 * MiB;
constexpr size_t WS_WIN = 101 * MiB, WS_WOUT = 115 * MiB, WS_W13 = 119 * MiB, WS_W2 = 231 * MiB, WS_BIG = 287 * MiB;
constexpr size_t B_Z = WS_BIG + 0 * MiB, B_XBCR = WS_BIG + 32 * MiB, B_HQ = WS_BIG + 80 * MiB, B_HFR = WS_BIG + 96 * MiB, B_HI = WS_BIG + 128 * MiB, B_HG = WS_BIG + 144 * MiB;
constexpr size_t B_MQKR = WS_BIG + 160 * MiB, B_MV = WS_BIG + 192 * MiB, B_MO = WS_BIG + 208 * MiB;
constexpr size_t B_XBCC = WS_BIG + 224 * MiB, B_MQKC = WS_BIG + 272 * MiB;
constexpr size_t B_YBUF = WS_BIG + 304 * MiB, B_OBUF = WS_BIG + 368 * MiB, B_HBUF = WS_BIG + 400 * MiB;
constexpr size_t B_MIX = WS_BIG + 464 * MiB;
constexpr size_t B_Y = WS_BIG + 0 * MiB;
constexpr size_t B_XS = WS_BIG + 64 * MiB, B_HID = WS_BIG + 136 * MiB, B_YE = WS_BIG + 376 * MiB;
constexpr size_t WS_END = WS_BIG + 528 * MiB;
constexpr int CW_TMO = 0, CW_BAR = 4096, CW_CNT = 8192;

#define LDS_WAIT() asm volatile("s_waitcnt lgkmcnt(0)" ::: "memory")
#define VM_WAIT() asm volatile("s_waitcnt vmcnt(0)" ::: "memory")
__device__ __forceinline__ unsigned f2bf(float f) { unsigned u = __builtin_bit_cast(unsigned, f); return (u + 0x7fffu + ((u >> 16) & 1u)) >> 16; }
__device__ __forceinline__ unsigned pk2(float lo, float hi) { return f2bf(lo) | (f2bf(hi) << 16); }
__device__ __forceinline__ float bf2f(unsigned short b) { return __builtin_bit_cast(float, ((unsigned)b) << 16); }
__device__ __forceinline__ float bflo(unsigned w) { return __builtin_bit_cast(float, w << 16); }
__device__ __forceinline__ float bfhi(unsigned w) { return __builtin_bit_cast(float, w & 0xffff0000u); }
__device__ __forceinline__ float sigmoidf_(float x) { return 1.0f / (1.0f + __expf(-x)); }
__device__ __forceinline__ float siluf_(float x) { return x / (1.0f + __expf(-x)); }
__device__ __forceinline__ float softplusf_(float x) { return fmaxf(x, 0.f) + log1pf(__expf(-fabsf(x))); }
__device__ __forceinline__ float wave_sum(float v) {
#pragma unroll
    for (int o = 1; o < 64; o <<= 1) v += __shfl_xor(v, o);
    return v;
}

namespace pg8 {
#define PG8_LAS __attribute__((address_space(3)))
typedef unsigned short bf16_t;
constexpr int BM = 256, BK = 64, HALF = 128, HTB = HALF * BK * 2, STAGE_BYTES = 8 * HTB, NXCD = 8, WGM = 8;
__host__ __device__ __forceinline__ int lds_byte(int r, int c) { const int st = (r >> 4) * 2 + (c >> 5), rr = r & 15, cc = c & 31, ob = rr * 64 + cc * 2; return st * 1024 + (ob ^ (((ob >> 9) & 1) << 5)); }
__host__ __device__ __forceinline__ void stage_rc(int b, int& R, int& C) { const int st = b / 1024, sb = b % 1024, swz = sb ^ (((sb >> 9) & 1) << 5); R = (st >> 1) * 16 + swz / 64; C = (st & 1) * 32 + (swz % 64) / 2; }
__host__ __device__ __forceinline__ int perm32(int rho) { const int n = rho >> 4, i = rho & 15; return 8 * (i >> 2) + 4 * n + (i & 3); }

struct Unit { const char* A; const char* B; int pm, pn; };

struct GOrder {
    const char* A; const char* Bt; int K; int nM, nN, nwg, G, c; size_t bexp; const PG8_LAS int* cum;
    __device__ void init(const void* A_, const void* Bt_, int K_, int nM_, int nN_, int G_, int c_, size_t bexp_, const PG8_LAS int* cum_) { A = (const char*)A_; Bt = (const char*)Bt_; K = K_; nM = nM_; nN = nN_; nwg = nM * nN; G = G_; c = c_; bexp = bexp_; cum = cum_; }
    __device__ bool next(int i, Unit& u) const {
        const long L = (long)i * G + c; if (L >= nwg) return false;
        int wgid = (int)L; { const int q = nwg / NXCD, r = nwg % NXCD, xcd = wgid % NXCD, off = wgid / NXCD; wgid = (xcd < r ? xcd * (q + 1) : r * (q + 1) + (xcd - r) * q) + off; }
        const int nig = WGM * nN, gid = wgid / nig, fm = gid * WGM, gsz = (nM - fm) < WGM ? (nM - fm) : WGM;
        u.pm = fm + ((wgid % nig) % gsz); u.pn = (wgid % nig) / gsz;
        int e = 0; if (cum) { for (int j = 0; j < 8; ++j) e += (cum[j] <= u.pm) ? 1 : 0; if (e > 7) e = 7; }
        u.A = A + (size_t)u.pm * 256 * K * 2; u.B = Bt + (size_t)e * bexp + (size_t)u.pn * 256 * K * 2; return true;
    }
};
__device__ __forceinline__ unsigned cvt_pk_bf16(float lo, float hi) { unsigned r; asm volatile("v_cvt_pk_bf16_f32 %0, %1, %2" : "=v"(r) : "v"(lo), "v"(hi)); return r; }

struct EpiF32 {
    static constexpr bool PERM = false;
    float* C; int ldc;
    __device__ __forceinline__ void operator()(const f32x4 (&acc)[2][2][4][2], const Unit& u, int wr, int wc, int fr, int fq) const {
        const int row0 = u.pm * BM + wr * 64 + fr, col0 = u.pn * BM + wc * 32 + 4 * fq;
#pragma unroll
        for (int ai = 0; ai < 2; ++ai)
#pragma unroll
            for (int m = 0; m < 4; ++m) { float* rowp = C + (size_t)(row0 + ai * HALF + m * 16) * ldc + col0;
#pragma unroll
                for (int bj = 0; bj < 2; ++bj)
#pragma unroll
                    for (int n = 0; n < 2; ++n) *(f32x4*)(rowp + bj * HALF + n * 16) = acc[ai][bj][m][n]; }
    }
};
struct EpiProj {
    static constexpr bool PERM = true;
    unsigned char* ws;
    __device__ __forceinline__ void operator()(const f32x4 (&acc)[2][2][4][2], const Unit& u, int wr, int wc, int fr, int fq) const {
        const int pn = u.pn; size_t off; int ldc, c0;
        if (pn < 4) { off = B_Z; ldc = 1024; c0 = pn; } else if (pn < 10) { off = B_XBCR; ldc = 1536; c0 = pn - 4; } else if (pn < 12) { off = B_HQ; ldc = 512; c0 = pn - 10; }
        else if (pn < 16) { off = B_HFR; ldc = 1024; c0 = pn - 12; } else if (pn < 18) { off = B_HI; ldc = 512; c0 = pn - 16; } else if (pn < 20) { off = B_HG; ldc = 512; c0 = pn - 18; }
        else if (pn < 24) { off = B_MQKR; ldc = 1024; c0 = pn - 20; } else if (pn < 26) { off = B_MV; ldc = 512; c0 = pn - 24; } else { off = B_MO; ldc = 512; c0 = pn - 26; }
        bf16_t* base = (bf16_t*)(ws + off);
        const int row0 = u.pm * BM + wr * 64 + fr, col0 = c0 * BM + wc * 32 + 8 * fq;
#pragma unroll
        for (int ai = 0; ai < 2; ++ai)
#pragma unroll
            for (int m = 0; m < 4; ++m) { bf16_t* rowp = base + (size_t)(row0 + ai * HALF + m * 16) * ldc + col0;
#pragma unroll
                for (int bj = 0; bj < 2; ++bj) { const f32x4 v0 = acc[ai][bj][m][0], v1 = acc[ai][bj][m][1];
                    u32x4 w; w.x = cvt_pk_bf16(v0[0], v0[1]); w.y = cvt_pk_bf16(v0[2], v0[3]); w.z = cvt_pk_bf16(v1[0], v1[1]); w.w = cvt_pk_bf16(v1[2], v1[3]);
                    *(u32x4*)(rowp + bj * HALF) = w; } }
    }
};
struct EpiSwiglu {
    static constexpr bool PERM = true;
    bf16_t* O; int ldc;
    __device__ __forceinline__ void operator()(const f32x4 (&acc)[2][2][4][2], const Unit& u, int wr, int wc, int fr, int fq) const {
        const int row0 = u.pm * BM + wr * 64 + fr, col0 = u.pn * HALF + wc * 32 + 8 * fq;
#pragma unroll
        for (int ai = 0; ai < 2; ++ai)
#pragma unroll
            for (int m = 0; m < 4; ++m) { bf16_t* rowp = O + (size_t)(row0 + ai * HALF + m * 16) * ldc + col0;
                float o[8];
#pragma unroll
                for (int n = 0; n < 2; ++n)
#pragma unroll
                    for (int j = 0; j < 4; ++j) { const float a = acc[ai][0][m][n][j], b = acc[ai][1][m][n][j]; o[n * 4 + j] = a * __builtin_amdgcn_rcpf(1.0f + __expf(-a)) * b; }
                u32x4 w; w.x = cvt_pk_bf16(o[0], o[1]); w.y = cvt_pk_bf16(o[2], o[3]); w.z = cvt_pk_bf16(o[4], o[5]); w.w = cvt_pk_bf16(o[6], o[7]);
                *(u32x4*)rowp = w; }
    }
};

template <class Epi, class Sched, bool ALIGN_EPI = true>
__device__ __forceinline__ void gemm_phase(PG8_LAS unsigned char* lds, const int K, const Sched& S, const Epi& E, const int tid) {
    const int wid = __builtin_amdgcn_readfirstlane(tid >> 6), lane = tid & 63, wr = wid >> 2, wc = wid & 3, fr = lane & 15, fq = lane >> 4;
    const int nt = K / BK;
    unsigned voffA[2], voffB[2];
#pragma unroll
    for (int i = 0; i < 2; ++i) { int R, C; stage_rc(tid * 16 + i * 8192, R, C); const int Rb = Epi::PERM ? ((R & ~31) + perm32(R & 31)) : R;
        voffA[i] = (unsigned)(R * K + C) * 2u; voffB[i] = (unsigned)(Rb * K + C) * 2u; }
    const size_t kstep = (size_t)(BK * 2);
    const size_t hstep = (size_t)HALF * K * 2;
    const unsigned ldsw = (unsigned)wid * 1024u;
    const int aoff = lds_byte(wr * 64 + fr, fq * 8), boff = lds_byte(wc * 32 + fr, fq * 8);
#define PG8_SA(b, h) (((b) * 2 + (h)) * HTB)
#define PG8_SB(b, h) ((4 + (b) * 2 + (h)) * HTB)
#define PG8_STAGE(bufoff, gbase, voff) do { _Pragma("unroll") for (int _i = 0; _i < 2; ++_i) \
        __builtin_amdgcn_global_load_lds((const unsigned*)((const char*)(gbase) + (voff)[_i]), (PG8_LAS unsigned*)(lds + (bufoff) + ldsw + _i * 8192), 16, 0, 0); } while (0)
#define PG8_LDA(dst, b, h) do { _Pragma("unroll") for (int m = 0; m < 4; ++m) _Pragma("unroll") for (int k = 0; k < 2; ++k) dst[m][k] = *(const PG8_LAS bf16x8*)(lds + PG8_SA(b, h) + aoff + m * 2048 + k * 1024); } while (0)
#define PG8_LDB(dst, b, h) do { _Pragma("unroll") for (int n = 0; n < 2; ++n) _Pragma("unroll") for (int k = 0; k < 2; ++k) dst[n][k] = *(const PG8_LAS bf16x8*)(lds + PG8_SB(b, h) + boff + n * 2048 + k * 1024); } while (0)
#define PG8_MMA(ai, bj, At, Bt) do { __builtin_amdgcn_s_setprio(1); _Pragma("unroll") for (int m = 0; m < 4; ++m) _Pragma("unroll") for (int n = 0; n < 2; ++n) _Pragma("unroll") for (int k = 0; k < 2; ++k) \
        acc[ai][bj][m][n] = __builtin_amdgcn_mfma_f32_16x16x32_bf16(Bt[n][k], At[m][k], acc[ai][bj][m][n], 0, 0, 0); __builtin_amdgcn_s_setprio(0); } while (0)
#define PG8_WAIT_V(n) asm volatile("s_waitcnt vmcnt(" #n ")" ::: "memory")
#define PG8_WAIT_L(n) asm volatile("s_waitcnt lgkmcnt(" #n ")" ::: "memory")
#define PG8_BAR __builtin_amdgcn_s_barrier()
#define PG8_SCHED __builtin_amdgcn_sched_barrier(0)
    Unit cur, nxt; int ui = 0;
    if (!S.next(0, cur)) return;
    f32x4 acc[2][2][4][2];
#pragma unroll
    for (int a = 0; a < 2; ++a)
#pragma unroll
        for (int b = 0; b < 2; ++b)
#pragma unroll
            for (int m = 0; m < 4; ++m)
#pragma unroll
                for (int n = 0; n < 2; ++n) acc[a][b][m][n] = (f32x4){0.f, 0.f, 0.f, 0.f};
    bf16x8 At[4][2], B0[2][2], B1[2][2];
    const char* cA = cur.A; const char* cB = cur.B;
    PG8_STAGE(PG8_SB(0, 0), cB, voffB); PG8_STAGE(PG8_SB(0, 1), cB + hstep, voffB); PG8_STAGE(PG8_SA(0, 0), cA, voffA); PG8_STAGE(PG8_SA(0, 1), cA + hstep, voffA);
    if (wr == 1) PG8_BAR;
    PG8_WAIT_V(2); PG8_BAR;
    PG8_STAGE(PG8_SB(1, 0), cB + kstep, voffB); PG8_STAGE(PG8_SA(1, 0), cA + kstep, voffA); PG8_STAGE(PG8_SB(1, 1), cB + hstep + kstep, voffB);
    PG8_WAIT_V(6); PG8_BAR;
    for (;;) {
        const bool has_next = S.next(ui + 1, nxt);
        const char* nA = has_next ? nxt.A : cA; const char* nB = has_next ? nxt.B : cB;
        for (int t = 0; t < nt; t += 2) {
            const bool last = (t == nt - 2);
            const char* a1 = cA + (size_t)(t + 1) * kstep;
            const char* a2 = last ? nA : cA + (size_t)(t + 2) * kstep; const char* b2 = last ? nB : cB + (size_t)(t + 2) * kstep;
            const char* a3 = a2 + kstep; const char* b3 = b2 + kstep;
            PG8_LDB(B0, 0, 0); PG8_LDB(B1, 0, 1); PG8_SCHED; PG8_LDA(At, 0, 0); PG8_STAGE(PG8_SA(1, 1), a1 + hstep, voffA);
            PG8_WAIT_V(8); PG8_WAIT_L(0); PG8_BAR; PG8_MMA(0, 0, At, B0); PG8_MMA(0, 1, At, B1); PG8_BAR; PG8_SCHED;
            PG8_LDA(At, 0, 1); PG8_STAGE(PG8_SB(0, 0), b2, voffB); PG8_STAGE(PG8_SB(0, 1), b2 + hstep, voffB); PG8_STAGE(PG8_SA(0, 0), a2, voffA);
            PG8_WAIT_V(8); PG8_WAIT_L(0); PG8_BAR; PG8_MMA(1, 0, At, B0); PG8_MMA(1, 1, At, B1); PG8_BAR; PG8_SCHED;
            PG8_LDB(B0, 1, 0); PG8_LDB(B1, 1, 1); PG8_SCHED; PG8_LDA(At, 1, 0); PG8_STAGE(PG8_SA(0, 1), a2 + hstep, voffA);
            PG8_WAIT_V(8); PG8_WAIT_L(0); PG8_BAR; PG8_MMA(0, 0, At, B0); PG8_MMA(0, 1, At, B1); PG8_BAR; PG8_SCHED;
            PG8_LDA(At, 1, 1); PG8_STAGE(PG8_SB(1, 0), b3, voffB); PG8_STAGE(PG8_SB(1, 1), b3 + hstep, voffB); PG8_STAGE(PG8_SA(1, 0), a3, voffA);
            PG8_WAIT_V(8); PG8_WAIT_L(0); PG8_BAR; PG8_MMA(1, 0, At, B0); PG8_MMA(1, 1, At, B1); PG8_BAR; PG8_SCHED;
        }
        if constexpr (ALIGN_EPI) { if (wr == 0) PG8_BAR; }
        E(acc, cur, wr, wc, fr, fq);
        if (!has_next) break;
#pragma unroll
        for (int a = 0; a < 2; ++a)
#pragma unroll
            for (int b = 0; b < 2; ++b)
#pragma unroll
                for (int m = 0; m < 4; ++m)
#pragma unroll
                    for (int n = 0; n < 2; ++n) acc[a][b][m][n] = (f32x4){0.f, 0.f, 0.f, 0.f};
        cur = nxt; cA = nA; cB = nB; ++ui;
        if constexpr (ALIGN_EPI) { if (wr == 1) PG8_BAR; }
    }
    PG8_WAIT_V(0);
    if constexpr (!ALIGN_EPI) { if (wr == 0) PG8_BAR; }
    PG8_BAR;
#undef PG8_SA
#undef PG8_SB
#undef PG8_STAGE
#undef PG8_LDA
#undef PG8_LDB
#undef PG8_MMA
#undef PG8_WAIT_V
#undef PG8_WAIT_L
#undef PG8_BAR
#undef PG8_SCHED
}
}

#define XB_TMO      128
#define XB_XCNT(j)  (256  + 64 * (j))
#define XB_XSUB(j)  (1280 + 64 * (j))
#define XB_XGEN(j)  (2304 + 64 * (j))
#define XB_TOP      3328
#define XB_TOPGEN   3392
#define XCD_BAR_WORDS 3456
#define XB_SPIN_CAP (1u << 22)
__device__ __forceinline__ unsigned xb_ld(unsigned* p)              { return __hip_atomic_load(p, __ATOMIC_RELAXED, __HIP_MEMORY_SCOPE_AGENT); }
__device__ __forceinline__ unsigned xb_add(unsigned* p, unsigned v) { return __hip_atomic_fetch_add(p, v, __ATOMIC_RELAXED, __HIP_MEMORY_SCOPE_AGENT); }
__device__ __forceinline__ unsigned xb_xcc_id() { return (unsigned)__builtin_amdgcn_s_getreg((3 << 11) | 20) & 0xFu; }
#define XB_SPIN(cond, bar) do { unsigned _sp = 0; while (cond) { __builtin_amdgcn_s_sleep(1); \
    if ((++_sp & 255u) == 0u) { if (xb_ld(&(bar)[XB_TMO])) break; if (_sp > XB_SPIN_CAP) { atomicAdd(&(bar)[XB_TMO], 1u); break; } } } } while (0)
struct XcdBarrier { unsigned* bar; unsigned x; volatile LAS unsigned* st; };
__device__ __forceinline__ XcdBarrier xcd_barrier_post(unsigned* bar, volatile LAS unsigned* st) {
    XcdBarrier b; b.bar = bar; b.x = xb_xcc_id(); b.st = st;
    if (threadIdx.x == 0) (void)xb_add(&bar[XB_XCNT(b.x)], 1u);
    return b;
}
__device__ __forceinline__ void xcd_barrier_complete(unsigned* bar, unsigned x, unsigned& nloc, unsigned& nx) {
    const unsigned G = gridDim.x * gridDim.y * gridDim.z;
    unsigned sum, cnt, mine, sp = 0u;
    for (;;) {
        sum = 0u; cnt = 0u; mine = 0u;
#pragma unroll
        for (unsigned j = 0; j < 16; ++j) { const unsigned c = xb_ld(&bar[XB_XCNT(j)]); sum += c; cnt += (c > 0u) ? 1u : 0u; mine = (j == x) ? c : mine; }
        if (sum == G) break;
        __builtin_amdgcn_s_sleep(1);
        if ((++sp & 255u) == 0u) { if (xb_ld(&bar[XB_TMO])) break; if (sp > XB_SPIN_CAP) { atomicAdd(&bar[XB_TMO], 1u); break; } }
    }
    nloc = mine > 0u ? mine : 1u; nx = cnt > 0u ? cnt : 1u;
}
__device__ __forceinline__ void xcd_barrier(const XcdBarrier& b) {
    asm volatile("s_waitcnt vmcnt(0)" ::: "memory");
    __syncthreads();
    if (threadIdx.x == 0) {
        unsigned* bar = b.bar;
        __builtin_amdgcn_s_waitcnt(0);
        unsigned nloc = b.st[0], nx = b.st[1];
        if (nloc == 0u) { xcd_barrier_complete(bar, b.x, nloc, nx); b.st[0] = nloc; b.st[1] = nx; }
        const unsigned old = xb_add(&bar[XB_XSUB(b.x)], 1u);
        const unsigned gen = old / nloc;
        if (old + 1u == (gen + 1u) * nloc) {
            __builtin_amdgcn_fence(__ATOMIC_RELEASE, "agent");
            asm volatile("s_waitcnt vmcnt(0)" ::: "memory");
            const unsigned og = xb_add(&bar[XB_TOP], 1u);
            const unsigned tg = og / nx;
            if (og + 1u == (tg + 1u) * nx) xb_add(&bar[XB_TOPGEN], 1u);
            else XB_SPIN(xb_ld(&bar[XB_TOPGEN]) == tg, bar);
            __builtin_amdgcn_fence(__ATOMIC_ACQUIRE, "agent");
            xb_add(&bar[XB_XGEN(b.x)], 1u);
            asm volatile("s_waitcnt vmcnt(0)" ::: "memory");
        } else {
            XB_SPIN(xb_ld(&bar[XB_XGEN(b.x)]) == gen, bar);
            __builtin_amdgcn_fence(__ATOMIC_ACQUIRE, "agent");
            asm volatile("s_waitcnt vmcnt(0)" ::: "memory");
        }
    }
    __syncthreads();
}

constexpr int RING_BYTES = 131072;
constexpr int MISC_OFF = RING_BYTES;
constexpr int LDS_BYTES = 147456;

struct Args { const float* in[29]; float* out; unsigned char* ws; int ph_lo, ph_hi; };

constexpr int PTAB_OFF = MISC_OFF + 256;
struct InTab {
    LAS unsigned char* lds;
    __device__ __forceinline__ const float* operator[](int i) const {
        const u32x2 w = *(const LAS u32x2*)(lds + PTAB_OFF + 8 * i);
        const unsigned long long p = ((unsigned long long)(unsigned)__builtin_amdgcn_readfirstlane((int)w.y) << 32) | (unsigned)__builtin_amdgcn_readfirstlane((int)w.x);
        return (const float*)p;
    }
};
struct Ctx {
    LAS unsigned char* lds; volatile LAS unsigned* misc; unsigned char* ws; InTab in; float* out;
    int tid, lane, wave, G, blk;
};

__device__ __forceinline__ void transpose_item(const float* W, size_t ldw, int K, bf16* WT, size_t dst_row0, size_t src_col0, int kb, LAS float* scr, int lane) {
    const int k0 = 64 * kb;
#pragma unroll 8
    for (int i = 0; i < 32; ++i) { const int kk = 2 * i + (lane >> 5); scr[kk * 33 + (lane & 31)] = W[(size_t)(k0 + kk) * ldw + src_col0 + (lane & 31)]; }
    LDS_WAIT(); asm volatile("" ::: "memory");
    const int c = lane & 7;
#pragma unroll
    for (int j = 0; j < 4; ++j) { const int n = (lane >> 3) + 8 * j; const LAS float* s = scr + (8 * c) * 33 + n;
        u32x4 o; o.x = pk2(s[0 * 33], s[1 * 33]); o.y = pk2(s[2 * 33], s[3 * 33]); o.z = pk2(s[4 * 33], s[5 * 33]); o.w = pk2(s[6 * 33], s[7 * 33]);
        *(u32x4*)(WT + (dst_row0 + n) * (size_t)K + k0 + 8 * c) = o; }
    LDS_WAIT(); asm volatile("" ::: "memory");
}
__device__ __forceinline__ void wconv_layer(Ctx& C, int l) {
    LAS float* scr = (LAS float*)(C.lds + C.wave * 16384);
    const int gw = C.blk * NWAVES + C.wave, NGW = C.G * NWAVES;
    const bool moe = (l & 1) != 0; const int li = l >> 1;
    const int dff = moe ? DFF_E : DFF_D, nexp = moe ? NEXP : 1;
    const int I_A = 16 * (NMAIN / 32), I_B = 32 * 32, I_C1 = 16 * (2 * dff / 32), I_D1 = (dff / 64) * 32;
    const int NIT = I_A + I_B + nexp * (I_C1 + I_D1);
    const float* w_in = C.in[3] + (size_t)l * D * DPROJ; const float* w_out = C.in[17] + (size_t)l * DMIX * D;
    const float* w1 = moe ? C.in[26] + (size_t)li * NEXP * D * DFF_E : C.in[22] + (size_t)li * D * DFF_D;
    const float* w3 = moe ? C.in[27] + (size_t)li * NEXP * D * DFF_E : C.in[23] + (size_t)li * D * DFF_D;
    const float* w2 = moe ? C.in[28] + (size_t)li * NEXP * DFF_E * D : C.in[24] + (size_t)li * DFF_D * D;
    bf16* WinT = (bf16*)(C.ws + WS_WIN); bf16* WoutT = (bf16*)(C.ws + WS_WOUT); bf16* W13T = (bf16*)(C.ws + WS_W13); bf16* W2T = (bf16*)(C.ws + WS_W2);
    for (int it = gw; it < NIT; it += NGW) {
        int r = it;
        if (r < I_A) { const int nb = r % (NMAIN / 32), kb = r / (NMAIN / 32); const int n0 = 32 * nb; transpose_item(w_in, DPROJ, D, WinT, n0, n0 < 2560 ? n0 : n0 + 32, kb, scr, C.lane); continue; } r -= I_A;
        if (r < I_B) { const int nb = r % 32, kb = r / 32; transpose_item(w_out, D, DMIX, WoutT, 32 * nb, 32 * nb, kb, scr, C.lane); continue; } r -= I_B;
        const int per = I_C1 + I_D1, e = r / per; r -= e * per;
        if (r < I_C1) { const int nbn = 2 * dff / 32, nb = r % nbn, kb = r / nbn; const int n0 = 32 * nb, pn = n0 >> 8, within = n0 & 255, bj = within >> 7, uu = within & 127;
            transpose_item((bj ? w3 : w1) + (size_t)e * D * dff, dff, D, W13T + (size_t)e * 2 * dff * D, n0, 128 * pn + uu, kb, scr, C.lane); continue; } r -= I_C1;
        { const int nb = r % 32, kb = r / 32; transpose_item(w2 + (size_t)e * dff * D, D, dff, W2T + (size_t)e * D * dff, 32 * nb, 32 * nb, kb, scr, C.lane); }
    }
}

template <int MODE, int SK>
__device__ __forceinline__ void ln_phase(Ctx& C, const float* src, const float* gam, const float* bet, float* dst_f32, int lsk) {
    LAS float* rows = (LAS float*)(C.lds + C.wave * 16384);
    float* HF = (float*)(C.ws + WS_HF32); bf16* HB = (bf16*)(C.ws + WS_HBF);
    const float* Y = (const float*)(C.ws + B_Y); const float* YE = (const float*)(C.ws + B_YE);
    const unsigned* route = (const unsigned*)(C.ws + WS_ROUTE);
    unsigned* gcnt = (unsigned*)(C.ws + WS_CTL) + CW_CNT + 64 * (lsk >> 1);
    const int lane = C.lane;
    f32x4 gv[4], bv[4];
#pragma unroll
    for (int j = 0; j < 4; ++j) { gv[j] = *(const f32x4*)(gam + 4 * lane + 256 * j); bv[j] = *(const f32x4*)(bet + 4 * lane + 256 * j); }
    for (int it = C.blk; it < T / 32; it += C.G) {
        const int row0 = it * 32 + C.wave * 4;
        if (SK == 2) { if (C.tid < 8) C.misc[C.tid] = 0u; __syncthreads(); }
#pragma unroll
        for (int r = 0; r < 4; ++r) {
            const int row = row0 + r;
            f32x4 v[4];
            if (MODE == 0) {
#pragma unroll
                for (int j = 0; j < 4; ++j) v[j] = *(const f32x4*)(src + (size_t)row * D + 4 * lane + 256 * j);
            } else {
                float g0 = 0.f, g1 = 0.f; size_t o0 = (size_t)row * D, o1 = 0;
                if (MODE == 3) { const unsigned* rt = route + (size_t)row * 8; o0 = (size_t)rt[6] * D; o1 = (size_t)rt[7] * D; g0 = __builtin_bit_cast(float, rt[4]); g1 = __builtin_bit_cast(float, rt[5]); }
#pragma unroll
                for (int j = 0; j < 4; ++j) {
                    const f32x4 h = *(const f32x4*)(HF + (size_t)row * D + 4 * lane + 256 * j);
                    f32x4 a;
                    if (MODE == 1) a = *(const f32x4*)(Y + (size_t)row * D + 4 * lane + 256 * j);
                    else if (MODE == 2) a = *(const f32x4*)(YE + (size_t)row * D + 4 * lane + 256 * j);
                    else a = g0 * *(const f32x4*)(YE + o0 + 4 * lane + 256 * j) + g1 * *(const f32x4*)(YE + o1 + 4 * lane + 256 * j);
                    v[j] = ALPHA * h + a;
                }
            }
            float s = 0.f;
#pragma unroll
            for (int j = 0; j < 4; ++j) s += (v[j].x + v[j].y) + (v[j].z + v[j].w);
            const float mean = wave_sum(s) * (1.f / D); float s2 = 0.f;
#pragma unroll
            for (int j = 0; j < 4; ++j) { v[j] = v[j] - mean; s2 += (v[j].x * v[j].x + v[j].y * v[j].y) + (v[j].z * v[j].z + v[j].w * v[j].w); }
            const float rstd = 1.f / sqrtf(wave_sum(s2) * (1.f / D) + LN_EPS);
#pragma unroll
            for (int j = 0; j < 4; ++j) {
                const f32x4 o = v[j] * rstd * gv[j] + bv[j];
                *(f32x4*)(dst_f32 + (size_t)row * D + 4 * lane + 256 * j) = o;
                u32x2 w; w.x = pk2(o.x, o.y); w.y = pk2(o.z, o.w);
                *(u32x2*)(HB + (size_t)row * D + 4 * lane + 256 * j) = w;
                if (SK != 0) *(LAS f32x4*)(rows + r * 1024 + 4 * lane + 256 * j) = o;
            }
        }
        if (SK != 0) {
            LDS_WAIT(); asm volatile("" ::: "memory");
            const int NC = (SK == 1) ? NGATE : NEXP;
            const float* W; size_t ldw;
            if (SK == 1) { W = C.in[3] + (size_t)lsk * D * DPROJ + (lane < 32 ? 2560 + lane : 7200 + (lane - 32)); ldw = DPROJ; }
            else { W = C.in[25] + (size_t)(lsk >> 1) * D * NEXP + lane; ldw = NEXP; }
            float a0 = 0.f, a1 = 0.f, a2 = 0.f, a3 = 0.f;
            if (lane < NC) {
#pragma unroll 2
                for (int k = 0; k < D; k += 4) {
                    const float w0 = W[(size_t)(k + 0) * ldw], w1 = W[(size_t)(k + 1) * ldw], w2 = W[(size_t)(k + 2) * ldw], w3 = W[(size_t)(k + 3) * ldw];
                    const f32x4 h0 = *(const LAS f32x4*)(rows + 0 * 1024 + k), h1 = *(const LAS f32x4*)(rows + 1 * 1024 + k), h2 = *(const LAS f32x4*)(rows + 2 * 1024 + k), h3 = *(const LAS f32x4*)(rows + 3 * 1024 + k);
                    a0 += h0.x * w0 + h0.y * w1 + h0.z * w2 + h0.w * w3;
                    a1 += h1.x * w0 + h1.y * w1 + h1.z * w2 + h1.w * w3;
                    a2 += h2.x * w0 + h2.y * w1 + h2.z * w2 + h2.w * w3;
                    a3 += h3.x * w0 + h3.y * w1 + h3.z * w2 + h3.w * w3;
                }
            }
            if (SK == 1) {
                float* Gt = (float*)(C.ws + WS_GATES);
                if (lane < NGATE) { Gt[(size_t)(row0 + 0) * NGATE + lane] = a0; Gt[(size_t)(row0 + 1) * NGATE + lane] = a1; Gt[(size_t)(row0 + 2) * NGATE + lane] = a2; Gt[(size_t)(row0 + 3) * NGATE + lane] = a3; }
            } else {
                float lg[4][8];
#pragma unroll
                for (int c = 0; c < 8; ++c) { lg[0][c] = __shfl(a0, c); lg[1][c] = __shfl(a1, c); lg[2][c] = __shfl(a2, c); lg[3][c] = __shfl(a3, c); }
                float my[8];
#pragma unroll
                for (int c = 0; c < 8; ++c) my[c] = (lane == 0) ? lg[0][c] : (lane == 1) ? lg[1][c] : (lane == 2) ? lg[2][c] : lg[3][c];
                int e0 = 0; float v0 = my[0];
#pragma unroll
                for (int c = 1; c < 8; ++c) if (my[c] > v0) { v0 = my[c]; e0 = c; }
                int e1 = -1; float v1 = -3.0e38f;
#pragma unroll
                for (int c = 0; c < 8; ++c) if (c != e0 && my[c] > v1) { v1 = my[c]; e1 = c; }
                const float g0 = 1.0f / (1.0f + __expf(v1 - v0)), g1 = 1.0f - g0;
                unsigned lr0 = 0, lr1 = 0;
                if (lane < 4) { lr0 = atomicAdd((unsigned*)(C.misc + e0), 1u); lr1 = atomicAdd((unsigned*)(C.misc + e1), 1u); }
                __syncthreads();
                if (C.tid < 8) C.misc[16 + C.tid] = atomicAdd(gcnt + C.tid, (unsigned)C.misc[C.tid]);
                __syncthreads();
                if (lane < 4) { unsigned* rt = (unsigned*)(C.ws + WS_ROUTE) + (size_t)(row0 + lane) * 8;
                    rt[0] = (unsigned)e0; rt[1] = (unsigned)e1; rt[2] = C.misc[16 + e0] + lr0; rt[3] = C.misc[16 + e1] + lr1; rt[4] = __builtin_bit_cast(unsigned, g0); rt[5] = __builtin_bit_cast(unsigned, g1); }
                __syncthreads();
            }
        }
    }
}

__device__ __forceinline__ int moe_cum_table(Ctx& C, int lm, bool moe) {
    if (C.tid == 0) {
        const unsigned* gcnt = (const unsigned*)(C.ws + WS_CTL) + CW_CNT + 64 * lm; int acc = 0;
        for (int e = 0; e < 8; ++e) { const int nb = moe ? (int)((__hip_atomic_load(gcnt + e, __ATOMIC_RELAXED, __HIP_MEMORY_SCOPE_AGENT) + 255u) >> 8) : (e == 0 ? T / 256 : 0); acc += nb; C.misc[e] = (unsigned)acc; }
    }
    __syncthreads();
    return (int)C.misc[7];
}
__device__ __forceinline__ void moe_dispatch(Ctx& C, int lm) {
    moe_cum_table(C, lm, true);
    unsigned* route = (unsigned*)(C.ws + WS_ROUTE); const bf16* HB = (const bf16*)(C.ws + WS_HBF); bf16* XS = (bf16*)(C.ws + B_XS);
    const int gw = C.blk * NWAVES + C.wave, NGW = C.G * NWAVES;
    for (int t = gw; t < T; t += NGW) {
        unsigned* rt = route + (size_t)t * 8;
        const unsigned e0 = rt[0], e1 = rt[1];
        const unsigned d0 = (e0 ? C.misc[e0 - 1] : 0u) * 256u + rt[2], d1 = (e1 ? C.misc[e1 - 1] : 0u) * 256u + rt[3];
        if (C.lane == 0) { rt[6] = d0; rt[7] = d1; }
        const u32x4* s = (const u32x4*)(HB + (size_t)t * D); u32x4* p0 = (u32x4*)(XS + (size_t)d0 * D); u32x4* p1 = (u32x4*)(XS + (size_t)d1 * D);
        const u32x4 a = s[C.lane], b = s[C.lane + 64];
        p0[C.lane] = a; p0[C.lane + 64] = b; p1[C.lane] = a; p1[C.lane + 64] = b;
    }
}

__device__ __forceinline__ void conv_phase(Ctx& C, int l) {
    const bf16* XR = (const bf16*)(C.ws + B_XBCR); const bf16* QR = (const bf16*)(C.ws + B_MQKR); bf16* XC = (bf16*)(C.ws + B_XBCC); bf16* QC = (bf16*)(C.ws + B_MQKC);
    const float* cw1 = C.in[4] + (size_t)l * 5 * 1536; const float* cb1 = C.in[5] + (size_t)l * 1536;
    const float* cw2 = C.in[12] + (size_t)l * 5 * 1024; const float* cb2 = C.in[13] + (size_t)l * 1024;
    const size_t NIT = (size_t)T * 320;
    for (size_t it = (size_t)C.blk * NTHR + C.tid; it < NIT; it += (size_t)C.G * NTHR) {
        const int tok = (int)(it / 320), gi = (int)(it % 320); const int t = tok & (SEQ - 1);
        const bool second = gi >= 192; const int c0 = second ? (gi - 192) * 8 : gi * 8; const int ld = second ? 1024 : 1536;
        const bf16* src = second ? QR : XR; const float* cw = second ? cw2 : cw1; const float* cb = second ? cb2 : cb1;
        float acc[8];
#pragma unroll
        for (int j = 0; j < 8; ++j) acc[j] = cb[c0 + j];
#pragma unroll
        for (int k = 0; k < 5; ++k) {
            const int tt = t + k - 2;
            if (tt >= 0 && tt < SEQ) {
                const u32x4 x = *(const u32x4*)(src + (size_t)(tok + k - 2) * ld + c0);
                const f32x4 wa = *(const f32x4*)(cw + (size_t)k * ld + c0), wb = *(const f32x4*)(cw + (size_t)k * ld + c0 + 4);
                acc[0] += bflo(x.x) * wa.x; acc[1] += bfhi(x.x) * wa.y; acc[2] += bflo(x.y) * wa.z; acc[3] += bfhi(x.y) * wa.w;
                acc[4] += bflo(x.z) * wb.x; acc[5] += bfhi(x.z) * wb.y; acc[6] += bflo(x.w) * wb.z; acc[7] += bfhi(x.w) * wb.w;
            }
        }
        u32x4 o; o.x = pk2(siluf_(acc[0]), siluf_(acc[1])); o.y = pk2(siluf_(acc[2]), siluf_(acc[3])); o.z = pk2(siluf_(acc[4]), siluf_(acc[5])); o.w = pk2(siluf_(acc[6]), siluf_(acc[7]));
        *(u32x4*)((second ? QC : XC) + (size_t)tok * ld + c0) = o;
    }
    u32x4* z = (u32x4*)(C.ws + B_YBUF); const size_t NZ = (size_t)128 * MiB / 16;
    for (size_t i = (size_t)C.blk * NTHR + C.tid; i < NZ; i += (size_t)C.G * NTHR) z[i] = (u32x4){0u, 0u, 0u, 0u};
}

__device__ __forceinline__ void naive_mixers(Ctx& C, int l) {
    const float* Gt = (const float*)(C.ws + WS_GATES);
    const bf16* XC = (const bf16*)(C.ws + B_XBCC); const bf16* QC = (const bf16*)(C.ws + B_MQKC);
    const bf16* HQ = (const bf16*)(C.ws + B_HQ); const bf16* HFR = (const bf16*)(C.ws + B_HFR); const bf16* HI = (const bf16*)(C.ws + B_HI); const bf16* MV = (const bf16*)(C.ws + B_MV);
    float* YB = (float*)(C.ws + B_YBUF); float* OB = (float*)(C.ws + B_OBUF); float* HBf = (float*)(C.ws + B_HBUF);
    const int tid = C.tid;
    for (int u = C.blk; u < 96; u += C.G) {
        if (u < 64) {
            const int b = u >> 5, dir = (u >> 4) & 1, h = u & 15, g = h >> 3;
            const int p = tid >> 3, nq = tid & 7;
            const float dtb = C.in[6][(l * 2 + dir) * 16 + h], Aneg = -__expf(C.in[7][(l * 2 + dir) * 16 + h]);
            float st[16];
#pragma unroll
            for (int i = 0; i < 16; ++i) st[i] = 0.f;
            for (int s = 0; s < SEQ; ++s) {
                const int t = dir ? (SEQ - 1 - s) : s; const size_t tok = (size_t)b * SEQ + t;
                const float dt = softplusf_(Gt[tok * NGATE + dir * 16 + h] + dtb), dec = __expf(dt * Aneg);
                const float xv = dt * bf2f(XC[tok * 1536 + h * 64 + p]);
                const u32x4 b0 = *(const u32x4*)(XC + tok * 1536 + 1024 + g * 128 + nq * 16), b1 = *(const u32x4*)(XC + tok * 1536 + 1024 + g * 128 + nq * 16 + 8);
                const u32x4 c0 = *(const u32x4*)(XC + tok * 1536 + 1280 + g * 128 + nq * 16), c1 = *(const u32x4*)(XC + tok * 1536 + 1280 + g * 128 + nq * 16 + 8);
                const unsigned bw[8] = {b0.x, b0.y, b0.z, b0.w, b1.x, b1.y, b1.z, b1.w}, cwv[8] = {c0.x, c0.y, c0.z, c0.w, c1.x, c1.y, c1.z, c1.w};
                float y = 0.f;
#pragma unroll
                for (int i = 0; i < 8; ++i) {
                    st[2 * i] = st[2 * i] * dec + xv * bflo(bw[i]); st[2 * i + 1] = st[2 * i + 1] * dec + xv * bfhi(bw[i]);
                    y += st[2 * i] * bflo(cwv[i]) + st[2 * i + 1] * bfhi(cwv[i]);
                }
                y += __shfl_xor(y, 1); y += __shfl_xor(y, 2); y += __shfl_xor(y, 4);
                if (nq == 0) atomicAdd(YB + tok * 1024 + h * 64 + p, y);
            }
        } else if (u < 80) {
            const int uu = u - 64, b = uu >> 3, dir = (uu >> 2) & 1, hd = uu & 3;
            const int v = tid >> 2, kq = tid & 3;
            float st[32], oml[32];
#pragma unroll
            for (int i = 0; i < 32; ++i) {
                const int ch = hd * 128 + kq * 32 + i;
                const float x0 = C.in[10][0 * 512 + ch], x1 = C.in[10][1 * 512 + ch], x2 = C.in[10][2 * 512 + ch], x3 = C.in[10][3 * 512 + ch];
                const float mx = fmaxf(fmaxf(x0, x1), fmaxf(x2, x3)); const float e0 = __expf(x0 - mx), e1 = __expf(x1 - mx), e2 = __expf(x2 - mx), e3 = __expf(x3 - mx); const float inv = 1.0f / (e0 + e1 + e2 + e3);
                float lb = 0.f; if (l >= 1) lb += e1 * inv; if (l >= 2) lb += e2 * inv; if (l >= 3) lb += e3 * inv;
                oml[i] = 1.0f - lb; st[i] = 0.f;
            }
            for (int s = 0; s < SEQ; ++s) {
                const int t = dir ? (SEQ - 1 - s) : s; const size_t tok = (size_t)b * SEQ + t;
                const float vv = bf2f(HI[tok * 512 + hd * 128 + v]);
                float o = 0.f;
#pragma unroll
                for (int c4 = 0; c4 < 4; ++c4) {
                    const u32x4 fw = *(const u32x4*)(HFR + tok * 1024 + dir * 512 + hd * 128 + kq * 32 + c4 * 8);
                    const u32x4 qw = *(const u32x4*)(HQ + tok * 512 + hd * 128 + kq * 32 + c4 * 8);
                    const unsigned fa[4] = {fw.x, fw.y, fw.z, fw.w}, qa[4] = {qw.x, qw.y, qw.z, qw.w};
#pragma unroll
                    for (int i = 0; i < 4; ++i) {
                        const int k0 = c4 * 8 + 2 * i;
                        const float key0 = oml[k0] * sigmoidf_(-bflo(fa[i])), key1 = oml[k0 + 1] * sigmoidf_(-bfhi(fa[i]));
                        st[k0] = (1.0f - key0) * st[k0] + key0 * vv; st[k0 + 1] = (1.0f - key1) * st[k0 + 1] + key1 * vv;
                        o += siluf_(bflo(qa[i])) * st[k0] + siluf_(bfhi(qa[i])) * st[k0 + 1];
                    }
                }
                o += __shfl_xor(o, 1); o += __shfl_xor(o, 2);
                if (kq == 0) atomicAdd(OB + tok * 512 + hd * 128 + v, o);
            }
        } else {
            const int uu = u - 80, b = uu >> 3, dir = (uu >> 2) & 1, hd = uu & 3;
            const int v = tid >> 2, kq = tid & 3;
            const float igb = C.in[14][(l * 2 + dir) * 4 + hd], fgb = C.in[15][(l * 2 + dir) * 4 + hd];
            float cs[32], ns[32];
#pragma unroll
            for (int i = 0; i < 32; ++i) { cs[i] = 0.f; ns[i] = 0.f; }
            for (int s = 0; s < SEQ; ++s) {
                const int t = dir ? (SEQ - 1 - s) : s; const size_t tok = (size_t)b * SEQ + t;
                const float ei = __expf(Gt[tok * NGATE + 32 + dir * 4 + hd] + igb);
                const float f = __expf(-softplusf_(-(Gt[tok * NGATE + 40 + dir * 4 + hd] + fgb)));
                const float vv = bf2f(MV[tok * 512 + hd * 128 + v]);
                float num = 0.f, den = 0.f;
#pragma unroll
                for (int c4 = 0; c4 < 4; ++c4) {
                    const u32x4 qw = *(const u32x4*)(QC + tok * 1024 + hd * 128 + kq * 32 + c4 * 8);
                    const u32x4 kw = *(const u32x4*)(QC + tok * 1024 + 512 + hd * 128 + kq * 32 + c4 * 8);
                    const unsigned qa[4] = {qw.x, qw.y, qw.z, qw.w}, ka[4] = {kw.x, kw.y, kw.z, kw.w};
#pragma unroll
                    for (int i = 0; i < 4; ++i) {
                        const int k0 = c4 * 8 + 2 * i;
                        const float ka0 = ei * bflo(ka[i]), ka1 = ei * bfhi(ka[i]);
                        cs[k0] = f * cs[k0] + ka0 * vv; cs[k0 + 1] = f * cs[k0 + 1] + ka1 * vv;
                        ns[k0] = f * ns[k0] + ka0; ns[k0 + 1] = f * ns[k0 + 1] + ka1;
                        const float q0 = bflo(qa[i]) * 0.08838834764831845f, q1 = bfhi(qa[i]) * 0.08838834764831845f;
                        num += q0 * cs[k0] + q1 * cs[k0 + 1]; den += q0 * ns[k0] + q1 * ns[k0 + 1];
                    }
                }
                num += __shfl_xor(num, 1); num += __shfl_xor(num, 2); den += __shfl_xor(den, 1); den += __shfl_xor(den, 2);
                if (kq == 0) atomicAdd(HBf + tok * 512 + hd * 128 + v, num / fmaxf(fabsf(den), 1.0f));
            }
        }
    }
}
__device__ __forceinline__ void naive_combine(Ctx& C, int l) {
    const float* YB = (const float*)(C.ws + B_YBUF); const float* OB = (const float*)(C.ws + B_OBUF); const float* HBf = (const float*)(C.ws + B_HBUF);
    const bf16* XC = (const bf16*)(C.ws + B_XBCC); const bf16* Z = (const bf16*)(C.ws + B_Z); const bf16* HG = (const bf16*)(C.ws + B_HG); const bf16* MO = (const bf16*)(C.ws + B_MO);
    bf16* MIX = (bf16*)(C.ws + B_MIX);
    const float* dsk = C.in[8] + l * 16; const float* nw1 = C.in[9] + l * 1024; const float* nw2 = C.in[11] + l * 512; const float* nw3 = C.in[16] + l * 512;
    const int gw = C.blk * NWAVES + C.wave, NGW = C.G * NWAVES, lane = C.lane;
    for (int tok = gw; tok < T; tok += NGW) {
        { float y[16]; float ss = 0.f; const int c0 = 16 * lane; const float dk = dsk[c0 >> 6];
#pragma unroll
          for (int j = 0; j < 16; ++j) { const float x = bf2f(XC[(size_t)tok * 1536 + c0 + j]); const float z = bf2f(Z[(size_t)tok * 1024 + c0 + j]);
              y[j] = (YB[(size_t)tok * 1024 + c0 + j] + x * dk) * siluf_(z); ss += y[j] * y[j]; }
#pragma unroll
          for (int o = 1; o < 32; o <<= 1) ss += __shfl_xor(ss, o);
          const float r = 1.0f / sqrtf(ss * (1.f / 512.f) + RMS_EPS);
#pragma unroll
          for (int j = 0; j < 16; ++j) MIX[(size_t)tok * 2048 + c0 + j] = (bf16)f2bf(y[j] * r * nw1[c0 + j]); }
        { float o[8]; float ss = 0.f; const int c0 = 8 * lane;
#pragma unroll
          for (int j = 0; j < 8; ++j) { o[j] = OB[(size_t)tok * 512 + c0 + j]; ss += o[j] * o[j]; }
#pragma unroll
          for (int q = 1; q < 16; q <<= 1) ss += __shfl_xor(ss, q);
          const float r = 1.0f / sqrtf(ss * (1.f / 128.f) + RMS_EPS);
#pragma unroll
          for (int j = 0; j < 8; ++j) MIX[(size_t)tok * 2048 + 1024 + c0 + j] = (bf16)f2bf(o[j] * r * nw2[c0 + j] * siluf_(bf2f(HG[(size_t)tok * 512 + c0 + j]))); }
        { float o[8]; float s = 0.f; const int c0 = 8 * lane;
#pragma unroll
          for (int j = 0; j < 8; ++j) { o[j] = HBf[(size_t)tok * 512 + c0 + j]; s += o[j]; }
#pragma unroll
          for (int q = 1; q < 16; q <<= 1) s += __shfl_xor(s, q);
          const float mean = s * (1.f / 128.f); float ss = 0.f;
#pragma unroll
          for (int j = 0; j < 8; ++j) { o[j] -= mean; ss += o[j] * o[j]; }
#pragma unroll
          for (int q = 1; q < 16; q <<= 1) ss += __shfl_xor(ss, q);
          const float r = 1.0f / sqrtf(ss * (1.f / 128.f) + LN_EPS);
#pragma unroll
          for (int j = 0; j < 8; ++j) MIX[(size_t)tok * 2048 + 1536 + c0 + j] = (bf16)f2bf(o[j] * r * nw3[c0 + j] * sigmoidf_(bf2f(MO[(size_t)tok * 512 + c0 + j]))); }
    }
}

constexpr int PH_PER_LAYER = 11, NPHASES = 1 + DEPTH * PH_PER_LAYER;
__global__ void __launch_bounds__(NTHR, 2) fwd_kernel(Args args) {
    extern __shared__ __attribute__((aligned(16))) unsigned char lds_raw[];
    Ctx C;
    C.lds = (LAS unsigned char*)lds_raw; C.misc = (volatile LAS unsigned*)(C.lds + MISC_OFF);
    C.ws = args.ws; C.in.lds = C.lds; C.out = args.out;
    C.tid = threadIdx.x; C.lane = C.tid & 63; C.wave = __builtin_amdgcn_readfirstlane(C.tid >> 6); C.G = gridDim.x; C.blk = blockIdx.x;
    if (C.tid < 64) C.misc[C.tid] = 0u;
    if (C.tid < 31) { const unsigned long long p = C.tid < 29 ? (unsigned long long)args.in[C.tid] : (C.tid == 29 ? (unsigned long long)args.out : (unsigned long long)args.ws);
        *(LAS u32x2*)(C.lds + PTAB_OFF + 8 * C.tid) = (u32x2){(unsigned)p, (unsigned)(p >> 32)}; }
    __syncthreads();
    const int lo = args.ph_lo, hi = args.ph_hi;
#if MK_ONE_LAUNCH
    XcdBarrier bar = xcd_barrier_post((unsigned*)(C.ws + WS_CTL) + CW_BAR, C.misc + 32);
#define GRID_BAR() xcd_barrier(bar)
#else
#define GRID_BAR() do { } while (0)
#endif
#define IN(k) (lo <= (k) && (k) < hi)
#define SEAM(k) do { if (IN((k) + 1)) GRID_BAR(); } while (0)
#define LAUNDER() do { __syncthreads(); C.out = (float*)C.in[29]; C.ws = (unsigned char*)C.in[30]; int t_ = threadIdx.x; asm volatile("" : "+v"(t_)); C.tid = t_; C.lane = t_ & 63; C.wave = __builtin_amdgcn_readfirstlane(t_ >> 6); } while (0)

    if (IN(0)) { LAUNDER();
        ln_phase<0, 1>(C, C.in[0], C.in[1], C.in[2], (float*)(C.ws + WS_HF32), 0);
        __syncthreads();
        wconv_layer(C, 0);
        SEAM(0);
    }
    for (int l = 0; l < DEPTH; ++l) {
        const int pb = 1 + l * PH_PER_LAYER; const bool moe = (l & 1) != 0; const int lm = l >> 1;
        const int dff = moe ? DFF_E : DFF_D;
        if (IN(pb + 0)) { LAUNDER();
            pg8::GOrder S; S.init(C.ws + WS_HBF, C.ws + WS_WIN, D, T / 256, NMAIN / 256, C.G, C.blk, 0, nullptr);
            pg8::EpiProj E{C.ws};
            pg8::gemm_phase<pg8::EpiProj, pg8::GOrder>(C.lds, D, S, E, C.tid);
            SEAM(pb + 0);
        }
        if (IN(pb + 1)) { LAUNDER(); conv_phase(C, l); SEAM(pb + 1); }
        if (IN(pb + 2)) { LAUNDER(); naive_mixers(C, l); SEAM(pb + 2); }
        if (IN(pb + 3)) { LAUNDER(); SEAM(pb + 3); }
        if (IN(pb + 4)) { LAUNDER(); naive_combine(C, l); SEAM(pb + 4); }
        if (IN(pb + 5)) { LAUNDER();
            pg8::GOrder S; S.init(C.ws + B_MIX, C.ws + WS_WOUT, DMIX, T / 256, D / 256, C.G, C.blk, 0, nullptr);
            pg8::EpiF32 E{(float*)(C.ws + B_Y), D};
            pg8::gemm_phase<pg8::EpiF32, pg8::GOrder>(C.lds, DMIX, S, E, C.tid);
            SEAM(pb + 5);
        }
        if (IN(pb + 6)) { LAUNDER();
            if (moe) ln_phase<1, 2>(C, nullptr, C.in[18] + l * D, C.in[19] + l * D, (float*)(C.ws + WS_HF32), l);
            else ln_phase<1, 0>(C, nullptr, C.in[18] + l * D, C.in[19] + l * D, (float*)(C.ws + WS_HF32), l);
            SEAM(pb + 6);
        }
        if (IN(pb + 7)) { LAUNDER(); if (moe) moe_dispatch(C, lm); SEAM(pb + 7); }
        if (IN(pb + 8)) { LAUNDER();
            __syncthreads();
            const int nblk = moe_cum_table(C, lm, moe);
            pg8::GOrder S; S.init(moe ? C.ws + B_XS : C.ws + WS_HBF, C.ws + WS_W13, D, nblk, 2 * dff / 256, C.G, C.blk, (size_t)2 * dff * D * 2, (const LAS int*)(C.lds + MISC_OFF));
            pg8::EpiSwiglu E{(bf16*)(C.ws + B_HID), dff};
            pg8::gemm_phase<pg8::EpiSwiglu, pg8::GOrder>(C.lds, D, S, E, C.tid);
            SEAM(pb + 8);
        }
        if (IN(pb + 9)) { LAUNDER();
            __syncthreads();
            const int nblk = moe_cum_table(C, lm, moe);
            pg8::GOrder S; S.init(C.ws + B_HID, C.ws + WS_W2, dff, nblk, D / 256, C.G, C.blk, (size_t)D * dff * 2, (const LAS int*)(C.lds + MISC_OFF));
            pg8::EpiF32 E{(float*)(C.ws + B_YE), D};
            pg8::gemm_phase<pg8::EpiF32, pg8::GOrder>(C.lds, dff, S, E, C.tid);
            SEAM(pb + 9);
        }
        if (IN(pb + 10)) { LAUNDER();
            float* dst = (l == DEPTH - 1) ? C.out : (float*)(C.ws + WS_HF32);
            const float* g = C.in[20] + l * D; const float* b = C.in[21] + l * D;
            if (l == DEPTH - 1) { if (moe) ln_phase<3, 0>(C, nullptr, g, b, dst, l); else ln_phase<2, 0>(C, nullptr, g, b, dst, l); }
            else { if (moe) ln_phase<3, 1>(C, nullptr, g, b, dst, l + 1); else ln_phase<2, 1>(C, nullptr, g, b, dst, l + 1);
                __syncthreads(); wconv_layer(C, l + 1); }
            SEAM(pb + 10);
        }
    }
#undef IN
#undef SEAM
}

extern "C" void kernel_launch(void* const* d_in, const int* in_sizes, int n_in, void* d_out, int out_size, void* d_ws, size_t ws_size, hipStream_t stream) {
    static int grid = 0;
    if (grid == 0) {
        if (n_in != 29 || out_size != T * D || ws_size < WS_END) { fprintf(stderr, "kernel_launch: unexpected shapes (n_in %d out %d ws %zu need %zu)\n", n_in, out_size, ws_size, (size_t)WS_END); grid = -1; return; }
        int dev = 0, cus = 0, per_cu = 0;
        if (hipGetDevice(&dev) != hipSuccess || hipDeviceGetAttribute(&cus, hipDeviceAttributeMultiprocessorCount, dev) != hipSuccess) { grid = -1; return; }
        if (hipFuncSetAttribute((const void*)fwd_kernel, hipFuncAttributeMaxDynamicSharedMemorySize, LDS_BYTES) != hipSuccess) { grid = -1; return; }
        if (hipOccupancyMaxActiveBlocksPerMultiprocessor(&per_cu, (const void*)fwd_kernel, NTHR, LDS_BYTES) != hipSuccess || per_cu < 1) fprintf(stderr, "kernel_launch: occupancy query says %d\n", per_cu);
        (void)hipGetLastError();
        grid = cus;
    }
    if (grid < 0) return;
    (void)hipMemsetAsync((char*)d_ws + WS_CTL, 0, CTL_ZERO_BYTES, stream);
    Args a{};
    for (int i = 0; i < 29; ++i) a.in[i] = (const float*)d_in[i];
    a.out = (float*)d_out; a.ws = (unsigned char*)d_ws;
#if MK_ONE_LAUNCH
    a.ph_lo = 0; a.ph_hi = NPHASES;
    hipLaunchKernelGGL(fwd_kernel, dim3(grid), dim3(NTHR), LDS_BYTES, stream, a);
#else
    for (int p = 0; p < NPHASES; ++p) {
        if (p >= 1) { const int k = (p - 1) % PH_PER_LAYER, l = (p - 1) / PH_PER_LAYER; if (k == 3) continue; if (k == 7 && !(l & 1)) continue; }
        a.ph_lo = p; a.ph_hi = p + 1;
        hipLaunchKernelGGL(fwd_kernel, dim3(grid), dim3(NTHR), LDS_BYTES, stream, a);
    }
#endif
}
```

```cpp
#include <hip/hip_runtime.h>
#include <cstdio>
#include <cstdint>

#ifndef MK_ONE_LAUNCH
#define MK_ONE_LAUNCH 1
#endif

#ifndef FAST_SSD
#define FAST_SSD 1
#endif
#ifndef FAST_HG
#define FAST_HG 1
#endif
#ifndef FAST_ML
#define FAST_ML 1
#endif

#define LAS __attribute__((address_space(3)))
#define GAS __attribute__((address_space(1)))
typedef unsigned short bf16;
typedef short bf16x8 __attribute__((ext_vector_type(8)));
typedef float f32x4 __attribute__((ext_vector_type(4)));
typedef float f32x2 __attribute__((ext_vector_type(2)));
typedef unsigned u32x4 __attribute__((ext_vector_type(4)));
typedef unsigned u32x2 __attribute__((ext_vector_type(2)));

constexpr int T = 16384, SEQ = 8192, D = 1024, DEPTH = 4, DPROJ = 7216, NMAIN = 7168, DMIX = 2048;
constexpr int DFF_D = 2816, DFF_E = 3584, NEXP = 8, NGATE = 48;
constexpr int NWAVES = 8, NTHR = 512;
constexpr float ALPHA = 1.681792830507429f;
constexpr float LN_EPS = 1e-5f, RMS_EPS = 1e-6f;
constexpr int MOE_ROWS = 34816;

constexpr size_t MiB = 1u << 20;
constexpr size_t WS_CTL = 0, CTL_ZERO_BYTES = 1 * MiB;
constexpr size_t WS_HF32 = 1 * MiB, WS_HBF = 65 * MiB, WS_GATES = 97 * MiB, WS_ROUTE = 100 * MiB;
constexpr size_t WS_WIN = 101 * MiB, WS_WOUT = 115 * MiB, WS_W13 = 119 * MiB, WS_W2 = 231 * MiB, WS_BIG = 287 * MiB;
constexpr size_t B_Z = WS_BIG + 0 * MiB, B_XBCR = WS_BIG + 32 * MiB, B_HQ = WS_BIG + 80 * MiB, B_HFR = WS_BIG + 96 * MiB, B_HI = WS_BIG + 128 * MiB, B_HG = WS_BIG + 144 * MiB;
constexpr size_t B_MQKR = WS_BIG + 160 * MiB, B_MV = WS_BIG + 192 * MiB, B_MO = WS_BIG + 208 * MiB;
constexpr size_t B_XBCC = WS_BIG + 224 * MiB, B_MQKC = WS_BIG + 272 * MiB;
constexpr size_t B_YBUF = WS_BIG + 304 * MiB, B_OBUF = WS_BIG + 368 * MiB, B_HBUF = WS_BIG + 432 * MiB;
constexpr size_t B_MIX = WS_BIG + 464 * MiB;
constexpr size_t B_Y = WS_BIG + 0 * MiB;
constexpr size_t B_XS = WS_BIG + 64 * MiB, B_HID = WS_BIG + 136 * MiB, B_YE = WS_BIG + 376 * MiB;
constexpr size_t B_STS = WS_BIG + 304 * MiB, B_STH = WS_BIG + 368 * MiB, B_STM = WS_BIG + 432 * MiB;
constexpr size_t B_DECS = WS_BIG + 528 * MiB, B_DECM = B_DECS + 65536, B_NM = B_DECS + 131072, B_DECH = B_DECS + 1 * MiB;
constexpr size_t WS_END = WS_BIG + 532 * MiB;
constexpr int CW_TMO = 0, CW_BAR = 4096, CW_CNT = 8192;

#define LDS_WAIT() asm volatile("s_waitcnt lgkmcnt(0)" ::: "memory")
#define VM_WAIT() asm volatile("s_waitcnt vmcnt(0)" ::: "memory")
__device__ __forceinline__ unsigned f2bf(float f) { unsigned u = __builtin_bit_cast(unsigned, f); return (u + 0x7fffu + ((u >> 16) & 1u)) >> 16; }
__device__ __forceinline__ unsigned pk2(float lo, float hi) { return f2bf(lo) | (f2bf(hi) << 16); }
__device__ __forceinline__ float bf2f(unsigned short b) { return __builtin_bit_cast(float, ((unsigned)b) << 16); }
__device__ __forceinline__ float bflo(unsigned w) { return __builtin_bit_cast(float, w << 16); }
__device__ __forceinline__ float bfhi(unsigned w) { return __builtin_bit_cast(float, w & 0xffff0000u); }
__device__ __forceinline__ float sigmoidf_(float x) { return 1.0f / (1.0f + __expf(-x)); }
__device__ __forceinline__ float siluf_(float x) { return x / (1.0f + __expf(-x)); }
__device__ __forceinline__ float softplusf_(float x) { return fmaxf(x, 0.f) + log1pf(__expf(-fabsf(x))); }
__device__ __forceinline__ float wave_sum(float v) {
#pragma unroll
    for (int o = 1; o < 64; o <<= 1) v += __shfl_xor(v, o);
    return v;
}

namespace pg8 {
#define PG8_LAS __attribute__((address_space(3)))
typedef unsigned short bf16_t;
constexpr int BM = 256, BK = 64, HALF = 128, HTB = HALF * BK * 2, STAGE_BYTES = 8 * HTB, NXCD = 8, WGM = 8;
__host__ __device__ __forceinline__ int lds_byte(int r, int c) { const int st = (r >> 4) * 2 + (c >> 5), rr = r & 15, cc = c & 31, ob = rr * 64 + cc * 2; return st * 1024 + (ob ^ (((ob >> 9) & 1) << 5)); }
__host__ __device__ __forceinline__ void stage_rc(int b, int& R, int& C) { const int st = b / 1024, sb = b % 1024, swz = sb ^ (((sb >> 9) & 1) << 5); R = (st >> 1) * 16 + swz / 64; C = (st & 1) * 32 + (swz % 64) / 2; }
__host__ __device__ __forceinline__ int perm32(int rho) { const int n = rho >> 4, i = rho & 15; return 8 * (i >> 2) + 4 * n + (i & 3); }

struct Unit { const char* A; const char* B; int pm, pn; };

struct GOrder {
    const char* A; const char* Bt; int K; int nM, nN, nwg, G, c; size_t bexp; const PG8_LAS int* cum;
    __device__ void init(const void* A_, const void* Bt_, int K_, int nM_, int nN_, int G_, int c_, size_t bexp_, const PG8_LAS int* cum_) { A = (const char*)A_; Bt = (const char*)Bt_; K = K_; nM = nM_; nN = nN_; nwg = nM * nN; G = G_; c = c_; bexp = bexp_; cum = cum_; }
    __device__ bool next(int i, Unit& u) const {
        const long L = (long)i * G + c; if (L >= nwg) return false;
        int wgid = (int)L; { const int q = nwg / NXCD, r = nwg % NXCD, xcd = wgid % NXCD, off = wgid / NXCD; wgid = (xcd < r ? xcd * (q + 1) : r * (q + 1) + (xcd - r) * q) + off; }
        const int nig = WGM * nN, gid = wgid / nig, fm = gid * WGM, gsz = (nM - fm) < WGM ? (nM - fm) : WGM;
        u.pm = fm + ((wgid % nig) % gsz); u.pn = (wgid % nig) / gsz;
        int e = 0; if (cum) { for (int j = 0; j < 8; ++j) e += (cum[j] <= u.pm) ? 1 : 0; if (e > 7) e = 7; }
        u.A = A + (size_t)u.pm * 256 * K * 2; u.B = Bt + (size_t)e * bexp + (size_t)u.pn * 256 * K * 2; return true;
    }
};
__device__ __forceinline__ unsigned cvt_pk_bf16(float lo, float hi) { unsigned r; asm volatile("v_cvt_pk_bf16_f32 %0, %1, %2" : "=v"(r) : "v"(lo), "v"(hi)); return r; }

struct EpiF32 {
    static constexpr bool PERM = false;
    float* C; int ldc;
    __device__ __forceinline__ void operator()(const f32x4 (&acc)[2][2][4][2], const Unit& u, int wr, int wc, int fr, int fq) const {
        const int row0 = u.pm * BM + wr * 64 + fr, col0 = u.pn * BM + wc * 32 + 4 * fq;
#pragma unroll
        for (int ai = 0; ai < 2; ++ai)
#pragma unroll
            for (int m = 0; m < 4; ++m) { float* rowp = C + (size_t)(row0 + ai * HALF + m * 16) * ldc + col0;
#pragma unroll
                for (int bj = 0; bj < 2; ++bj)
#pragma unroll
                    for (int n = 0; n < 2; ++n) *(f32x4*)(rowp + bj * HALF + n * 16) = acc[ai][bj][m][n]; }
    }
};
struct EpiProj {
    static constexpr bool PERM = true;
    unsigned char* ws;
    __device__ __forceinline__ void operator()(const f32x4 (&acc)[2][2][4][2], const Unit& u, int wr, int wc, int fr, int fq) const {
        const int pn = u.pn; size_t off; int ldc, c0;
        if (pn < 4) { off = B_Z; ldc = 1024; c0 = pn; } else if (pn < 10) { off = B_XBCR; ldc = 1536; c0 = pn - 4; } else if (pn < 12) { off = B_HQ; ldc = 512; c0 = pn - 10; }
        else if (pn < 16) { off = B_HFR; ldc = 1024; c0 = pn - 12; } else if (pn < 18) { off = B_HI; ldc = 512; c0 = pn - 16; } else if (pn < 20) { off = B_HG; ldc = 512; c0 = pn - 18; }
        else if (pn < 24) { off = B_MQKR; ldc = 1024; c0 = pn - 20; } else if (pn < 26) { off = B_MV; ldc = 512; c0 = pn - 24; } else { off = B_MO; ldc = 512; c0 = pn - 26; }
        bf16_t* base = (bf16_t*)(ws + off);
        const int row0 = u.pm * BM + wr * 64 + fr, col0 = c0 * BM + wc * 32 + 8 * fq;
#pragma unroll
        for (int ai = 0; ai < 2; ++ai)
#pragma unroll
            for (int m = 0; m < 4; ++m) { bf16_t* rowp = base + (size_t)(row0 + ai * HALF + m * 16) * ldc + col0;
#pragma unroll
                for (int bj = 0; bj < 2; ++bj) { const f32x4 v0 = acc[ai][bj][m][0], v1 = acc[ai][bj][m][1];
                    u32x4 w; w.x = cvt_pk_bf16(v0[0], v0[1]); w.y = cvt_pk_bf16(v0[2], v0[3]); w.z = cvt_pk_bf16(v1[0], v1[1]); w.w = cvt_pk_bf16(v1[2], v1[3]);
                    *(u32x4*)(rowp + bj * HALF) = w; } }
    }
};
struct EpiSwiglu {
    static constexpr bool PERM = true;
    bf16_t* O; int ldc;
    __device__ __forceinline__ void operator()(const f32x4 (&acc)[2][2][4][2], const Unit& u, int wr, int wc, int fr, int fq) const {
        const int row0 = u.pm * BM + wr * 64 + fr, col0 = u.pn * HALF + wc * 32 + 8 * fq;
#pragma unroll
        for (int ai = 0; ai < 2; ++ai)
#pragma unroll
            for (int m = 0; m < 4; ++m) { bf16_t* rowp = O + (size_t)(row0 + ai * HALF + m * 16) * ldc + col0;
                float o[8];
#pragma unroll
                for (int n = 0; n < 2; ++n)
#pragma unroll
                    for (int j = 0; j < 4; ++j) { const float a = acc[ai][0][m][n][j], b = acc[ai][1][m][n][j]; o[n * 4 + j] = a * __builtin_amdgcn_rcpf(1.0f + __expf(-a)) * b; }
                u32x4 w; w.x = cvt_pk_bf16(o[0], o[1]); w.y = cvt_pk_bf16(o[2], o[3]); w.z = cvt_pk_bf16(o[4], o[5]); w.w = cvt_pk_bf16(o[6], o[7]);
                *(u32x4*)rowp = w; }
    }
};

template <class Epi, class Sched, bool ALIGN_EPI = true>
__device__ __forceinline__ void gemm_phase(PG8_LAS unsigned char* lds, const int K, const Sched& S, const Epi& E, const int tid) {
    const int wid = __builtin_amdgcn_readfirstlane(tid >> 6), lane = tid & 63, wr = wid >> 2, wc = wid & 3, fr = lane & 15, fq = lane >> 4;
    const int nt = K / BK;
    unsigned voffA[2], voffB[2];
#pragma unroll
    for (int i = 0; i < 2; ++i) { int R, C; stage_rc(tid * 16 + i * 8192, R, C); const int Rb = Epi::PERM ? ((R & ~31) + perm32(R & 31)) : R;
        voffA[i] = (unsigned)(R * K + C) * 2u; voffB[i] = (unsigned)(Rb * K + C) * 2u; }
    const size_t kstep = (size_t)(BK * 2);
    const size_t hstep = (size_t)HALF * K * 2;
    const unsigned ldsw = (unsigned)wid * 1024u;
    const int aoff = lds_byte(wr * 64 + fr, fq * 8), boff = lds_byte(wc * 32 + fr, fq * 8);
#define PG8_SA(b, h) (((b) * 2 + (h)) * HTB)
#define PG8_SB(b, h) ((4 + (b) * 2 + (h)) * HTB)
#define PG8_STAGE(bufoff, gbase, voff) do { _Pragma("unroll") for (int _i = 0; _i < 2; ++_i) \
        __builtin_amdgcn_global_load_lds((const unsigned*)((const char*)(gbase) + (voff)[_i]), (PG8_LAS unsigned*)(lds + (bufoff) + ldsw + _i * 8192), 16, 0, 0); } while (0)
#define PG8_LDA(dst, b, h) do { _Pragma("unroll") for (int m = 0; m < 4; ++m) _Pragma("unroll") for (int k = 0; k < 2; ++k) dst[m][k] = *(const PG8_LAS bf16x8*)(lds + PG8_SA(b, h) + aoff + m * 2048 + k * 1024); } while (0)
#define PG8_LDB(dst, b, h) do { _Pragma("unroll") for (int n = 0; n < 2; ++n) _Pragma("unroll") for (int k = 0; k < 2; ++k) dst[n][k] = *(const PG8_LAS bf16x8*)(lds + PG8_SB(b, h) + boff + n * 2048 + k * 1024); } while (0)
#define PG8_MMA(ai, bj, At, Bt) do { __builtin_amdgcn_s_setprio(1); _Pragma("unroll") for (int m = 0; m < 4; ++m) _Pragma("unroll") for (int n = 0; n < 2; ++n) _Pragma("unroll") for (int k = 0; k < 2; ++k) \
        acc[ai][bj][m][n] = __builtin_amdgcn_mfma_f32_16x16x32_bf16(Bt[n][k], At[m][k], acc[ai][bj][m][n], 0, 0, 0); __builtin_amdgcn_s_setprio(0); } while (0)
#define PG8_WAIT_V(n) asm volatile("s_waitcnt vmcnt(" #n ")" ::: "memory")
#define PG8_WAIT_L(n) asm volatile("s_waitcnt lgkmcnt(" #n ")" ::: "memory")
#define PG8_BAR __builtin_amdgcn_s_barrier()
#define PG8_SCHED __builtin_amdgcn_sched_barrier(0)
    Unit cur, nxt; int ui = 0;
    if (!S.next(0, cur)) return;
    f32x4 acc[2][2][4][2];
#pragma unroll
    for (int a = 0; a < 2; ++a)
#pragma unroll
        for (int b = 0; b < 2; ++b)
#pragma unroll
            for (int m = 0; m < 4; ++m)
#pragma unroll
                for (int n = 0; n < 2; ++n) acc[a][b][m][n] = (f32x4){0.f, 0.f, 0.f, 0.f};
    bf16x8 At[4][2], B0[2][2], B1[2][2];
    const char* cA = cur.A; const char* cB = cur.B;
    PG8_STAGE(PG8_SB(0, 0), cB, voffB); PG8_STAGE(PG8_SB(0, 1), cB + hstep, voffB); PG8_STAGE(PG8_SA(0, 0), cA, voffA); PG8_STAGE(PG8_SA(0, 1), cA + hstep, voffA);
    if (wr == 1) PG8_BAR;
    PG8_WAIT_V(2); PG8_BAR;
    PG8_STAGE(PG8_SB(1, 0), cB + kstep, voffB); PG8_STAGE(PG8_SA(1, 0), cA + kstep, voffA); PG8_STAGE(PG8_SB(1, 1), cB + hstep + kstep, voffB);
    PG8_WAIT_V(6); PG8_BAR;
    for (;;) {
        const bool has_next = S.next(ui + 1, nxt);
        const char* nA = has_next ? nxt.A : cA; const char* nB = has_next ? nxt.B : cB;
        for (int t = 0; t < nt; t += 2) {
            const bool last = (t == nt - 2);
            const char* a1 = cA + (size_t)(t + 1) * kstep;
            const char* a2 = last ? nA : cA + (size_t)(t + 2) * kstep; const char* b2 = last ? nB : cB + (size_t)(t + 2) * kstep;
            const char* a3 = a2 + kstep; const char* b3 = b2 + kstep;
            PG8_LDB(B0, 0, 0); PG8_LDB(B1, 0, 1); PG8_SCHED; PG8_LDA(At, 0, 0); PG8_STAGE(PG8_SA(1, 1), a1 + hstep, voffA);
            PG8_WAIT_V(8); PG8_WAIT_L(0); PG8_BAR; PG8_MMA(0, 0, At, B0); PG8_MMA(0, 1, At, B1); PG8_BAR; PG8_SCHED;
            PG8_LDA(At, 0, 1); PG8_STAGE(PG8_SB(0, 0), b2, voffB); PG8_STAGE(PG8_SB(0, 1), b2 + hstep, voffB); PG8_STAGE(PG8_SA(0, 0), a2, voffA);
            PG8_WAIT_V(8); PG8_WAIT_L(0); PG8_BAR; PG8_MMA(1, 0, At, B0); PG8_MMA(1, 1, At, B1); PG8_BAR; PG8_SCHED;
            PG8_LDB(B0, 1, 0); PG8_LDB(B1, 1, 1); PG8_SCHED; PG8_LDA(At, 1, 0); PG8_STAGE(PG8_SA(0, 1), a2 + hstep, voffA);
            PG8_WAIT_V(8); PG8_WAIT_L(0); PG8_BAR; PG8_MMA(0, 0, At, B0); PG8_MMA(0, 1, At, B1); PG8_BAR; PG8_SCHED;
            PG8_LDA(At, 1, 1); PG8_STAGE(PG8_SB(1, 0), b3, voffB); PG8_STAGE(PG8_SB(1, 1), b3 + hstep, voffB); PG8_STAGE(PG8_SA(1, 0), a3, voffA);
            PG8_WAIT_V(8); PG8_WAIT_L(0); PG8_BAR; PG8_MMA(1, 0, At, B0); PG8_MMA(1, 1, At, B1); PG8_BAR; PG8_SCHED;
        }
        if constexpr (ALIGN_EPI) { if (wr == 0) PG8_BAR; }
        E(acc, cur, wr, wc, fr, fq);
        if (!has_next) break;
#pragma unroll
        for (int a = 0; a < 2; ++a)
#pragma unroll
            for (int b = 0; b < 2; ++b)
#pragma unroll
                for (int m = 0; m < 4; ++m)
#pragma unroll
                    for (int n = 0; n < 2; ++n) acc[a][b][m][n] = (f32x4){0.f, 0.f, 0.f, 0.f};
        cur = nxt; cA = nA; cB = nB; ++ui;
        if constexpr (ALIGN_EPI) { if (wr == 1) PG8_BAR; }
    }
    PG8_WAIT_V(0);
    if constexpr (!ALIGN_EPI) { if (wr == 0) PG8_BAR; }
    PG8_BAR;
#undef PG8_SA
#undef PG8_SB
#undef PG8_STAGE
#undef PG8_LDA
#undef PG8_LDB
#undef PG8_MMA
#undef PG8_WAIT_V
#undef PG8_WAIT_L
#undef PG8_BAR
#undef PG8_SCHED
}
}

#define XB_TMO      128
#define XB_XCNT(j)  (256  + 64 * (j))
#define XB_XSUB(j)  (1280 + 64 * (j))
#define XB_XGEN(j)  (2304 + 64 * (j))
#define XB_TOP      3328
#define XB_TOPGEN   3392
#define XCD_BAR_WORDS 3456
#define XB_SPIN_CAP (1u << 22)
__device__ __forceinline__ unsigned xb_ld(unsigned* p)              { return __hip_atomic_load(p, __ATOMIC_RELAXED, __HIP_MEMORY_SCOPE_AGENT); }
__device__ __forceinline__ unsigned xb_add(unsigned* p, unsigned v) { return __hip_atomic_fetch_add(p, v, __ATOMIC_RELAXED, __HIP_MEMORY_SCOPE_AGENT); }
__device__ __forceinline__ unsigned xb_xcc_id() { return (unsigned)__builtin_amdgcn_s_getreg((3 << 11) | 20) & 0xFu; }
#define XB_SPIN(cond, bar) do { unsigned _sp = 0; while (cond) { __builtin_amdgcn_s_sleep(1); \
    if ((++_sp & 255u) == 0u) { if (xb_ld(&(bar)[XB_TMO])) break; if (_sp > XB_SPIN_CAP) { atomicAdd(&(bar)[XB_TMO], 1u); break; } } } } while (0)
struct XcdBarrier { unsigned* bar; unsigned x; volatile LAS unsigned* st; };
__device__ __forceinline__ XcdBarrier xcd_barrier_post(unsigned* bar, volatile LAS unsigned* st) {
    XcdBarrier b; b.bar = bar; b.x = xb_xcc_id(); b.st = st;
    if (threadIdx.x == 0) (void)xb_add(&bar[XB_XCNT(b.x)], 1u);
    return b;
}
__device__ __forceinline__ void xcd_barrier_complete(unsigned* bar, unsigned x, unsigned& nloc, unsigned& nx) {
    const unsigned G = gridDim.x * gridDim.y * gridDim.z;
    unsigned sum, cnt, mine, sp = 0u;
    for (;;) {
        sum = 0u; cnt = 0u; mine = 0u;
#pragma unroll
        for (unsigned j = 0; j < 16; ++j) { const unsigned c = xb_ld(&bar[XB_XCNT(j)]); sum += c; cnt += (c > 0u) ? 1u : 0u; mine = (j == x) ? c : mine; }
        if (sum == G) break;
        __builtin_amdgcn_s_sleep(1);
        if ((++sp & 255u) == 0u) { if (xb_ld(&bar[XB_TMO])) break; if (sp > XB_SPIN_CAP) { atomicAdd(&bar[XB_TMO], 1u); break; } }
    }
    nloc = mine > 0u ? mine : 1u; nx = cnt > 0u ? cnt : 1u;
}
__device__ __forceinline__ void xcd_barrier(const XcdBarrier& b) {
    asm volatile("s_waitcnt vmcnt(0)" ::: "memory");
    __syncthreads();
    if (threadIdx.x == 0) {
        unsigned* bar = b.bar;
        __builtin_amdgcn_s_waitcnt(0);
        unsigned nloc = b.st[0], nx = b.st[1];
        if (nloc == 0u) { xcd_barrier_complete(bar, b.x, nloc, nx); b.st[0] = nloc; b.st[1] = nx; }
        const unsigned old = xb_add(&bar[XB_XSUB(b.x)], 1u);
        const unsigned gen = old / nloc;
        if (old + 1u == (gen + 1u) * nloc) {
            __builtin_amdgcn_fence(__ATOMIC_RELEASE, "agent");
            asm volatile("s_waitcnt vmcnt(0)" ::: "memory");
            const unsigned og = xb_add(&bar[XB_TOP], 1u);
            const unsigned tg = og / nx;
            if (og + 1u == (tg + 1u) * nx) xb_add(&bar[XB_TOPGEN], 1u);
            else XB_SPIN(xb_ld(&bar[XB_TOPGEN]) == tg, bar);
            __builtin_amdgcn_fence(__ATOMIC_ACQUIRE, "agent");
            xb_add(&bar[XB_XGEN(b.x)], 1u);
            asm volatile("s_waitcnt vmcnt(0)" ::: "memory");
        } else {
            XB_SPIN(xb_ld(&bar[XB_XGEN(b.x)]) == gen, bar);
            __builtin_amdgcn_fence(__ATOMIC_ACQUIRE, "agent");
            asm volatile("s_waitcnt vmcnt(0)" ::: "memory");
        }
    }
    __syncthreads();
}

constexpr int RING_BYTES = 131072;
constexpr int MISC_OFF = RING_BYTES;
constexpr int LDS_BYTES = 147456;

struct Args { const float* in[29]; float* out; unsigned char* ws; int ph_lo, ph_hi; };

constexpr int PTAB_OFF = MISC_OFF + 256;
struct InTab {
    LAS unsigned char* lds;
    __device__ __forceinline__ const float* operator[](int i) const {
        const u32x2 w = *(const LAS u32x2*)(lds + PTAB_OFF + 8 * i);
        const unsigned long long p = ((unsigned long long)(unsigned)__builtin_amdgcn_readfirstlane((int)w.y) << 32) | (unsigned)__builtin_amdgcn_readfirstlane((int)w.x);
        return (const float*)p;
    }
};
struct Ctx {
    LAS unsigned char* lds; volatile LAS unsigned* misc; unsigned char* ws; InTab in; float* out;
    int tid, lane, wave, G, blk;
};

__device__ __forceinline__ void transpose_item(const float* W, size_t ldw, int K, bf16* WT, size_t dst_row0, size_t src_col0, int kb, LAS float* scr, int lane) {
    const int k0 = 64 * kb;
#pragma unroll 8
    for (int i = 0; i < 32; ++i) { const int kk = 2 * i + (lane >> 5); scr[kk * 33 + (lane & 31)] = W[(size_t)(k0 + kk) * ldw + src_col0 + (lane & 31)]; }
    LDS_WAIT(); asm volatile("" ::: "memory");
    const int c = lane & 7;
#pragma unroll
    for (int j = 0; j < 4; ++j) { const int n = (lane >> 3) + 8 * j; const LAS float* s = scr + (8 * c) * 33 + n;
        u32x4 o; o.x = pk2(s[0 * 33], s[1 * 33]); o.y = pk2(s[2 * 33], s[3 * 33]); o.z = pk2(s[4 * 33], s[5 * 33]); o.w = pk2(s[6 * 33], s[7 * 33]);
        *(u32x4*)(WT + (dst_row0 + n) * (size_t)K + k0 + 8 * c) = o; }
    LDS_WAIT(); asm volatile("" ::: "memory");
}
__device__ __forceinline__ void wconv_layer(Ctx& C, int l) {
    LAS float* scr = (LAS float*)(C.lds + C.wave * 16384);
    const int gw = C.blk * NWAVES + C.wave, NGW = C.G * NWAVES;
    const bool moe = (l & 1) != 0; const int li = l >> 1;
    const int dff = moe ? DFF_E : DFF_D, nexp = moe ? NEXP : 1;
    const int I_A = 16 * (NMAIN / 32), I_B = 32 * 32, I_C1 = 16 * (2 * dff / 32), I_D1 = (dff / 64) * 32;
    const int NIT = I_A + I_B + nexp * (I_C1 + I_D1);
    const float* w_in = C.in[3] + (size_t)l * D * DPROJ; const float* w_out = C.in[17] + (size_t)l * DMIX * D;
    const float* w1 = moe ? C.in[26] + (size_t)li * NEXP * D * DFF_E : C.in[22] + (size_t)li * D * DFF_D;
    const float* w3 = moe ? C.in[27] + (size_t)li * NEXP * D * DFF_E : C.in[23] + (size_t)li * D * DFF_D;
    const float* w2 = moe ? C.in[28] + (size_t)li * NEXP * DFF_E * D : C.in[24] + (size_t)li * DFF_D * D;
    bf16* WinT = (bf16*)(C.ws + WS_WIN); bf16* WoutT = (bf16*)(C.ws + WS_WOUT); bf16* W13T = (bf16*)(C.ws + WS_W13); bf16* W2T = (bf16*)(C.ws + WS_W2);
    for (int it = gw; it < NIT; it += NGW) {
        int r = it;
        if (r < I_A) { const int nb = r % (NMAIN / 32), kb = r / (NMAIN / 32); const int n0 = 32 * nb; transpose_item(w_in, DPROJ, D, WinT, n0, n0 < 2560 ? n0 : n0 + 32, kb, scr, C.lane); continue; } r -= I_A;
        if (r < I_B) { const int nb = r % 32, kb = r / 32; transpose_item(w_out, D, DMIX, WoutT, 32 * nb, 32 * nb, kb, scr, C.lane); continue; } r -= I_B;
        const int per = I_C1 + I_D1, e = r / per; r -= e * per;
        if (r < I_C1) { const int nbn = 2 * dff / 32, nb = r % nbn, kb = r / nbn; const int n0 = 32 * nb, pn = n0 >> 8, within = n0 & 255, bj = within >> 7, uu = within & 127;
            transpose_item((bj ? w3 : w1) + (size_t)e * D * dff, dff, D, W13T + (size_t)e * 2 * dff * D, n0, 128 * pn + uu, kb, scr, C.lane); continue; } r -= I_C1;
        { const int nb = r % 32, kb = r / 32; transpose_item(w2 + (size_t)e * dff * D, D, dff, W2T + (size_t)e * D * dff, 32 * nb, 32 * nb, kb, scr, C.lane); }
    }
}

template <int MODE, int SK>
__device__ __forceinline__ void ln_phase(Ctx& C, const float* src, const float* gam, const float* bet, float* dst_f32, int lsk) {
    LAS float* rows = (LAS float*)(C.lds + C.wave * 16384);
    float* HF = (float*)(C.ws + WS_HF32); bf16* HB = (bf16*)(C.ws + WS_HBF);
    const float* Y = (const float*)(C.ws + B_Y); const float* YE = (const float*)(C.ws + B_YE);
    const unsigned* route = (const unsigned*)(C.ws + WS_ROUTE);
    unsigned* gcnt = (unsigned*)(C.ws + WS_CTL) + CW_CNT + 64 * (lsk >> 1);
    const int lane = C.lane;
    f32x4 gv[4], bv[4];
#pragma unroll
    for (int j = 0; j < 4; ++j) { gv[j] = *(const f32x4*)(gam + 4 * lane + 256 * j); bv[j] = *(const f32x4*)(bet + 4 * lane + 256 * j); }
    for (int it = C.blk; it < T / 32; it += C.G) {
        const int row0 = it * 32 + C.wave * 4;
        if (SK == 2) { if (C.tid < 8) C.misc[C.tid] = 0u; __syncthreads(); }
#pragma unroll
        for (int r = 0; r < 4; ++r) {
            const int row = row0 + r;
            f32x4 v[4];
            if (MODE == 0) {
#pragma unroll
                for (int j = 0; j < 4; ++j) v[j] = *(const f32x4*)(src + (size_t)row * D + 4 * lane + 256 * j);
            } else {
                float g0 = 0.f, g1 = 0.f; size_t o0 = (size_t)row * D, o1 = 0;
                if (MODE == 3) { const unsigned* rt = route + (size_t)row * 8; o0 = (size_t)rt[6] * D; o1 = (size_t)rt[7] * D; g0 = __builtin_bit_cast(float, rt[4]); g1 = __builtin_bit_cast(float, rt[5]); }
#pragma unroll
                for (int j = 0; j < 4; ++j) {
                    const f32x4 h = *(const f32x4*)(HF + (size_t)row * D + 4 * lane + 256 * j);
                    f32x4 a;
                    if (MODE == 1) a = *(const f32x4*)(Y + (size_t)row * D + 4 * lane + 256 * j);
                    else if (MODE == 2) a = *(const f32x4*)(YE + (size_t)row * D + 4 * lane + 256 * j);
                    else a = g0 * *(const f32x4*)(YE + o0 + 4 * lane + 256 * j) + g1 * *(const f32x4*)(YE + o1 + 4 * lane + 256 * j);
                    v[j] = ALPHA * h + a;
                }
            }
            float s = 0.f;
#pragma unroll
            for (int j = 0; j < 4; ++j) s += (v[j].x + v[j].y) + (v[j].z + v[j].w);
            const float mean = wave_sum(s) * (1.f / D); float s2 = 0.f;
#pragma unroll
            for (int j = 0; j < 4; ++j) { v[j] = v[j] - mean; s2 += (v[j].x * v[j].x + v[j].y * v[j].y) + (v[j].z * v[j].z + v[j].w * v[j].w); }
            const float rstd = 1.f / sqrtf(wave_sum(s2) * (1.f / D) + LN_EPS);
#pragma unroll
            for (int j = 0; j < 4; ++j) {
                const f32x4 o = v[j] * rstd * gv[j] + bv[j];
                *(f32x4*)(dst_f32 + (size_t)row * D + 4 * lane + 256 * j) = o;
                u32x2 w; w.x = pk2(o.x, o.y); w.y = pk2(o.z, o.w);
                *(u32x2*)(HB + (size_t)row * D + 4 * lane + 256 * j) = w;
                if (SK != 0) *(LAS f32x4*)(rows + r * 1024 + 4 * lane + 256 * j) = o;
            }
        }
        if (SK != 0) {
            LDS_WAIT(); asm volatile("" ::: "memory");
            const int NC = (SK == 1) ? NGATE : NEXP;
            const float* W; size_t ldw;
            if (SK == 1) { W = C.in[3] + (size_t)lsk * D * DPROJ + (lane < 32 ? 2560 + lane : 7200 + (lane - 32)); ldw = DPROJ; }
            else { W = C.in[25] + (size_t)(lsk >> 1) * D * NEXP + lane; ldw = NEXP; }
            float a0 = 0.f, a1 = 0.f, a2 = 0.f, a3 = 0.f;
            if (lane < NC) {
#pragma unroll 2
                for (int k = 0; k < D; k += 4) {
                    const float w0 = W[(size_t)(k + 0) * ldw], w1 = W[(size_t)(k + 1) * ldw], w2 = W[(size_t)(k + 2) * ldw], w3 = W[(size_t)(k + 3) * ldw];
                    const f32x4 h0 = *(const LAS f32x4*)(rows + 0 * 1024 + k), h1 = *(const LAS f32x4*)(rows + 1 * 1024 + k), h2 = *(const LAS f32x4*)(rows + 2 * 1024 + k), h3 = *(const LAS f32x4*)(rows + 3 * 1024 + k);
                    a0 += h0.x * w0 + h0.y * w1 + h0.z * w2 + h0.w * w3;
                    a1 += h1.x * w0 + h1.y * w1 + h1.z * w2 + h1.w * w3;
                    a2 += h2.x * w0 + h2.y * w1 + h2.z * w2 + h2.w * w3;
                    a3 += h3.x * w0 + h3.y * w1 + h3.z * w2 + h3.w * w3;
                }
            }
            if (SK == 1) {
                float* Gt = (float*)(C.ws + WS_GATES);
                if (lane < NGATE) { Gt[(size_t)(row0 + 0) * NGATE + lane] = a0; Gt[(size_t)(row0 + 1) * NGATE + lane] = a1; Gt[(size_t)(row0 + 2) * NGATE + lane] = a2; Gt[(size_t)(row0 + 3) * NGATE + lane] = a3; }
            } else {
                float lg[4][8];
#pragma unroll
                for (int c = 0; c < 8; ++c) { lg[0][c] = __shfl(a0, c); lg[1][c] = __shfl(a1, c); lg[2][c] = __shfl(a2, c); lg[3][c] = __shfl(a3, c); }
                float my[8];
#pragma unroll
                for (int c = 0; c < 8; ++c) my[c] = (lane == 0) ? lg[0][c] : (lane == 1) ? lg[1][c] : (lane == 2) ? lg[2][c] : lg[3][c];
                int e0 = 0; float v0 = my[0];
#pragma unroll
                for (int c = 1; c < 8; ++c) if (my[c] > v0) { v0 = my[c]; e0 = c; }
                int e1 = -1; float v1 = -3.0e38f;
#pragma unroll
                for (int c = 0; c < 8; ++c) if (c != e0 && my[c] > v1) { v1 = my[c]; e1 = c; }
                const float g0 = 1.0f / (1.0f + __expf(v1 - v0)), g1 = 1.0f - g0;
                unsigned lr0 = 0, lr1 = 0;
                if (lane < 4) { lr0 = atomicAdd((unsigned*)(C.misc + e0), 1u); lr1 = atomicAdd((unsigned*)(C.misc + e1), 1u); }
                __syncthreads();
                if (C.tid < 8) C.misc[16 + C.tid] = atomicAdd(gcnt + C.tid, (unsigned)C.misc[C.tid]);
                __syncthreads();
                if (lane < 4) { unsigned* rt = (unsigned*)(C.ws + WS_ROUTE) + (size_t)(row0 + lane) * 8;
                    rt[0] = (unsigned)e0; rt[1] = (unsigned)e1; rt[2] = C.misc[16 + e0] + lr0; rt[3] = C.misc[16 + e1] + lr1; rt[4] = __builtin_bit_cast(unsigned, g0); rt[5] = __builtin_bit_cast(unsigned, g1); }
                __syncthreads();
            }
        }
    }
}

__device__ __forceinline__ int moe_cum_table(Ctx& C, int lm, bool moe) {
    if (C.tid == 0) {
        const unsigned* gcnt = (const unsigned*)(C.ws + WS_CTL) + CW_CNT + 64 * lm; int acc = 0;
        for (int e = 0; e < 8; ++e) { const int nb = moe ? (int)((__hip_atomic_load(gcnt + e, __ATOMIC_RELAXED, __HIP_MEMORY_SCOPE_AGENT) + 255u) >> 8) : (e == 0 ? T / 256 : 0); acc += nb; C.misc[e] = (unsigned)acc; }
    }
    __syncthreads();
    return (int)C.misc[7];
}
__device__ __forceinline__ void moe_dispatch(Ctx& C, int lm) {
    moe_cum_table(C, lm, true);
    unsigned* route = (unsigned*)(C.ws + WS_ROUTE); const bf16* HB = (const bf16*)(C.ws + WS_HBF); bf16* XS = (bf16*)(C.ws + B_XS);
    const int gw = C.blk * NWAVES + C.wave, NGW = C.G * NWAVES;
    for (int t = gw; t < T; t += NGW) {
        unsigned* rt = route + (size_t)t * 8;
        const unsigned e0 = rt[0], e1 = rt[1];
        const unsigned d0 = (e0 ? C.misc[e0 - 1] : 0u) * 256u + rt[2], d1 = (e1 ? C.misc[e1 - 1] : 0u) * 256u + rt[3];
        if (C.lane == 0) { rt[6] = d0; rt[7] = d1; }
        const u32x4* s = (const u32x4*)(HB + (size_t)t * D); u32x4* p0 = (u32x4*)(XS + (size_t)d0 * D); u32x4* p1 = (u32x4*)(XS + (size_t)d1 * D);
        const u32x4 a = s[C.lane], b = s[C.lane + 64];
        p0[C.lane] = a; p0[C.lane + 64] = b; p1[C.lane] = a; p1[C.lane + 64] = b;
    }
}

__device__ __forceinline__ void conv_phase(Ctx& C, int l) {
    const bf16* XR = (const bf16*)(C.ws + B_XBCR); const bf16* QR = (const bf16*)(C.ws + B_MQKR); bf16* XC = (bf16*)(C.ws + B_XBCC); bf16* QC = (bf16*)(C.ws + B_MQKC);
    const float* cw1 = C.in[4] + (size_t)l * 5 * 1536; const float* cb1 = C.in[5] + (size_t)l * 1536;
    const float* cw2 = C.in[12] + (size_t)l * 5 * 1024; const float* cb2 = C.in[13] + (size_t)l * 1024;
    const size_t NIT = (size_t)T * 320;
    for (size_t it = (size_t)C.blk * NTHR + C.tid; it < NIT; it += (size_t)C.G * NTHR) {
        const int tok = (int)(it / 320), gi = (int)(it % 320); const int t = tok & (SEQ - 1);
        const bool second = gi >= 192; const int c0 = second ? (gi - 192) * 8 : gi * 8; const int ld = second ? 1024 : 1536;
        const bf16* src = second ? QR : XR; const float* cw = second ? cw2 : cw1; const float* cb = second ? cb2 : cb1;
        float acc[8];
#pragma unroll
        for (int j = 0; j < 8; ++j) acc[j] = cb[c0 + j];
#pragma unroll
        for (int k = 0; k < 5; ++k) {
            const int tt = t + k - 2;
            if (tt >= 0 && tt < SEQ) {
                const u32x4 x = *(const u32x4*)(src + (size_t)(tok + k - 2) * ld + c0);
                const f32x4 wa = *(const f32x4*)(cw + (size_t)k * ld + c0), wb = *(const f32x4*)(cw + (size_t)k * ld + c0 + 4);
                acc[0] += bflo(x.x) * wa.x; acc[1] += bfhi(x.x) * wa.y; acc[2] += bflo(x.y) * wa.z; acc[3] += bfhi(x.y) * wa.w;
                acc[4] += bflo(x.z) * wb.x; acc[5] += bfhi(x.z) * wb.y; acc[6] += bflo(x.w) * wb.z; acc[7] += bfhi(x.w) * wb.w;
            }
        }
        u32x4 o; o.x = pk2(siluf_(acc[0]), siluf_(acc[1])); o.y = pk2(siluf_(acc[2]), siluf_(acc[3])); o.z = pk2(siluf_(acc[4]), siluf_(acc[5])); o.w = pk2(siluf_(acc[6]), siluf_(acc[7]));
        *(u32x4*)((second ? QC : XC) + (size_t)tok * ld + c0) = o;
    }
    u32x4* z = (u32x4*)(C.ws + B_YBUF); const size_t NZ = (FAST_SSD && FAST_HG && FAST_ML) ? 0 : (size_t)160 * MiB / 16;
    for (size_t i = (size_t)C.blk * NTHR + C.tid; i < NZ; i += (size_t)C.G * NTHR) z[i] = (u32x4){0u, 0u, 0u, 0u};
}

__device__ __forceinline__ void naive_mixers(Ctx& C, int l) {
    const float* Gt = (const float*)(C.ws + WS_GATES);
    const bf16* XC = (const bf16*)(C.ws + B_XBCC); const bf16* QC = (const bf16*)(C.ws + B_MQKC);
    const bf16* HQ = (const bf16*)(C.ws + B_HQ); const bf16* HFR = (const bf16*)(C.ws + B_HFR); const bf16* HI = (const bf16*)(C.ws + B_HI); const bf16* MV = (const bf16*)(C.ws + B_MV);
    float* YB = (float*)(C.ws + B_YBUF); float* OB = (float*)(C.ws + B_OBUF); float* HBf = (float*)(C.ws + B_HBUF);
    const int tid = C.tid;
    for (int u = C.blk; u < 96; u += C.G) {
        if ((u < 64 && FAST_SSD) || (u >= 64 && u < 80 && FAST_HG) || (u >= 80 && FAST_ML)) continue;
        if (u < 64) {
            const int b = u >> 5, dir = (u >> 4) & 1, h = u & 15, g = h >> 3;
            const int p = tid >> 3, nq = tid & 7;
            const float dtb = C.in[6][(l * 2 + dir) * 16 + h], Aneg = -__expf(C.in[7][(l * 2 + dir) * 16 + h]);
            float st[16];
#pragma unroll
            for (int i = 0; i < 16; ++i) st[i] = 0.f;
            for (int s = 0; s < SEQ; ++s) {
                const int t = dir ? (SEQ - 1 - s) : s; const size_t tok = (size_t)b * SEQ + t;
                const float dt = softplusf_(Gt[tok * NGATE + dir * 16 + h] + dtb), dec = __expf(dt * Aneg);
                const float xv = dt * bf2f(XC[tok * 1536 + h * 64 + p]);
                const u32x4 b0 = *(const u32x4*)(XC + tok * 1536 + 1024 + g * 128 + nq * 16), b1 = *(const u32x4*)(XC + tok * 1536 + 1024 + g * 128 + nq * 16 + 8);
                const u32x4 c0 = *(const u32x4*)(XC + tok * 1536 + 1280 + g * 128 + nq * 16), c1 = *(const u32x4*)(XC + tok * 1536 + 1280 + g * 128 + nq * 16 + 8);
                const unsigned bw[8] = {b0.x, b0.y, b0.z, b0.w, b1.x, b1.y, b1.z, b1.w}, cwv[8] = {c0.x, c0.y, c0.z, c0.w, c1.x, c1.y, c1.z, c1.w};
                float y = 0.f;
#pragma unroll
                for (int i = 0; i < 8; ++i) {
                    st[2 * i] = st[2 * i] * dec + xv * bflo(bw[i]); st[2 * i + 1] = st[2 * i + 1] * dec + xv * bfhi(bw[i]);
                    y += st[2 * i] * bflo(cwv[i]) + st[2 * i + 1] * bfhi(cwv[i]);
                }
                y += __shfl_xor(y, 1); y += __shfl_xor(y, 2); y += __shfl_xor(y, 4);
                if (nq == 0) atomicAdd(YB + tok * 1024 + h * 64 + p, y);
            }
        } else if (u < 80) {
            const int uu = u - 64, b = uu >> 3, dir = (uu >> 2) & 1, hd = uu & 3;
            const int v = tid >> 2, kq = tid & 3;
            float st[32], oml[32];
#pragma unroll
            for (int i = 0; i < 32; ++i) {
                const int ch = hd * 128 + kq * 32 + i;
                const float x0 = C.in[10][0 * 512 + ch], x1 = C.in[10][1 * 512 + ch], x2 = C.in[10][2 * 512 + ch], x3 = C.in[10][3 * 512 + ch];
                const float mx = fmaxf(fmaxf(x0, x1), fmaxf(x2, x3)); const float e0 = __expf(x0 - mx), e1 = __expf(x1 - mx), e2 = __expf(x2 - mx), e3 = __expf(x3 - mx); const float inv = 1.0f / (e0 + e1 + e2 + e3);
                float lb = 0.f; if (l >= 1) lb += e1 * inv; if (l >= 2) lb += e2 * inv; if (l >= 3) lb += e3 * inv;
                oml[i] = 1.0f - lb; st[i] = 0.f;
            }
            for (int s = 0; s < SEQ; ++s) {
                const int t = dir ? (SEQ - 1 - s) : s; const size_t tok = (size_t)b * SEQ + t;
                const float vv = bf2f(HI[tok * 512 + hd * 128 + v]);
                float o = 0.f;
#pragma unroll
                for (int c4 = 0; c4 < 4; ++c4) {
                    const u32x4 fw = *(const u32x4*)(HFR + tok * 1024 + dir * 512 + hd * 128 + kq * 32 + c4 * 8);
                    const u32x4 qw = *(const u32x4*)(HQ + tok * 512 + hd * 128 + kq * 32 + c4 * 8);
                    const unsigned fa[4] = {fw.x, fw.y, fw.z, fw.w}, qa[4] = {qw.x, qw.y, qw.z, qw.w};
#pragma unroll
                    for (int i = 0; i < 4; ++i) {
                        const int k0 = c4 * 8 + 2 * i;
                        const float key0 = oml[k0] * sigmoidf_(-bflo(fa[i])), key1 = oml[k0 + 1] * sigmoidf_(-bfhi(fa[i]));
                        st[k0] = (1.0f - key0) * st[k0] + key0 * vv; st[k0 + 1] = (1.0f - key1) * st[k0 + 1] + key1 * vv;
                        o += siluf_(bflo(qa[i])) * st[k0] + siluf_(bfhi(qa[i])) * st[k0 + 1];
                    }
                }
                o += __shfl_xor(o, 1); o += __shfl_xor(o, 2);
                if (kq == 0) atomicAdd(OB + tok * 512 + hd * 128 + v, o);
            }
        } else {
            const int uu = u - 80, b = uu >> 3, dir = (uu >> 2) & 1, hd = uu & 3;
            const int v = tid >> 2, kq = tid & 3;
            const float igb = C.in[14][(l * 2 + dir) * 4 + hd], fgb = C.in[15][(l * 2 + dir) * 4 + hd];
            float cs[32], ns[32];
#pragma unroll
            for (int i = 0; i < 32; ++i) { cs[i] = 0.f; ns[i] = 0.f; }
            for (int s = 0; s < SEQ; ++s) {
                const int t = dir ? (SEQ - 1 - s) : s; const size_t tok = (size_t)b * SEQ + t;
                const float ei = __expf(Gt[tok * NGATE + 32 + dir * 4 + hd] + igb);
                const float f = __expf(-softplusf_(-(Gt[tok * NGATE + 40 + dir * 4 + hd] + fgb)));
                const float vv = bf2f(MV[tok * 512 + hd * 128 + v]);
                float num = 0.f, den = 0.f;
#pragma unroll
                for (int c4 = 0; c4 < 4; ++c4) {
                    const u32x4 qw = *(const u32x4*)(QC + tok * 1024 + hd * 128 + kq * 32 + c4 * 8);
                    const u32x4 kw = *(const u32x4*)(QC + tok * 1024 + 512 + hd * 128 + kq * 32 + c4 * 8);
                    const unsigned qa[4] = {qw.x, qw.y, qw.z, qw.w}, ka[4] = {kw.x, kw.y, kw.z, kw.w};
#pragma unroll
                    for (int i = 0; i < 4; ++i) {
                        const int k0 = c4 * 8 + 2 * i;
                        const float ka0 = ei * bflo(ka[i]), ka1 = ei * bfhi(ka[i]);
                        cs[k0] = f * cs[k0] + ka0 * vv; cs[k0 + 1] = f * cs[k0 + 1] + ka1 * vv;
                        ns[k0] = f * ns[k0] + ka0; ns[k0 + 1] = f * ns[k0 + 1] + ka1;
                        const float q0 = bflo(qa[i]) * 0.08838834764831845f, q1 = bfhi(qa[i]) * 0.08838834764831845f;
                        num += q0 * cs[k0] + q1 * cs[k0 + 1]; den += q0 * ns[k0] + q1 * ns[k0 + 1];
                    }
                }
                num += __shfl_xor(num, 1); num += __shfl_xor(num, 2); den += __shfl_xor(den, 1); den += __shfl_xor(den, 2);
                if (kq == 0) atomicAdd(HBf + tok * 512 + hd * 128 + v, num / fmaxf(fabsf(den), 1.0f));
            }
        }
    }
}
__device__ __forceinline__ void naive_combine(Ctx& C, int l) {
    const float* YB = (const float*)(C.ws + B_YBUF); const float* OB = (const float*)(C.ws + B_OBUF); const float* HBf = (const float*)(C.ws + B_HBUF);
    const bf16* XC = (const bf16*)(C.ws + B_XBCC); const bf16* Z = (const bf16*)(C.ws + B_Z); const bf16* HG = (const bf16*)(C.ws + B_HG); const bf16* MO = (const bf16*)(C.ws + B_MO);
    bf16* MIX = (bf16*)(C.ws + B_MIX);
    const float* dsk = C.in[8] + l * 16; const float* nw1 = C.in[9] + l * 1024; const float* nw2 = C.in[11] + l * 512; const float* nw3 = C.in[16] + l * 512;
    const int gw = C.blk * NWAVES + C.wave, NGW = C.G * NWAVES, lane = C.lane;
    for (int tok = gw; tok < T; tok += NGW) {
        if (!FAST_SSD) { float y[16]; float ss = 0.f; const int c0 = 16 * lane; const float dk = dsk[c0 >> 6];
#pragma unroll
          for (int j = 0; j < 16; ++j) { const float x = bf2f(XC[(size_t)tok * 1536 + c0 + j]); const float z = bf2f(Z[(size_t)tok * 1024 + c0 + j]);
              y[j] = (YB[(size_t)tok * 1024 + c0 + j] + x * dk) * siluf_(z); ss += y[j] * y[j]; }
#pragma unroll
          for (int o = 1; o < 32; o <<= 1) ss += __shfl_xor(ss, o);
          const float r = 1.0f / sqrtf(ss * (1.f / 512.f) + RMS_EPS);
#pragma unroll
          for (int j = 0; j < 16; ++j) MIX[(size_t)tok * 2048 + c0 + j] = (bf16)f2bf(y[j] * r * nw1[c0 + j]); }
        if (!FAST_HG) { float o[8]; float ss = 0.f; const int c0 = 8 * lane;
#pragma unroll
          for (int j = 0; j < 8; ++j) { o[j] = OB[(size_t)tok * 512 + c0 + j]; ss += o[j] * o[j]; }
#pragma unroll
          for (int q = 1; q < 16; q <<= 1) ss += __shfl_xor(ss, q);
          const float r = 1.0f / sqrtf(ss * (1.f / 128.f) + RMS_EPS);
#pragma unroll
          for (int j = 0; j < 8; ++j) MIX[(size_t)tok * 2048 + 1024 + c0 + j] = (bf16)f2bf(o[j] * r * nw2[c0 + j] * siluf_(bf2f(HG[(size_t)tok * 512 + c0 + j]))); }
        if (!FAST_ML) { float o[8]; float s = 0.f; const int c0 = 8 * lane;
#pragma unroll
          for (int j = 0; j < 8; ++j) { o[j] = HBf[(size_t)tok * 512 + c0 + j]; s += o[j]; }
#pragma unroll
          for (int q = 1; q < 16; q <<= 1) s += __shfl_xor(s, q);
          const float mean = s * (1.f / 128.f); float ss = 0.f;
#pragma unroll
          for (int j = 0; j < 8; ++j) { o[j] -= mean; ss += o[j] * o[j]; }
#pragma unroll
          for (int q = 1; q < 16; q <<= 1) ss += __shfl_xor(ss, q);
          const float r = 1.0f / sqrtf(ss * (1.f / 128.f) + LN_EPS);
#pragma unroll
          for (int j = 0; j < 8; ++j) MIX[(size_t)tok * 2048 + 1536 + c0 + j] = (bf16)f2bf(o[j] * r * nw3[c0 + j] * sigmoidf_(bf2f(MO[(size_t)tok * 512 + c0 + j]))); }
    }
}


#define MFMA16(a, b, c) __builtin_amdgcn_mfma_f32_16x16x32_bf16((a), (b), (c), 0, 0, 0)
typedef short s16x4 __attribute__((ext_vector_type(4)));
__device__ __forceinline__ unsigned lds_addr(const LAS unsigned char* p) { return (unsigned)(size_t)p; }
__device__ __forceinline__ bf16x8 frag_row(const LAS unsigned char* img, int stride, int row, int kel) { return *(const LAS bf16x8*)(img + row * stride + kel * 2); }
__device__ __forceinline__ bf16x8 tr2(unsigned a0, unsigned a1) {
    s16x4 lo, hi;
    asm volatile("ds_read_b64_tr_b16 %0, %2\n\tds_read_b64_tr_b16 %1, %3\n\ts_waitcnt lgkmcnt(0)" : "=&v"(lo), "=&v"(hi) : "v"(a0), "v"(a1) : "memory");
    return __builtin_shufflevector(lo, hi, 0, 1, 2, 3, 4, 5, 6, 7);
}
__device__ __forceinline__ bf16x8 frag_tr(unsigned img, int stride, int k0, int n0, int r, int q) { const unsigned a = img + (k0 + 8 * q + (r >> 2)) * stride + (n0 + 4 * (r & 3)) * 2; return tr2(a, a + 4 * stride); }
__device__ __forceinline__ bf16x8 frag_tr_acc(unsigned img, int stride, int k0, int n0, int r, int q) { const unsigned a = img + (k0 + 4 * q + (r >> 2)) * stride + (n0 + 4 * (r & 3)) * 2; return tr2(a, a + 16 * stride); }
__device__ __forceinline__ bf16x8 pack8(const float (&v)[8]) { u32x4 w; w.x = pk2(v[0], v[1]); w.y = pk2(v[2], v[3]); w.z = pk2(v[4], v[5]); w.w = pk2(v[6], v[7]); return __builtin_bit_cast(bf16x8, w); }
__device__ __forceinline__ void unpack8(const bf16x8 f, float (&v)[8]) { const u32x4 w = __builtin_bit_cast(u32x4, f); v[0] = bflo(w.x); v[1] = bfhi(w.x); v[2] = bflo(w.y); v[3] = bfhi(w.y); v[4] = bflo(w.z); v[5] = bfhi(w.z); v[6] = bflo(w.w); v[7] = bfhi(w.w); }
__device__ __forceinline__ u32x2 pack4(const f32x4 v) { u32x2 w; w.x = pk2(v[0], v[1]); w.y = pk2(v[2], v[3]); return w; }
__device__ __forceinline__ void load_tile(LAS unsigned char* img, int stride, const bf16* src, size_t ld, int rows, int cols, int tid) {
    const int cpr = cols >> 3, n = rows * cpr;
    for (int i = tid; i < n; i += NTHR) { const int row = i / cpr, ch = i - row * cpr; *(LAS u32x4*)(img + row * stride + ch * 16) = *(const u32x4*)(src + (size_t)row * ld + ch * 8); }
}
__device__ __forceinline__ void scan128(float a0, float a1, int lane, float& i0, float& i1, float& tot) {
    float s = a0 + a1;
#pragma unroll
    for (int o = 1; o < 64; o <<= 1) { const float t = __shfl_up(s, o); if (lane >= o) s += t; }
    i1 = s; i0 = s - a1; tot = __shfl(s, 63);
}
__device__ __forceinline__ float hg_lb(const float* lbl, int l, int ch) {
    const float x0 = lbl[0 * 512 + ch], x1 = lbl[1 * 512 + ch], x2 = lbl[2 * 512 + ch], x3 = lbl[3 * 512 + ch];
    const float mx = fmaxf(fmaxf(x0, x1), fmaxf(x2, x3)); const float e0 = __expf(x0 - mx), e1 = __expf(x1 - mx), e2 = __expf(x2 - mx), e3 = __expf(x3 - mx); const float inv = 1.0f / (e0 + e1 + e2 + e3);
    float lb = 0.f; if (l >= 1) lb += e1 * inv; if (l >= 2) lb += e2 * inv; if (l >= 3) lb += e3 * inv; return lb;
}

#define UNIT_PROLOG() Ctx C = C0_; { int ln_; asm volatile("v_mbcnt_lo_u32_b32 %0, -1, 0\n\tv_mbcnt_hi_u32_b32 %0, -1, %0" : "=v"(ln_)); C.lane = ln_; C.tid = C.wave * 64 + ln_; C.ws = (unsigned char*)C0_.in[30]; }
__device__ __forceinline__ void ssdC_unit(Ctx& C0_, int l, int u) { UNIT_PROLOG();
    const int half = u & 1, g = (u >> 1) & 1, c = (u >> 2) & 63, b = u >> 8;
    const int tid = C.tid, lane = C.lane, w = C.wave, r = lane & 15, q = lane >> 4;
    const size_t tok0 = (size_t)b * SEQ + c * 128;
    LAS unsigned char* Bimg = C.lds; LAS unsigned char* Ximg = C.lds + 34816; LAS float* wv = (LAS float*)(C.lds + 102400);
    const bf16* XC = (const bf16*)(C.ws + B_XBCC);
    load_tile(Bimg, 272, XC + tok0 * 1536 + 1024 + g * 128, 1536, 128, 128, tid);
    load_tile(Ximg, 528, XC + tok0 * 1536 + (g * 8 + half * 4) * 64, 1536, 128, 256, tid);
    {
        const int hh = w >> 1, dir = w & 1, h = g * 8 + half * 4 + hh;
        const float dtb = C.in[6][(l * 2 + dir) * 16 + h], Aneg = -__expf(C.in[7][(l * 2 + dir) * 16 + h]);
        const float* Gt = (const float*)(C.ws + WS_GATES);
        const float d0 = softplusf_(Gt[(tok0 + 2 * lane) * NGATE + dir * 16 + h] + dtb), d1 = softplusf_(Gt[(tok0 + 2 * lane + 1) * NGATE + dir * 16 + h] + dtb);
        const float a0 = d0 * Aneg, a1 = d1 * Aneg; float i0, i1, tot; scan128(a0, a1, lane, i0, i1, tot);
        const float c0 = dir ? tot - i0 + a0 : i0, c1 = dir ? tot - i1 + a1 : i1;
        wv[w * 128 + 2 * lane] = d0 * __expf(tot - c0); wv[w * 128 + 2 * lane + 1] = d1 * __expf(tot - c1);
        if (lane == 0) ((float*)(C.ws + B_DECS))[((b * 64 + c) * 2 + dir) * 16 + h] = __expf(tot);
    }
    __syncthreads();
    const unsigned bimg = lds_addr(Bimg), ximg = lds_addr(Ximg);
    bf16x8 bfr[4];
#pragma unroll
    for (int ks = 0; ks < 4; ++ks) bfr[ks] = frag_tr(bimg, 272, 32 * ks, 16 * w, r, q);
    bf16* ST = (bf16*)(C.ws + B_STS);
#pragma unroll 1
    for (int hh = 0; hh < 4; ++hh) {
        const int h = g * 8 + half * 4 + hh;
        f32x4 acc[2][4];
#pragma unroll
        for (int d = 0; d < 2; ++d)
#pragma unroll
            for (int pt = 0; pt < 4; ++pt) acc[d][pt] = (f32x4){0.f, 0.f, 0.f, 0.f};
#pragma unroll
        for (int ks = 0; ks < 4; ++ks) {
            bf16x8 xf[4];
#pragma unroll
            for (int pt = 0; pt < 4; ++pt) xf[pt] = frag_tr(ximg, 528, 32 * ks, hh * 64 + 16 * pt, r, q);
            float bv[8]; unpack8(bfr[ks], bv);
#pragma unroll
            for (int d = 0; d < 2; ++d) {
                const f32x4 w0 = *(const LAS f32x4*)(wv + (hh * 2 + d) * 128 + 32 * ks + 8 * q), w1 = *(const LAS f32x4*)(wv + (hh * 2 + d) * 128 + 32 * ks + 8 * q + 4);
                float sv[8] = {bv[0] * w0.x, bv[1] * w0.y, bv[2] * w0.z, bv[3] * w0.w, bv[4] * w1.x, bv[5] * w1.y, bv[6] * w1.z, bv[7] * w1.w};
                const bf16x8 bs = pack8(sv);
#pragma unroll
                for (int pt = 0; pt < 4; ++pt) acc[d][pt] = MFMA16(bs, xf[pt], acc[d][pt]);
            }
        }
#pragma unroll
        for (int d = 0; d < 2; ++d)
#pragma unroll
            for (int pt = 0; pt < 4; ++pt)
                *(u32x2*)(ST + ((size_t)(((b * 64 + c) * 2 + d) * 16 + h) * 64 + 16 * pt + r) * 128 + 16 * w + 4 * q) = pack4(acc[d][pt]);
    }
    __syncthreads();
}
__device__ __forceinline__ void mlC_unit(Ctx& C0_, int l, int u) { UNIT_PROLOG();
    const int hd = u & 3, c = (u >> 2) & 63, b = u >> 8;
    const int tid = C.tid, lane = C.lane, w = C.wave, r = lane & 15, q = lane >> 4;
    const size_t tok0 = (size_t)b * SEQ + c * 128;
    LAS unsigned char* Kimg = C.lds; LAS unsigned char* Vimg = C.lds + 34816; LAS float* wv = (LAS float*)(C.lds + 69632);
    load_tile(Kimg, 272, (const bf16*)(C.ws + B_MQKC) + tok0 * 1024 + 512 + hd * 128, 1024, 128, 128, tid);
    load_tile(Vimg, 272, (const bf16*)(C.ws + B_MV) + tok0 * 512 + hd * 128, 512, 128, 128, tid);
    if (w < 2) {
        const int dir = w; const float igb = C.in[14][(l * 2 + dir) * 4 + hd], fgb = C.in[15][(l * 2 + dir) * 4 + hd];
        const float* Gt = (const float*)(C.ws + WS_GATES);
        const float f0 = -softplusf_(-(Gt[(tok0 + 2 * lane) * NGATE + 40 + dir * 4 + hd] + fgb)), f1 = -softplusf_(-(Gt[(tok0 + 2 * lane + 1) * NGATE + 40 + dir * 4 + hd] + fgb));
        const float li0 = Gt[(tok0 + 2 * lane) * NGATE + 32 + dir * 4 + hd] + igb, li1 = Gt[(tok0 + 2 * lane + 1) * NGATE + 32 + dir * 4 + hd] + igb;
        float i0, i1, tot; scan128(f0, f1, lane, i0, i1, tot);
        const float c0 = dir ? tot - i0 + f0 : i0, c1 = dir ? tot - i1 + f1 : i1;
        wv[dir * 128 + 2 * lane] = __expf(tot - c0 + li0); wv[dir * 128 + 2 * lane + 1] = __expf(tot - c1 + li1);
        if (lane == 0) ((float*)(C.ws + B_DECM))[((b * 64 + c) * 2 + dir) * 4 + hd] = __expf(tot);
    }
    __syncthreads();
    const unsigned kimg = lds_addr(Kimg), vimg = lds_addr(Vimg);
    bf16* ST = (bf16*)(C.ws + B_STM); float* NM = (float*)(C.ws + B_NM);
#pragma unroll 1
    for (int d = 0; d < 2; ++d) {
        f32x4 acc[8]; float nacc[8];
#pragma unroll
        for (int kt = 0; kt < 8; ++kt) { acc[kt] = (f32x4){0.f, 0.f, 0.f, 0.f}; nacc[kt] = 0.f; }
#pragma unroll 1
        for (int ks = 0; ks < 4; ++ks) {
            const f32x4 w0 = *(const LAS f32x4*)(wv + d * 128 + 32 * ks + 8 * q), w1 = *(const LAS f32x4*)(wv + d * 128 + 32 * ks + 8 * q + 4);
            const bf16x8 vf = frag_tr(vimg, 272, 32 * ks, 16 * w, r, q);
#pragma unroll
            for (int kt = 0; kt < 8; ++kt) {
                float kv[8]; unpack8(frag_tr(kimg, 272, 32 * ks, 16 * kt, r, q), kv);
                float sv[8] = {kv[0] * w0.x, kv[1] * w0.y, kv[2] * w0.z, kv[3] * w0.w, kv[4] * w1.x, kv[5] * w1.y, kv[6] * w1.z, kv[7] * w1.w};
                nacc[kt] += ((sv[0] + sv[1]) + (sv[2] + sv[3])) + ((sv[4] + sv[5]) + (sv[6] + sv[7]));
                acc[kt] = MFMA16(pack8(sv), vf, acc[kt]);
            }
        }
        const size_t sb = (size_t)(((b * 64 + c) * 2 + d) * 4 + hd);
#pragma unroll
        for (int kt = 0; kt < 8; ++kt) {
            *(u32x2*)(ST + (sb * 128 + 16 * w + r) * 128 + 16 * kt + 4 * q) = pack4(acc[kt]);
            float n = nacc[kt]; n += __shfl_xor(n, 16); n += __shfl_xor(n, 32);
            if (w == 0 && q == 0) NM[sb * 128 + 16 * kt + r] = n;
        }
    }
    __syncthreads();
}
template <int MODE>
__device__ __forceinline__ float hg_gates(Ctx& C, int l, size_t tok0, int hd, int dir, LAS float* Gimg, LAS unsigned char* Kimg, LAS float* segtot) {
    const int k = C.tid & 127, seg = C.tid >> 7;
    const float oml = 1.0f - hg_lb(C.in[10], l, hd * 128 + k);
    const bf16* HFR = (const bf16*)(C.ws + B_HFR) + tok0 * 1024 + dir * 512 + hd * 128 + k;
    float run = 0.f;
#pragma unroll 4
    for (int i = 0; i < 16; ++i) {
        const int t = dir ? (seg * 16 + 15 - i) : (seg * 16 + i);
        const float key = oml * sigmoidf_(-bf2f(HFR[(size_t)t * 1024]));
        run += log1pf(-key); Gimg[t * 132 + k] = run; *(LAS bf16*)(Kimg + t * 272 + k * 2) = (bf16)f2bf(key);
    }
    segtot[seg * 128 + k] = run;
    __syncthreads();
    float off = 0.f, tot = 0.f;
#pragma unroll
    for (int s2 = 0; s2 < 4; ++s2) { const float v = segtot[s2 * 128 + k]; tot += v; if (dir ? (s2 > seg) : (s2 < seg)) off += v; }
#pragma unroll 4
    for (int i = 0; i < 16; ++i) {
        const int t = seg * 16 + i; const float gv = Gimg[t * 132 + k] + off; Gimg[t * 132 + k] = gv;
        if (MODE == 1) { const float key = bf2f(*(const LAS bf16*)(Kimg + t * 272 + k * 2)); *(LAS bf16*)(Kimg + t * 272 + k * 2) = (bf16)f2bf(key * __expf(tot - gv)); }
    }
    __syncthreads();
    return __expf(tot);
}
__device__ __forceinline__ void hgC_unit(Ctx& C0_, int l, int u) { UNIT_PROLOG();
    const int hd = u & 3, c = (u >> 2) & 127, b = u >> 9;
    const int tid = C.tid, lane = C.lane, w = C.wave, r = lane & 15, q = lane >> 4;
    const size_t tok0 = (size_t)b * SEQ + c * 64;
    LAS float* Gimg = (LAS float*)C.lds; LAS unsigned char* Kimg = C.lds + 33792; LAS unsigned char* Vimg = C.lds + 51200; LAS float* segtot = (LAS float*)(C.lds + 68608);
    load_tile(Vimg, 272, (const bf16*)(C.ws + B_HI) + tok0 * 512 + hd * 128, 512, 64, 128, tid);
    const unsigned kimg = lds_addr(Kimg), vimg = lds_addr(Vimg);
    bf16* ST = (bf16*)(C.ws + B_STH); float* DH = (float*)(C.ws + B_DECH);
#pragma unroll 1
    for (int d = 0; d < 2; ++d) {
        const float dec = hg_gates<1>(C, l, tok0, hd, d, Gimg, Kimg, segtot);
        const size_t sb = (size_t)(((b * 128 + c) * 2 + d) * 4 + hd);
        if (tid < 128) DH[sb * 128 + tid] = dec;
        f32x4 acc[8];
#pragma unroll
        for (int kt = 0; kt < 8; ++kt) acc[kt] = (f32x4){0.f, 0.f, 0.f, 0.f};
#pragma unroll
        for (int ks = 0; ks < 2; ++ks) {
            const bf16x8 vf = frag_tr(vimg, 272, 32 * ks, 16 * w, r, q);
#pragma unroll
            for (int kt = 0; kt < 8; ++kt) acc[kt] = MFMA16(frag_tr(kimg, 272, 32 * ks, 16 * kt, r, q), vf, acc[kt]);
        }
#pragma unroll
        for (int kt = 0; kt < 8; ++kt) *(u32x2*)(ST + (sb * 128 + 16 * w + r) * 128 + 16 * kt + 4 * q) = pack4(acc[kt]);
        __syncthreads();
    }
}
__device__ __forceinline__ void mixC_phase(Ctx& C, int l) {
    for (int u = C.blk; u < 2048; u += C.G) {
        if (u < 512) { if (FAST_SSD) ssdC_unit(C, l, u); }
        else if (u < 1024) { if (FAST_ML) mlC_unit(C, l, u - 512); }
        else { if (FAST_HG) hgC_unit(C, l, u - 1024); }
    }
}

template <int NCH, int DECMODE  >
__device__ __forceinline__ void scan_items(bf16* ST, const float* DEC, size_t base, size_t cstride, size_t dbase, size_t dstride, int dir) {
    float run[8];
#pragma unroll
    for (int j = 0; j < 8; ++j) run[j] = 0.f;
    u32x4 Lb[4]; f32x4 Da[4], Db[4];
#pragma unroll
    for (int j = 0; j < 4; ++j) { const int c = dir ? NCH - 1 - j : j; Lb[j] = *(const u32x4*)(ST + base + c * cstride);
        if (DECMODE == 0) { Da[j] = (f32x4){DEC[dbase + c * dstride], 0.f, 0.f, 0.f}; Db[j] = Da[j]; } else { Da[j] = *(const f32x4*)(DEC + dbase + c * dstride); Db[j] = *(const f32x4*)(DEC + dbase + c * dstride + 4); } }
#pragma unroll 1
    for (int st = 0; st < NCH; st += 4) {
#pragma unroll
        for (int j = 0; j < 4; ++j) {
            const int c = dir ? NCH - 1 - (st + j) : st + j;
            u32x4 o; o.x = pk2(run[0], run[1]); o.y = pk2(run[2], run[3]); o.z = pk2(run[4], run[5]); o.w = pk2(run[6], run[7]);
            const u32x4 L = Lb[j]; const f32x4 da = Da[j], db = Db[j];
            if (st + j + 4 < NCH) { const int c2 = dir ? NCH - 1 - (st + j + 4) : st + j + 4; Lb[j] = *(const u32x4*)(ST + base + c2 * cstride);
                if (DECMODE == 0) { Da[j] = (f32x4){DEC[dbase + c2 * dstride], 0.f, 0.f, 0.f}; Db[j] = Da[j]; } else { Da[j] = *(const f32x4*)(DEC + dbase + c2 * dstride); Db[j] = *(const f32x4*)(DEC + dbase + c2 * dstride + 4); } }
            *(u32x4*)(ST + base + c * cstride) = o;
            if (DECMODE == 0) { const float d = da.x;
                run[0] = run[0] * d + bflo(L.x); run[1] = run[1] * d + bfhi(L.x); run[2] = run[2] * d + bflo(L.y); run[3] = run[3] * d + bfhi(L.y);
                run[4] = run[4] * d + bflo(L.z); run[5] = run[5] * d + bfhi(L.z); run[6] = run[6] * d + bflo(L.w); run[7] = run[7] * d + bfhi(L.w);
            } else {
                run[0] = run[0] * da.x + bflo(L.x); run[1] = run[1] * da.y + bfhi(L.x); run[2] = run[2] * da.z + bflo(L.y); run[3] = run[3] * da.w + bfhi(L.y);
                run[4] = run[4] * db.x + bflo(L.z); run[5] = run[5] * db.y + bfhi(L.z); run[6] = run[6] * db.z + bflo(L.w); run[7] = run[7] * db.w + bfhi(L.w);
            }
        }
    }
}
__device__ __forceinline__ void scan_phase(Ctx& C) {
    const int NT = C.G * NTHR;
    for (int it = C.blk * NTHR + C.tid; it < 131072 + 2048; it += NT) {
        if (it < 65536) {
            if (!FAST_SSD) continue;
            const int seq = it >> 10, e8 = it & 1023, b = seq >> 5, dir = (seq >> 4) & 1, h = seq & 15;
            scan_items<64, 0>((bf16*)(C.ws + B_STS), (const float*)(C.ws + B_DECS), ((size_t)(b * 64 * 2 + dir) * 16 + h) * 8192 + e8 * 8, (size_t)2 * 16 * 8192, (size_t)(b * 64 * 2 + dir) * 16 + h, 32, dir);
        } else if (it < 98304) {
            if (!FAST_ML) continue;
            const int i2 = it - 65536, seq = i2 >> 11, e8 = i2 & 2047, b = seq >> 3, dir = (seq >> 2) & 1, hd = seq & 3;
            scan_items<64, 0>((bf16*)(C.ws + B_STM), (const float*)(C.ws + B_DECM), ((size_t)(b * 64 * 2 + dir) * 4 + hd) * 16384 + e8 * 8, (size_t)2 * 4 * 16384, (size_t)(b * 64 * 2 + dir) * 4 + hd, 8, dir);
        } else if (it < 131072) {
            if (!FAST_HG) continue;
            const int i2 = it - 98304, seq = i2 >> 11, e8 = i2 & 2047, b = seq >> 3, dir = (seq >> 2) & 1, hd = seq & 3;
            scan_items<128, 1>((bf16*)(C.ws + B_STH), (const float*)(C.ws + B_DECH), ((size_t)(b * 128 * 2 + dir) * 4 + hd) * 16384 + e8 * 8, (size_t)2 * 4 * 16384, ((size_t)(b * 128 * 2 + dir) * 4 + hd) * 128 + ((e8 * 8) & 127), (size_t)2 * 4 * 128, dir);
        } else {
            if (!FAST_ML) continue;
            const int i2 = it - 131072, seq = i2 >> 7, k = i2 & 127, b = seq >> 3, dir = (seq >> 2) & 1, hd = seq & 3;
            float* NM = (float*)(C.ws + B_NM); const float* DM = (const float*)(C.ws + B_DECM); float run = 0.f;
            for (int st = 0; st < 64; ++st) { const int c = dir ? 63 - st : st; const size_t sb = (size_t)((b * 64 + c) * 2 + dir) * 4 + hd; const float loc = NM[sb * 128 + k], d = DM[sb]; NM[sb * 128 + k] = run; run = run * d + loc; }
        }
    }
}

__device__ __forceinline__ void ssdE_unit(Ctx& C0_, int l, int u) { UNIT_PROLOG();
    const int g = u & 1, c = (u >> 1) & 63, b = u >> 7;
    const int tid = C.tid, lane = C.lane, w = C.wave, r = lane & 15, q = lane >> 4;
    const size_t tok0 = (size_t)b * SEQ + c * 128;
    LAS unsigned char* Cimg = C.lds; LAS unsigned char* Bimg = C.lds + 34816; LAS unsigned char* Ximg = C.lds + 34816; LAS unsigned char* S0 = C.lds + 69632;
    LAS float* cumf = (LAS float*)(C.lds + 104448); LAS float* dtv = (LAS float*)(C.lds + 112640);
    const bf16* XC = (const bf16*)(C.ws + B_XBCC);
    load_tile(Bimg, 272, XC + tok0 * 1536 + 1024 + g * 128, 1536, 128, 128, tid);
    load_tile(Cimg, 272, XC + tok0 * 1536 + 1280 + g * 128, 1536, 128, 128, tid);
    {
        const int h = g * 8 + w; const float* Gt = (const float*)(C.ws + WS_GATES);
#pragma unroll
        for (int dir = 0; dir < 2; ++dir) {
            const float dtb = C.in[6][(l * 2 + dir) * 16 + h], Aneg = -__expf(C.in[7][(l * 2 + dir) * 16 + h]);
            const float d0 = softplusf_(Gt[(tok0 + 2 * lane) * NGATE + dir * 16 + h] + dtb), d1 = softplusf_(Gt[(tok0 + 2 * lane + 1) * NGATE + dir * 16 + h] + dtb);
            const float a0 = d0 * Aneg, a1 = d1 * Aneg; float i0, i1, tot; scan128(a0, a1, lane, i0, i1, tot);
            cumf[(w * 2 + dir) * 128 + 2 * lane] = dir ? tot - i0 + a0 : i0; cumf[(w * 2 + dir) * 128 + 2 * lane + 1] = dir ? tot - i1 + a1 : i1;
            dtv[(w * 2 + dir) * 128 + 2 * lane] = d0; dtv[(w * 2 + dir) * 128 + 2 * lane + 1] = d1;
        }
    }
    __syncthreads();
    f32x4 cbT[8]; bf16x8 cfr[4];
#pragma unroll
    for (int ks = 0; ks < 4; ++ks) cfr[ks] = frag_row(Cimg, 272, 16 * w + r, 32 * ks + 8 * q);
#pragma unroll
    for (int st = 0; st < 8; ++st) { cbT[st] = (f32x4){0.f, 0.f, 0.f, 0.f};
#pragma unroll
        for (int ks = 0; ks < 4; ++ks) cbT[st] = MFMA16(frag_row(Bimg, 272, 16 * st + r, 32 * ks + 8 * q), cfr[ks], cbT[st]); }
    __syncthreads();
    const unsigned ximg = lds_addr(Ximg);
    const int lrow = 16 * w + r; const size_t tok = tok0 + lrow;
    bf16* MIX = (bf16*)(C.ws + B_MIX); const bf16* Z = (const bf16*)(C.ws + B_Z); const bf16* STS = (const bf16*)(C.ws + B_STS);
    float ssq = 0.f;
#pragma unroll 1
    for (int hh = 0; hh < 8; ++hh) {
        const int h = g * 8 + hh;
        load_tile(Ximg, 144, XC + tok0 * 1536 + h * 64, 1536, 128, 64, tid);
        load_tile(S0, 272, STS + (size_t)(((b * 64 + c) * 2 + 0) * 16 + h) * 8192, 128, 64, 128, tid);
        load_tile(S0 + 17408, 272, STS + (size_t)(((b * 64 + c) * 2 + 1) * 16 + h) * 8192, 128, 64, 128, tid);
        __syncthreads();
        f32x4 y[4];
#pragma unroll
        for (int pt = 0; pt < 4; ++pt) y[pt] = (f32x4){0.f, 0.f, 0.f, 0.f};
#pragma unroll
        for (int dir = 0; dir < 2; ++dir) {
            const LAS float* cm = cumf + (hh * 2 + dir) * 128; const LAS float* dv = dtv + (hh * 2 + dir) * 128;
            const float cl = cm[lrow];
#pragma unroll
            for (int ks = 0; ks < 4; ++ks) {
                const bool active = dir ? (32 * ks + 31 >= 16 * w) : (32 * ks <= 16 * w + 15);
                if (active) {
                    const f32x4 ca = *(const LAS f32x4*)(cm + 32 * ks + 4 * q), cb = *(const LAS f32x4*)(cm + 32 * ks + 16 + 4 * q);
                    const f32x4 da = *(const LAS f32x4*)(dv + 32 * ks + 4 * q), db = *(const LAS f32x4*)(dv + 32 * ks + 16 + 4 * q);
                    float m[8];
#pragma unroll
                    for (int j = 0; j < 8; ++j) {
                        const int s = 32 * ks + 16 * (j >> 2) + 4 * q + (j & 3);
                        const float cs = (j < 4) ? ca[j & 3] : cb[j & 3], ds = (j < 4) ? da[j & 3] : db[j & 3];
                        const bool keep = dir ? (s >= lrow) : (s <= lrow);
                        m[j] = keep ? cbT[2 * ks + (j >> 2)][j & 3] * __expf(cl - cs) * ds : 0.f;
                    }
                    const bf16x8 mf = pack8(m);
#pragma unroll
                    for (int pt = 0; pt < 4; ++pt) y[pt] = MFMA16(frag_tr_acc(ximg, 144, 32 * ks, 16 * pt, r, q), mf, y[pt]);
                }
            }
            f32x4 yo[4];
#pragma unroll
            for (int pt = 0; pt < 4; ++pt) yo[pt] = (f32x4){0.f, 0.f, 0.f, 0.f};
#pragma unroll
            for (int ks = 0; ks < 4; ++ks)
#pragma unroll
                for (int pt = 0; pt < 4; ++pt) yo[pt] = MFMA16(frag_row(S0 + dir * 17408, 272, 16 * pt + r, 32 * ks + 8 * q), cfr[ks], yo[pt]);
            const float e = __expf(cl);
#pragma unroll
            for (int pt = 0; pt < 4; ++pt) y[pt] += yo[pt] * e;
        }
        const float dk = C.in[8][l * 16 + h];
#pragma unroll
        for (int pt = 0; pt < 4; ++pt) {
            const u32x2 xw = *(const LAS u32x2*)(Ximg + lrow * 144 + (16 * pt + 4 * q) * 2);
            const u32x2 zw = *(const u32x2*)(Z + tok * 1024 + h * 64 + 16 * pt + 4 * q);
            f32x4 v;
            v[0] = (y[pt][0] + bflo(xw.x) * dk) * siluf_(bflo(zw.x)); v[1] = (y[pt][1] + bfhi(xw.x) * dk) * siluf_(bfhi(zw.x));
            v[2] = (y[pt][2] + bflo(xw.y) * dk) * siluf_(bflo(zw.y)); v[3] = (y[pt][3] + bfhi(xw.y) * dk) * siluf_(bfhi(zw.y));
            ssq += (v[0] * v[0] + v[1] * v[1]) + (v[2] * v[2] + v[3] * v[3]);
            *(u32x2*)(MIX + tok * 2048 + h * 64 + 16 * pt + 4 * q) = pack4(v);
        }
        __syncthreads();
    }
    ssq += __shfl_xor(ssq, 16); ssq += __shfl_xor(ssq, 32);
    const float rs = 1.0f / sqrtf(ssq * (1.f / 512.f) + RMS_EPS);
    const float* nw = C.in[9] + l * 1024 + g * 512;
#pragma unroll 4
    for (int i = 0; i < 32; ++i) {
        bf16* p = MIX + tok * 2048 + g * 512 + i * 16 + 4 * q; const u32x2 vw = *(const u32x2*)p; const f32x4 nv = *(const f32x4*)(nw + i * 16 + 4 * q);
        f32x4 v; v[0] = bflo(vw.x) * rs * nv[0]; v[1] = bfhi(vw.x) * rs * nv[1]; v[2] = bflo(vw.y) * rs * nv[2]; v[3] = bfhi(vw.y) * rs * nv[3];
        *(u32x2*)p = pack4(v);
    }
}
__device__ __forceinline__ void mlE_unit(Ctx& C0_, int l, int u) { UNIT_PROLOG();
    const int hd = u & 3, c = (u >> 2) & 63, b = u >> 8;
    const int tid = C.tid, lane = C.lane, w = C.wave, r = lane & 15, q = lane >> 4;
    const size_t tok0 = (size_t)b * SEQ + c * 128;
    LAS unsigned char* Qimg = C.lds; LAS unsigned char* Kimg = C.lds + 34816; LAS unsigned char* Vimg = C.lds + 69632;
    LAS float* cum = (LAS float*)(C.lds + 104448); LAS float* liv = (LAS float*)(C.lds + 105472); LAS float* nent = (LAS float*)(C.lds + 106496);
    load_tile(Qimg, 272, (const bf16*)(C.ws + B_MQKC) + tok0 * 1024 + hd * 128, 1024, 128, 128, tid);
    load_tile(Kimg, 272, (const bf16*)(C.ws + B_MQKC) + tok0 * 1024 + 512 + hd * 128, 1024, 128, 128, tid);
    load_tile(Vimg, 272, (const bf16*)(C.ws + B_MV) + tok0 * 512 + hd * 128, 512, 128, 128, tid);
    if (w < 2) {
        const int dir = w; const float igb = C.in[14][(l * 2 + dir) * 4 + hd], fgb = C.in[15][(l * 2 + dir) * 4 + hd];
        const float* Gt = (const float*)(C.ws + WS_GATES);
        const float f0 = -softplusf_(-(Gt[(tok0 + 2 * lane) * NGATE + 40 + dir * 4 + hd] + fgb)), f1 = -softplusf_(-(Gt[(tok0 + 2 * lane + 1) * NGATE + 40 + dir * 4 + hd] + fgb));
        float i0, i1, tot; scan128(f0, f1, lane, i0, i1, tot);
        cum[dir * 128 + 2 * lane] = dir ? tot - i0 + f0 : i0; cum[dir * 128 + 2 * lane + 1] = dir ? tot - i1 + f1 : i1;
        liv[dir * 128 + 2 * lane] = Gt[(tok0 + 2 * lane) * NGATE + 32 + dir * 4 + hd] + igb; liv[dir * 128 + 2 * lane + 1] = Gt[(tok0 + 2 * lane + 1) * NGATE + 32 + dir * 4 + hd] + igb;
    }
    __syncthreads();
    const float SC = 0.08838834764831845f;
    f32x4 sT[8]; bf16x8 qfr[4];
#pragma unroll
    for (int ks = 0; ks < 4; ++ks) qfr[ks] = frag_row(Qimg, 272, 16 * w + r, 32 * ks + 8 * q);
#pragma unroll
    for (int st = 0; st < 8; ++st) { sT[st] = (f32x4){0.f, 0.f, 0.f, 0.f};
#pragma unroll
        for (int ks = 0; ks < 4; ++ks) sT[st] = MFMA16(frag_row(Kimg, 272, 16 * st + r, 32 * ks + 8 * q), qfr[ks], sT[st]);
        sT[st] *= SC; }
    __syncthreads();
    const unsigned vimg = lds_addr(Vimg);
    const int lrow = 16 * w + r; const size_t tok = tok0 + lrow;
    f32x4 hs[8];
#pragma unroll
    for (int vt = 0; vt < 8; ++vt) hs[vt] = (f32x4){0.f, 0.f, 0.f, 0.f};
#pragma unroll 1
    for (int dir = 0; dir < 2; ++dir) {
        const size_t sb = (size_t)(((b * 64 + c) * 2 + dir) * 4 + hd);
        load_tile(Kimg, 272, (const bf16*)(C.ws + B_STM) + sb * 16384, 128, 128, 128, tid);
        if (tid < 128) nent[tid] = ((const float*)(C.ws + B_NM))[sb * 128 + tid];
        __syncthreads();
        const LAS float* cm = cum + dir * 128; const LAS float* lv = liv + dir * 128;
        const float cl = cm[lrow];
        f32x4 num[8]; float denp = 0.f;
#pragma unroll
        for (int vt = 0; vt < 8; ++vt) num[vt] = (f32x4){0.f, 0.f, 0.f, 0.f};
#pragma unroll
        for (int ks = 0; ks < 4; ++ks) {
            const bool active = dir ? (32 * ks + 31 >= 16 * w) : (32 * ks <= 16 * w + 15);
            if (active) {
                const f32x4 ca = *(const LAS f32x4*)(cm + 32 * ks + 4 * q), cb = *(const LAS f32x4*)(cm + 32 * ks + 16 + 4 * q);
                const f32x4 la = *(const LAS f32x4*)(lv + 32 * ks + 4 * q), lb = *(const LAS f32x4*)(lv + 32 * ks + 16 + 4 * q);
                float m[8];
#pragma unroll
                for (int j = 0; j < 8; ++j) {
                    const int s = 32 * ks + 16 * (j >> 2) + 4 * q + (j & 3);
                    const float cs = (j < 4) ? ca[j & 3] : cb[j & 3], ls = (j < 4) ? la[j & 3] : lb[j & 3];
                    const bool keep = dir ? (s >= lrow) : (s <= lrow);
                    m[j] = keep ? sT[2 * ks + (j >> 2)][j & 3] * __expf(cl - cs + ls) : 0.f; denp += m[j];
                }
                const bf16x8 mf = pack8(m);
#pragma unroll
                for (int vt = 0; vt < 8; ++vt) num[vt] = MFMA16(frag_tr_acc(vimg, 272, 32 * ks, 16 * vt, r, q), mf, num[vt]);
            }
        }
        f32x4 ni[8];
#pragma unroll
        for (int vt = 0; vt < 8; ++vt) ni[vt] = (f32x4){0.f, 0.f, 0.f, 0.f};
        float qn = 0.f;
#pragma unroll
        for (int ks = 0; ks < 4; ++ks) {
#pragma unroll
            for (int vt = 0; vt < 8; ++vt) ni[vt] = MFMA16(frag_row(Kimg, 272, 16 * vt + r, 32 * ks + 8 * q), qfr[ks], ni[vt]);
            float qv[8]; unpack8(qfr[ks], qv);
            const f32x4 n0 = *(const LAS f32x4*)(nent + 32 * ks + 8 * q), n1 = *(const LAS f32x4*)(nent + 32 * ks + 8 * q + 4);
            qn += (qv[0] * n0.x + qv[1] * n0.y + qv[2] * n0.z + qv[3] * n0.w) + (qv[4] * n1.x + qv[5] * n1.y + qv[6] * n1.z + qv[7] * n1.w);
        }
        denp += __shfl_xor(denp, 16); denp += __shfl_xor(denp, 32); qn += __shfl_xor(qn, 16); qn += __shfl_xor(qn, 32);
        const float e = __expf(cl) * SC; const float den = denp + e * qn; const float inv = 1.0f / fmaxf(fabsf(den), 1.0f);
#pragma unroll
        for (int vt = 0; vt < 8; ++vt) hs[vt] += (num[vt] + ni[vt] * e) * inv;
        __syncthreads();
    }
    float s1 = 0.f;
#pragma unroll
    for (int vt = 0; vt < 8; ++vt) s1 += (hs[vt][0] + hs[vt][1]) + (hs[vt][2] + hs[vt][3]);
    s1 += __shfl_xor(s1, 16); s1 += __shfl_xor(s1, 32);
    const float mean = s1 * (1.f / 128.f); float s2 = 0.f;
#pragma unroll
    for (int vt = 0; vt < 8; ++vt) { hs[vt] -= mean; s2 += (hs[vt][0] * hs[vt][0] + hs[vt][1] * hs[vt][1]) + (hs[vt][2] * hs[vt][2] + hs[vt][3] * hs[vt][3]); }
    s2 += __shfl_xor(s2, 16); s2 += __shfl_xor(s2, 32);
    const float rs = 1.0f / sqrtf(s2 * (1.f / 128.f) + LN_EPS);
    const float* nw = C.in[16] + l * 512 + hd * 128; const bf16* MO = (const bf16*)(C.ws + B_MO) + tok * 512 + hd * 128; bf16* MIX = (bf16*)(C.ws + B_MIX) + tok * 2048 + 1536 + hd * 128;
#pragma unroll
    for (int vt = 0; vt < 8; ++vt) {
        const int v0 = 16 * vt + 4 * q; const f32x4 nv = *(const f32x4*)(nw + v0); const u32x2 ow = *(const u32x2*)(MO + v0);
        f32x4 o; o[0] = hs[vt][0] * rs * nv[0] * sigmoidf_(bflo(ow.x)); o[1] = hs[vt][1] * rs * nv[1] * sigmoidf_(bfhi(ow.x)); o[2] = hs[vt][2] * rs * nv[2] * sigmoidf_(bflo(ow.y)); o[3] = hs[vt][3] * rs * nv[3] * sigmoidf_(bfhi(ow.y));
        *(u32x2*)(MIX + v0) = pack4(o);
    }
}
__device__ __forceinline__ void hgE_unit(Ctx& C0_, int l, int u) { UNIT_PROLOG();
    const int hd = u & 3, c = (u >> 2) & 127, b = u >> 9;
    const int tid = C.tid, lane = C.lane, w = C.wave, r = lane & 15, q = lane >> 4, I = w & 3, vh = w >> 2;
    const size_t tok0 = (size_t)b * SEQ + c * 64;
    LAS unsigned char* Qimg = C.lds; LAS unsigned char* Vimg = C.lds + 17408; LAS float* Gimg = (LAS float*)(C.lds + 34816); LAS unsigned char* Kimg = C.lds + 68608; LAS unsigned char* Simg = C.lds + 86016;
    LAS float* segtot = (LAS float*)(C.lds + 120832); LAS float* xch = (LAS float*)(C.lds + 122880);
    {
        const bf16* HQ = (const bf16*)(C.ws + B_HQ) + tok0 * 512 + hd * 128;
        for (int i = tid; i < 64 * 16; i += NTHR) { const int row = i >> 4, ch = i & 15; const u32x4 x = *(const u32x4*)(HQ + (size_t)row * 512 + ch * 8);
            u32x4 o; o.x = pk2(siluf_(bflo(x.x)), siluf_(bfhi(x.x))); o.y = pk2(siluf_(bflo(x.y)), siluf_(bfhi(x.y))); o.z = pk2(siluf_(bflo(x.z)), siluf_(bfhi(x.z))); o.w = pk2(siluf_(bflo(x.w)), siluf_(bfhi(x.w)));
            *(LAS u32x4*)(Qimg + row * 272 + ch * 16) = o; }
        load_tile(Vimg, 272, (const bf16*)(C.ws + B_HI) + tok0 * 512 + hd * 128, 512, 64, 128, tid);
    }
    const unsigned vimg = lds_addr(Vimg);
    const int lrow = 16 * I + r; const size_t tok = tok0 + lrow;
    f32x4 o[4];
#pragma unroll
    for (int vt = 0; vt < 4; ++vt) o[vt] = (f32x4){0.f, 0.f, 0.f, 0.f};
#pragma unroll 1
    for (int dir = 0; dir < 2; ++dir) {
        const size_t sb = (size_t)(((b * 128 + c) * 2 + dir) * 4 + hd);
        load_tile(Simg, 272, (const bf16*)(C.ws + B_STH) + sb * 16384, 128, 128, 128, tid);
        (void)hg_gates<0>(C, l, tok0, hd, dir, Gimg, Kimg, segtot);
        const int refrow = dir ? (I < 3 ? 16 * (I + 1) : -1) : (I > 0 ? 16 * I - 1 : -1);
        bf16x8 qt[4], qh[4];
#pragma unroll
        for (int ks = 0; ks < 4; ++ks) {
            const int k0 = 32 * ks + 8 * q;
            float qv[8]; unpack8(frag_row(Qimg, 272, lrow, k0), qv);
            const f32x4 g0 = *(const LAS f32x4*)(Gimg + lrow * 132 + k0), g1 = *(const LAS f32x4*)(Gimg + lrow * 132 + k0 + 4);
            f32x4 r0 = (f32x4){0.f, 0.f, 0.f, 0.f}, r1 = r0;
            if (refrow >= 0) { r0 = *(const LAS f32x4*)(Gimg + refrow * 132 + k0); r1 = *(const LAS f32x4*)(Gimg + refrow * 132 + k0 + 4); }
            float a[8], h8[8];
#pragma unroll
            for (int j = 0; j < 8; ++j) { const float gl = (j < 4) ? g0[j & 3] : g1[j & 3], rf = (j < 4) ? r0[j & 3] : r1[j & 3]; a[j] = qv[j] * __expf(gl - rf); h8[j] = qv[j] * __expf(gl); }
            qt[ks] = pack8(a); qh[ks] = pack8(h8);
        }
        f32x4 att[4];
#pragma unroll
        for (int J = 0; J < 4; ++J) {
            att[J] = (f32x4){0.f, 0.f, 0.f, 0.f};
            const bool inr = dir ? (J >= I) : (J <= I);
            if (inr) {
                const int srow = 16 * J + r;
#pragma unroll
                for (int ks = 0; ks < 4; ++ks) {
                    const int k0 = 32 * ks + 8 * q;
                    float kv[8]; unpack8(frag_row(Kimg, 272, srow, k0), kv);
                    const f32x4 g0 = *(const LAS f32x4*)(Gimg + srow * 132 + k0), g1 = *(const LAS f32x4*)(Gimg + srow * 132 + k0 + 4);
                    f32x4 r0 = (f32x4){0.f, 0.f, 0.f, 0.f}, r1 = r0;
                    if (refrow >= 0) { r0 = *(const LAS f32x4*)(Gimg + refrow * 132 + k0); r1 = *(const LAS f32x4*)(Gimg + refrow * 132 + k0 + 4); }
                    float a[8];
#pragma unroll
                    for (int j = 0; j < 8; ++j) { const float gs = (j < 4) ? g0[j & 3] : g1[j & 3], rf = (j < 4) ? r0[j & 3] : r1[j & 3]; a[j] = kv[j] * __expf(fminf(rf - gs, 80.f)); }
                    att[J] = MFMA16(pack8(a), qt[ks], att[J]);
                }
                if (J == I) {
#pragma unroll
                    for (int i = 0; i < 4; ++i) { const bool keep = dir ? (4 * q + i >= r) : (4 * q + i <= r); att[J][i] = keep ? att[J][i] : 0.f; }
                }
            }
        }
#pragma unroll
        for (int k2 = 0; k2 < 2; ++k2) {
            float m[8] = {att[2 * k2][0], att[2 * k2][1], att[2 * k2][2], att[2 * k2][3], att[2 * k2 + 1][0], att[2 * k2 + 1][1], att[2 * k2 + 1][2], att[2 * k2 + 1][3]};
            const bf16x8 mf = pack8(m);
#pragma unroll
            for (int vt = 0; vt < 4; ++vt) o[vt] = MFMA16(frag_tr_acc(vimg, 272, 32 * k2, 64 * vh + 16 * vt, r, q), mf, o[vt]);
        }
#pragma unroll
        for (int ks = 0; ks < 4; ++ks)
#pragma unroll
            for (int vt = 0; vt < 4; ++vt) o[vt] = MFMA16(frag_row(Simg, 272, 64 * vh + 16 * vt + r, 32 * ks + 8 * q), qh[ks], o[vt]);
        __syncthreads();
    }
    float ss = 0.f;
#pragma unroll
    for (int vt = 0; vt < 4; ++vt) ss += (o[vt][0] * o[vt][0] + o[vt][1] * o[vt][1]) + (o[vt][2] * o[vt][2] + o[vt][3] * o[vt][3]);
    ss += __shfl_xor(ss, 16); ss += __shfl_xor(ss, 32);
    if (q == 0) xch[vh * 64 + lrow] = ss;
    __syncthreads();
    const float rs = 1.0f / sqrtf((xch[lrow] + xch[64 + lrow]) * (1.f / 128.f) + RMS_EPS);
    const float* nw = C.in[11] + l * 512 + hd * 128; const bf16* HGt = (const bf16*)(C.ws + B_HG) + tok * 512 + hd * 128; bf16* MIX = (bf16*)(C.ws + B_MIX) + tok * 2048 + 1024 + hd * 128;
#pragma unroll
    for (int vt = 0; vt < 4; ++vt) {
        const int v0 = 64 * vh + 16 * vt + 4 * q; const f32x4 nv = *(const f32x4*)(nw + v0); const u32x2 gw = *(const u32x2*)(HGt + v0);
        f32x4 v; v[0] = o[vt][0] * rs * nv[0] * siluf_(bflo(gw.x)); v[1] = o[vt][1] * rs * nv[1] * siluf_(bfhi(gw.x)); v[2] = o[vt][2] * rs * nv[2] * siluf_(bflo(gw.y)); v[3] = o[vt][3] * rs * nv[3] * siluf_(bfhi(gw.y));
        *(u32x2*)(MIX + v0) = pack4(v);
    }
    __syncthreads();
}
__device__ __forceinline__ void mixE_phase(Ctx& C, int l) {
    for (int u = C.blk; u < 1792; u += C.G) {
        if (u < 256) { if (FAST_SSD) ssdE_unit(C, l, u); }
        else if (u < 768) { if (FAST_ML) mlE_unit(C, l, u - 256); }
        else { if (FAST_HG) hgE_unit(C, l, u - 768); }
    }
}

constexpr int PH_PER_LAYER = 11, NPHASES = 1 + DEPTH * PH_PER_LAYER;
__global__ void __launch_bounds__(NTHR, 2) fwd_kernel(Args args) {
    extern __shared__ __attribute__((aligned(16))) unsigned char lds_raw[];
    Ctx C;
    C.lds = (LAS unsigned char*)lds_raw; C.misc = (volatile LAS unsigned*)(C.lds + MISC_OFF);
    C.ws = args.ws; C.in.lds = C.lds; C.out = args.out;
    C.tid = threadIdx.x; C.lane = C.tid & 63; C.wave = __builtin_amdgcn_readfirstlane(C.tid >> 6); C.G = gridDim.x; C.blk = blockIdx.x;
    if (C.tid < 64) C.misc[C.tid] = 0u;
    if (C.tid < 31) { const unsigned long long p = C.tid < 29 ? (unsigned long long)args.in[C.tid] : (C.tid == 29 ? (unsigned long long)args.out : (unsigned long long)args.ws);
        *(LAS u32x2*)(C.lds + PTAB_OFF + 8 * C.tid) = (u32x2){(unsigned)p, (unsigned)(p >> 32)}; }
    __syncthreads();
    const int lo = args.ph_lo, hi = args.ph_hi;
#if MK_ONE_LAUNCH
    XcdBarrier bar = xcd_barrier_post((unsigned*)(C.ws + WS_CTL) + CW_BAR, C.misc + 32);
#define GRID_BAR() do { XcdBarrier b2_ = bar; b2_.bar = (unsigned*)C.in[30] + CW_BAR; asm volatile("" : "+s"(b2_.x)); xcd_barrier(b2_); } while (0)
#else
#define GRID_BAR() do { } while (0)
#endif
#define IN(k) (lo <= (k) && (k) < hi)
#define SEAM(k) do { if (IN((k) + 1)) GRID_BAR(); } while (0)
#define LAUNDER() do { __syncthreads(); C.out = (float*)C.in[29]; C.ws = (unsigned char*)C.in[30]; int ln_; asm volatile("v_mbcnt_lo_u32_b32 %0, -1, 0\n\tv_mbcnt_hi_u32_b32 %0, -1, %0" : "=v"(ln_)); C.lane = ln_; C.tid = C.wave * 64 + ln_; asm volatile("" : "+s"(C.blk), "+s"(C.G)); } while (0)

    if (IN(0)) { LAUNDER();
        ln_phase<0, 1>(C, C.in[0], C.in[1], C.in[2], (float*)(C.ws + WS_HF32), 0);
        __syncthreads();
        wconv_layer(C, 0);
        SEAM(0);
    }
    for (int l = 0; l < DEPTH; ++l) {
        const int pb = 1 + l * PH_PER_LAYER; const bool moe = (l & 1) != 0; const int lm = l >> 1;
        const int dff = moe ? DFF_E : DFF_D;
        if (IN(pb + 0)) { LAUNDER();
            pg8::GOrder S; S.init(C.ws + WS_HBF, C.ws + WS_WIN, D, T / 256, NMAIN / 256, C.G, C.blk, 0, nullptr);
            pg8::EpiProj E{C.ws};
            pg8::gemm_phase<pg8::EpiProj, pg8::GOrder>(C.lds, D, S, E, C.tid);
            SEAM(pb + 0);
        }
        if (IN(pb + 1)) { LAUNDER(); conv_phase(C, l); SEAM(pb + 1); }
        if (IN(pb + 2)) { LAUNDER(); if (!(FAST_SSD && FAST_HG && FAST_ML)) naive_mixers(C, l); __syncthreads(); mixC_phase(C, l); SEAM(pb + 2); }
        if (IN(pb + 3)) { LAUNDER(); scan_phase(C); SEAM(pb + 3); }
        if (IN(pb + 4)) { LAUNDER(); if (!(FAST_SSD && FAST_HG && FAST_ML)) naive_combine(C, l); __syncthreads(); mixE_phase(C, l); SEAM(pb + 4); }
        if (IN(pb + 5)) { LAUNDER();
            pg8::GOrder S; S.init(C.ws + B_MIX, C.ws + WS_WOUT, DMIX, T / 256, D / 256, C.G, C.blk, 0, nullptr);
            pg8::EpiF32 E{(float*)(C.ws + B_Y), D};
            pg8::gemm_phase<pg8::EpiF32, pg8::GOrder>(C.lds, DMIX, S, E, C.tid);
            SEAM(pb + 5);
        }
        if (IN(pb + 6)) { LAUNDER();
            if (moe) ln_phase<1, 2>(C, nullptr, C.in[18] + l * D, C.in[19] + l * D, (float*)(C.ws + WS_HF32), l);
            else ln_phase<1, 0>(C, nullptr, C.in[18] + l * D, C.in[19] + l * D, (float*)(C.ws + WS_HF32), l);
            SEAM(pb + 6);
        }
        if (IN(pb + 7)) { LAUNDER(); if (moe) moe_dispatch(C, lm); SEAM(pb + 7); }
        if (IN(pb + 8)) { LAUNDER();
            __syncthreads();
            const int nblk = moe_cum_table(C, lm, moe);
            pg8::GOrder S; S.init(moe ? C.ws + B_XS : C.ws + WS_HBF, C.ws + WS_W13, D, nblk, 2 * dff / 256, C.G, C.blk, (size_t)2 * dff * D * 2, (const LAS int*)(C.lds + MISC_OFF));
            pg8::EpiSwiglu E{(bf16*)(C.ws + B_HID), dff};
            pg8::gemm_phase<pg8::EpiSwiglu, pg8::GOrder>(C.lds, D, S, E, C.tid);
            SEAM(pb + 8);
        }
        if (IN(pb + 9)) { LAUNDER();
            __syncthreads();
            const int nblk = moe_cum_table(C, lm, moe);
            pg8::GOrder S; S.init(C.ws + B_HID, C.ws + WS_W2, dff, nblk, D / 256, C.G, C.blk, (size_t)D * dff * 2, (const LAS int*)(C.lds + MISC_OFF));
            pg8::EpiF32 E{(float*)(C.ws + B_YE), D};
            pg8::gemm_phase<pg8::EpiF32, pg8::GOrder>(C.lds, dff, S, E, C.tid);
            SEAM(pb + 9);
        }
        if (IN(pb + 10)) { LAUNDER();
            float* dst = (l == DEPTH - 1) ? C.out : (float*)(C.ws + WS_HF32);
            const float* g = C.in[20] + l * D; const float* b = C.in[21] + l * D;
            if (l == DEPTH - 1) { if (moe) ln_phase<3, 0>(C, nullptr, g, b, dst, l); else ln_phase<2, 0>(C, nullptr, g, b, dst, l); }
            else { if (moe) ln_phase<3, 1>(C, nullptr, g, b, dst, l + 1); else ln_phase<2, 1>(C, nullptr, g, b, dst, l + 1);
                __syncthreads(); wconv_layer(C, l + 1); }
            SEAM(pb + 10);
        }
    }
#undef IN
#undef SEAM
}

extern "C" void kernel_launch(void* const* d_in, const int* in_sizes, int n_in, void* d_out, int out_size, void* d_ws, size_t ws_size, hipStream_t stream) {
    static int grid = 0;
    if (grid == 0) {
        if (n_in != 29 || out_size != T * D || ws_size < WS_END) { fprintf(stderr, "kernel_launch: unexpected shapes (n_in %d out %d ws %zu need %zu)\n", n_in, out_size, ws_size, (size_t)WS_END); grid = -1; return; }
        int dev = 0, cus = 0, per_cu = 0;
        if (hipGetDevice(&dev) != hipSuccess || hipDeviceGetAttribute(&cus, hipDeviceAttributeMultiprocessorCount, dev) != hipSuccess) { grid = -1; return; }
        if (hipFuncSetAttribute((const void*)fwd_kernel, hipFuncAttributeMaxDynamicSharedMemorySize, LDS_BYTES) != hipSuccess) { grid = -1; return; }
        if (hipOccupancyMaxActiveBlocksPerMultiprocessor(&per_cu, (const void*)fwd_kernel, NTHR, LDS_BYTES) != hipSuccess || per_cu < 1) fprintf(stderr, "kernel_launch: occupancy query says %d\n", per_cu);
        (void)hipGetLastError();
        grid = cus;
    }
    if (grid < 0) return;
    (void)hipMemsetAsync((char*)d_ws + WS_CTL, 0, CTL_ZERO_BYTES, stream);
    Args a{};
    for (int i = 0; i < 29; ++i) a.in[i] = (const float*)d_in[i];
    a.out = (float*)d_out; a.ws = (unsigned char*)d_ws;
#if MK_ONE_LAUNCH
    a.ph_lo = 0; a.ph_hi = NPHASES;
    hipLaunchKernelGGL(fwd_kernel, dim3(grid), dim3(NTHR), LDS_BYTES, stream, a);
#else
    for (int p = 0; p < NPHASES; ++p) {
        if (p >= 1) { const int k = (p - 1) % PH_PER_LAYER, l = (p - 1) / PH_PER_LAYER; if (k == 7 && !(l & 1)) continue; }
        a.ph_lo = p; a.ph_hi = p + 1;
        hipLaunchKernelGGL(fwd_kernel, dim3(grid), dim3(NTHR), LDS_BYTES, stream, a);
    }
#endif
}
```

```cpp
#include <hip/hip_runtime.h>
#include <cstdio>
#include <cstdint>

#ifndef PROFILE_A
#define PROFILE_A 0
#define PROFILE_B 0
#endif
#ifndef MK_ONE_LAUNCH
#define MK_ONE_LAUNCH 1
#endif

#ifndef FAST_SSD
#define FAST_SSD 1
#endif
#ifndef FAST_HG
#define FAST_HG 1
#endif
#ifndef FAST_ML
#define FAST_ML 1
#endif

#define LAS __attribute__((address_space(3)))
#define GAS __attribute__((address_space(1)))
typedef unsigned short bf16;
typedef short bf16x8 __attribute__((ext_vector_type(8)));
typedef float f32x4 __attribute__((ext_vector_type(4)));
typedef float f32x2 __attribute__((ext_vector_type(2)));
typedef unsigned u32x4 __attribute__((ext_vector_type(4)));
typedef unsigned u32x2 __attribute__((ext_vector_type(2)));
typedef short s16x4 __attribute__((ext_vector_type(4)));

constexpr int T = 16384, SEQ = 8192, D = 1024, DEPTH = 4, DPROJ = 7216, NMAIN = 7168, DMIX = 2048;
constexpr int DFF_D = 2816, DFF_E = 3584, NEXP = 8, NGATE = 48;
constexpr int NWAVES = 8, NTHR = 512;
constexpr float ALPHA = 1.681792830507429f;
constexpr float LN_EPS = 1e-5f, RMS_EPS = 1e-6f;
constexpr int MOE_ROWS = 34816;

constexpr size_t MiB = 1u << 20;
constexpr size_t WS_CTL = 0, CTL_ZERO_BYTES = 1 * MiB;
constexpr size_t WS_HF32 = 1 * MiB, WS_HBF = 65 * MiB, WS_GATES = 97 * MiB, WS_ROUTE = 100 * MiB;
constexpr size_t WS_WIN = 101 * MiB, WS_WOUT = 115 * MiB, WS_W13 = 119 * MiB, WS_W2 = 231 * MiB, WS_BIG = 287 * MiB;
constexpr size_t B_Z = WS_BIG + 0 * MiB, B_XBCR = WS_BIG + 32 * MiB, B_HQ = WS_BIG + 80 * MiB, B_HFR = WS_BIG + 96 * MiB, B_HI = WS_BIG + 128 * MiB, B_HG = WS_BIG + 144 * MiB;
constexpr size_t B_MQKR = WS_BIG + 160 * MiB, B_MV = WS_BIG + 192 * MiB, B_MO = WS_BIG + 208 * MiB;
constexpr size_t B_XBCC = WS_BIG + 224 * MiB, B_MQKC = WS_BIG + 272 * MiB;
constexpr size_t B_YBUF = WS_BIG + 304 * MiB, B_OBUF = WS_BIG + 368 * MiB, B_HBUF = WS_BIG + 432 * MiB;
constexpr size_t B_MIX = WS_BIG + 464 * MiB;
constexpr size_t B_Y = WS_BIG + 0 * MiB;
constexpr size_t B_XS = WS_BIG + 64 * MiB, B_HID = WS_BIG + 136 * MiB, B_YE = WS_BIG + 376 * MiB;
constexpr size_t B_PART = B_XS;
constexpr size_t B_STS = WS_BIG + 304 * MiB, B_STH = WS_BIG + 368 * MiB, B_STM = WS_BIG + 432 * MiB;
constexpr size_t B_DECS = WS_BIG + 528 * MiB, B_DECM = B_DECS + 65536, B_NM = B_DECS + 131072, B_DECH = B_DECS + 1 * MiB;
constexpr size_t WS_END = WS_BIG + 532 * MiB;
constexpr int CW_TMO = 0, CW_BAR = 4096, CW_CNT = 8192;

#define LDS_WAIT() asm volatile("s_waitcnt lgkmcnt(0)" ::: "memory")
#define VM_WAIT() asm volatile("s_waitcnt vmcnt(0)" ::: "memory")
__device__ __forceinline__ unsigned f2bf(float f) { unsigned u = __builtin_bit_cast(unsigned, f); return (u + 0x7fffu + ((u >> 16) & 1u)) >> 16; }
typedef __bf16 nbf16x2 __attribute__((ext_vector_type(2)));
__device__ __forceinline__ unsigned pk2(float lo, float hi) { const f32x2 v = {lo, hi}; return __builtin_bit_cast(unsigned, __builtin_convertvector(v, nbf16x2)); }
__device__ __forceinline__ float bf2f(unsigned short b) { return __builtin_bit_cast(float, ((unsigned)b) << 16); }
__device__ __forceinline__ float bflo(unsigned w) { return __builtin_bit_cast(float, w << 16); }
__device__ __forceinline__ float bfhi(unsigned w) { return __builtin_bit_cast(float, w & 0xffff0000u); }
__device__ __forceinline__ float sigmoidf_(float x) { return __builtin_amdgcn_rcpf(1.0f + __expf(-x)); }
__device__ __forceinline__ float siluf_(float x) { return x * __builtin_amdgcn_rcpf(1.0f + __expf(-x)); }
__device__ __forceinline__ float softplusf_(float x) { return fmaxf(x, 0.f) + log1pf(__expf(-fabsf(x))); }
__device__ __forceinline__ float wave_sum(float v) {
#pragma unroll
    for (int o = 1; o < 64; o <<= 1) v += __shfl_xor(v, o);
    return v;
}

namespace pg8 {
#define PG8_LAS __attribute__((address_space(3)))
typedef unsigned short bf16_t;
constexpr int BM = 256, BK = 64, HALF = 128, HTB = HALF * BK * 2, STAGE_BYTES = 8 * HTB, NXCD = 8, WGM = 8;
__host__ __device__ __forceinline__ int lds_byte(int r, int c) { const int st = (r >> 4) * 2 + (c >> 5), rr = r & 15, cc = c & 31, ob = rr * 64 + cc * 2; return st * 1024 + (ob ^ (((ob >> 9) & 1) << 5)); }
__host__ __device__ __forceinline__ void stage_rc(int b, int& R, int& C) { const int st = b / 1024, sb = b % 1024, swz = sb ^ (((sb >> 9) & 1) << 5); R = (st >> 1) * 16 + swz / 64; C = (st & 1) * 32 + (swz % 64) / 2; }
__host__ __device__ __forceinline__ int perm32(int rho) { const int n = rho >> 4, i = rho & 15; return 8 * (i >> 2) + 4 * n + (i & 3); }

struct Unit { const char* A; const char* B; int pm, pn; };

struct GOrder {
    const char* A; const char* Bt; int K; int nM, nN, nwg, G, c; size_t bexp; const PG8_LAS int* cum;
    __device__ void init(const void* A_, const void* Bt_, int K_, int nM_, int nN_, int G_, int c_, size_t bexp_, const PG8_LAS int* cum_) { A = (const char*)A_; Bt = (const char*)Bt_; K = K_; nM = nM_; nN = nN_; nwg = nM * nN; G = G_; c = c_; bexp = bexp_; cum = cum_; }
    __device__ bool next(int i, Unit& u) const {
        const long L = (long)i * G + c; if (L >= nwg) return false;
        int wgid = (int)L; { const int q = nwg / NXCD, r = nwg % NXCD, xcd = wgid % NXCD, off = wgid / NXCD; wgid = (xcd < r ? xcd * (q + 1) : r * (q + 1) + (xcd - r) * q) + off; }
        const int nig = WGM * nN, gid = wgid / nig, fm = gid * WGM, gsz = (nM - fm) < WGM ? (nM - fm) : WGM;
        u.pm = fm + ((wgid % nig) % gsz); u.pn = (wgid % nig) / gsz;
        int e = 0; if (cum) { for (int j = 0; j < 8; ++j) e += (cum[j] <= u.pm) ? 1 : 0; if (e > 7) e = 7; }
        u.A = A + (size_t)u.pm * 256 * K * 2; u.B = Bt + (size_t)e * bexp + (size_t)u.pn * 256 * K * 2; return true;
    }
};
struct TailOrder {
    const char* A; const char* Bt; int KS, npieces, G, c; size_t bexp; const PG8_LAS int* cum;
    __device__ void init(const void* A_, const void* Bt_, int KS_, int ntail, int G_, int c_, size_t bexp_, const PG8_LAS int* cum_) { A = (const char*)A_; Bt = (const char*)Bt_; KS = KS_; npieces = ntail * 28; G = G_; c = c_; bexp = bexp_; cum = cum_; }
    __device__ bool next(int i, Unit& u) const {
        const long L = (long)i * G + c; if (L >= npieces) return false;
        const int p = (int)L, kp = p % 7, pn = (p / 7) & 3, rbi = p / 28, rb = 128 + rbi;
        int e = 0; for (int j = 0; j < 8; ++j) e += (cum[j] <= rb) ? 1 : 0; if (e > 7) e = 7;
        u.pm = kp * 8 + rbi; u.pn = pn;
        u.A = A + ((size_t)rb * 256 * KS + (size_t)kp * 512) * 2; u.B = Bt + (size_t)e * bexp + ((size_t)pn * 256 * KS + (size_t)kp * 512) * 2; return true;
    }
};
__device__ __forceinline__ unsigned cvt_pk_bf16(float lo, float hi) { unsigned r; asm volatile("v_cvt_pk_bf16_f32 %0, %1, %2" : "=v"(r) : "v"(lo), "v"(hi)); return r; }

struct EpiF32 {
    static constexpr bool PERM = false;
    float* C; int ldc;
    __device__ __forceinline__ void operator()(const f32x4 (&acc)[2][2][4][2], const Unit& u, int wr, int wc, int fr, int fq) const {
        const int row0 = u.pm * BM + wr * 64 + fr, col0 = u.pn * BM + wc * 32 + 4 * fq;
#pragma unroll
        for (int ai = 0; ai < 2; ++ai)
#pragma unroll
            for (int m = 0; m < 4; ++m) { float* rowp = C + (size_t)(row0 + ai * HALF + m * 16) * ldc + col0;
#pragma unroll
                for (int bj = 0; bj < 2; ++bj)
#pragma unroll
                    for (int n = 0; n < 2; ++n) *(f32x4*)(rowp + bj * HALF + n * 16) = acc[ai][bj][m][n]; }
    }
};
struct EpiBf16Res {
    static constexpr bool PERM = true;
    bf16_t* O; const bf16_t* res; int ldc;
    __device__ __forceinline__ void operator()(const f32x4 (&acc)[2][2][4][2], const Unit& u, int wr, int wc, int fr, int fq) const {
        const int row0 = u.pm * BM + wr * 64 + fr, col0 = u.pn * BM + wc * 32 + 8 * fq;
#pragma unroll
        for (int ai = 0; ai < 2; ++ai)
#pragma unroll
            for (int m = 0; m < 4; ++m) { const size_t off = (size_t)(row0 + ai * HALF + m * 16) * ldc + col0;
#pragma unroll
                for (int bj = 0; bj < 2; ++bj) { f32x4 v0 = acc[ai][bj][m][0], v1 = acc[ai][bj][m][1];
                    if (res) { const u32x4 rw = *(const u32x4*)(res + off + bj * HALF);
                        v0[0] += ALPHA * bflo(rw.x); v0[1] += ALPHA * bfhi(rw.x); v0[2] += ALPHA * bflo(rw.y); v0[3] += ALPHA * bfhi(rw.y);
                        v1[0] += ALPHA * bflo(rw.z); v1[1] += ALPHA * bfhi(rw.z); v1[2] += ALPHA * bflo(rw.w); v1[3] += ALPHA * bfhi(rw.w); }
                    u32x4 w; w.x = cvt_pk_bf16(v0[0], v0[1]); w.y = cvt_pk_bf16(v0[2], v0[3]); w.z = cvt_pk_bf16(v1[0], v1[1]); w.w = cvt_pk_bf16(v1[2], v1[3]);
                    *(u32x4*)(O + off + bj * HALF) = w; } }
    }
};
struct EpiProj {
    static constexpr bool PERM = true;
    unsigned char* ws;
    __device__ __forceinline__ void operator()(const f32x4 (&acc)[2][2][4][2], const Unit& u, int wr, int wc, int fr, int fq) const {
        const int pn = u.pn; size_t off; int ldc, c0;
        if (pn < 4) { off = B_Z; ldc = 1024; c0 = pn; } else if (pn < 10) { off = B_XBCR; ldc = 1536; c0 = pn - 4; } else if (pn < 12) { off = B_HQ; ldc = 512; c0 = pn - 10; }
        else if (pn < 16) { off = B_HFR; ldc = 1024; c0 = pn - 12; } else if (pn < 18) { off = B_HI; ldc = 512; c0 = pn - 16; } else if (pn < 20) { off = B_HG; ldc = 512; c0 = pn - 18; }
        else if (pn < 24) { off = B_MQKR; ldc = 1024; c0 = pn - 20; } else if (pn < 26) { off = B_MV; ldc = 512; c0 = pn - 24; } else { off = B_MO; ldc = 512; c0 = pn - 26; }
        bf16_t* base = (bf16_t*)(ws + off);
        const int row0 = u.pm * BM + wr * 64 + fr, col0 = c0 * BM + wc * 32 + 8 * fq;
#pragma unroll
        for (int ai = 0; ai < 2; ++ai)
#pragma unroll
            for (int m = 0; m < 4; ++m) { bf16_t* rowp = base + (size_t)(row0 + ai * HALF + m * 16) * ldc + col0;
#pragma unroll
                for (int bj = 0; bj < 2; ++bj) { const f32x4 v0 = acc[ai][bj][m][0], v1 = acc[ai][bj][m][1];
                    u32x4 w; w.x = cvt_pk_bf16(v0[0], v0[1]); w.y = cvt_pk_bf16(v0[2], v0[3]); w.z = cvt_pk_bf16(v1[0], v1[1]); w.w = cvt_pk_bf16(v1[2], v1[3]);
                    *(u32x4*)(rowp + bj * HALF) = w; } }
    }
};
struct EpiSwiglu {
    static constexpr bool PERM = true;
    bf16_t* O; int ldc;
    __device__ __forceinline__ void operator()(const f32x4 (&acc)[2][2][4][2], const Unit& u, int wr, int wc, int fr, int fq) const {
        const int row0 = u.pm * BM + wr * 64 + fr, col0 = u.pn * HALF + wc * 32 + 8 * fq;
#pragma unroll
        for (int ai = 0; ai < 2; ++ai)
#pragma unroll
            for (int m = 0; m < 4; ++m) { bf16_t* rowp = O + (size_t)(row0 + ai * HALF + m * 16) * ldc + col0;
                float o[8];
#pragma unroll
                for (int n = 0; n < 2; ++n)
#pragma unroll
                    for (int j = 0; j < 4; ++j) { const float a = acc[ai][0][m][n][j], b = acc[ai][1][m][n][j]; o[n * 4 + j] = a * __builtin_amdgcn_rcpf(1.0f + __expf(-a)) * b; }
                u32x4 w; w.x = cvt_pk_bf16(o[0], o[1]); w.y = cvt_pk_bf16(o[2], o[3]); w.z = cvt_pk_bf16(o[4], o[5]); w.w = cvt_pk_bf16(o[6], o[7]);
                *(u32x4*)rowp = w; }
    }
};

template <class Epi, class Sched, bool ALIGN_EPI = true>
__device__ __forceinline__ void gemm_phase(PG8_LAS unsigned char* lds, const int K, const int KS, const Sched& S, const Epi& E, const int tid) {
    const int wid = __builtin_amdgcn_readfirstlane(tid >> 6), lane = tid & 63, wr = wid >> 2, wc = wid & 3, fr = lane & 15, fq = lane >> 4;
    const int nt = K / BK;
    unsigned voffA[2], voffB[2];
#pragma unroll
    for (int i = 0; i < 2; ++i) { int R, C; stage_rc(tid * 16 + i * 8192, R, C); const int Rb = Epi::PERM ? ((R & ~31) + perm32(R & 31)) : R;
        voffA[i] = (unsigned)(R * KS + C) * 2u; voffB[i] = (unsigned)(Rb * KS + C) * 2u; }
    const size_t kstep = (size_t)(BK * 2);
    const size_t hstep = (size_t)HALF * KS * 2;
    const unsigned ldsw = (unsigned)wid * 1024u;
    const int aoff = lds_byte(wr * 64 + fr, fq * 8), boff = lds_byte(wc * 32 + fr, fq * 8);
#define PG8_SA(b, h) (((b) * 2 + (h)) * HTB)
#define PG8_SB(b, h) ((4 + (b) * 2 + (h)) * HTB)
#define PG8_STAGE(bufoff, gbase, voff) do { _Pragma("unroll") for (int _i = 0; _i < 2; ++_i) \
        __builtin_amdgcn_global_load_lds((const unsigned*)((const char*)(gbase) + (voff)[_i]), (PG8_LAS unsigned*)(lds + (bufoff) + ldsw + _i * 8192), 16, 0, 0); } while (0)
#define PG8_LDA(dst, b, h) do { _Pragma("unroll") for (int m = 0; m < 4; ++m) _Pragma("unroll") for (int k = 0; k < 2; ++k) dst[m][k] = *(const PG8_LAS bf16x8*)(lds + PG8_SA(b, h) + aoff + m * 2048 + k * 1024); } while (0)
#define PG8_LDB(dst, b, h) do { _Pragma("unroll") for (int n = 0; n < 2; ++n) _Pragma("unroll") for (int k = 0; k < 2; ++k) dst[n][k] = *(const PG8_LAS bf16x8*)(lds + PG8_SB(b, h) + boff + n * 2048 + k * 1024); } while (0)
#define PG8_MMA(ai, bj, At, Bt) do { __builtin_amdgcn_s_setprio(1); _Pragma("unroll") for (int m = 0; m < 4; ++m) _Pragma("unroll") for (int n = 0; n < 2; ++n) _Pragma("unroll") for (int k = 0; k < 2; ++k) \
        acc[ai][bj][m][n] = __builtin_amdgcn_mfma_f32_16x16x32_bf16(Bt[n][k], At[m][k], acc[ai][bj][m][n], 0, 0, 0); __builtin_amdgcn_s_setprio(0); } while (0)
#define PG8_WAIT_V(n) asm volatile("s_waitcnt vmcnt(" #n ")" ::: "memory")
#define PG8_WAIT_L(n) asm volatile("s_waitcnt lgkmcnt(" #n ")" ::: "memory")
#define PG8_BAR __builtin_amdgcn_s_barrier()
#define PG8_SCHED __builtin_amdgcn_sched_barrier(0)
    Unit cur, nxt; int ui = 0;
    if (!S.next(0, cur)) return;
    f32x4 acc[2][2][4][2];
#pragma unroll
    for (int a = 0; a < 2; ++a)
#pragma unroll
        for (int b = 0; b < 2; ++b)
#pragma unroll
            for (int m = 0; m < 4; ++m)
#pragma unroll
                for (int n = 0; n < 2; ++n) acc[a][b][m][n] = (f32x4){0.f, 0.f, 0.f, 0.f};
    bf16x8 At[4][2], B0[2][2], B1[2][2];
    const char* cA = cur.A; const char* cB = cur.B;
    PG8_STAGE(PG8_SB(0, 0), cB, voffB); PG8_STAGE(PG8_SB(0, 1), cB + hstep, voffB); PG8_STAGE(PG8_SA(0, 0), cA, voffA); PG8_STAGE(PG8_SA(0, 1), cA + hstep, voffA);
    if (wr == 1) PG8_BAR;
    PG8_WAIT_V(2); PG8_BAR;
    PG8_STAGE(PG8_SB(1, 0), cB + kstep, voffB); PG8_STAGE(PG8_SA(1, 0), cA + kstep, voffA); PG8_STAGE(PG8_SB(1, 1), cB + hstep + kstep, voffB);
    PG8_WAIT_V(6); PG8_BAR;
    for (;;) {
        const bool has_next = S.next(ui + 1, nxt);
        const char* nA = has_next ? nxt.A : cA; const char* nB = has_next ? nxt.B : cB;
        for (int t = 0; t < nt; t += 2) {
            const bool last = (t == nt - 2);
            const char* a1 = cA + (size_t)(t + 1) * kstep;
            const char* a2 = last ? nA : cA + (size_t)(t + 2) * kstep; const char* b2 = last ? nB : cB + (size_t)(t + 2) * kstep;
            const char* a3 = a2 + kstep; const char* b3 = b2 + kstep;
            PG8_LDB(B0, 0, 0); PG8_LDB(B1, 0, 1); PG8_SCHED; PG8_LDA(At, 0, 0); PG8_STAGE(PG8_SA(1, 1), a1 + hstep, voffA);
            PG8_WAIT_V(8); PG8_WAIT_L(0); PG8_BAR; PG8_MMA(0, 0, At, B0); PG8_MMA(0, 1, At, B1); PG8_BAR; PG8_SCHED;
            PG8_LDA(At, 0, 1); PG8_STAGE(PG8_SB(0, 0), b2, voffB); PG8_STAGE(PG8_SB(0, 1), b2 + hstep, voffB); PG8_STAGE(PG8_SA(0, 0), a2, voffA);
            PG8_WAIT_V(8); PG8_WAIT_L(0); PG8_BAR; PG8_MMA(1, 0, At, B0); PG8_MMA(1, 1, At, B1); PG8_BAR; PG8_SCHED;
            PG8_LDB(B0, 1, 0); PG8_LDB(B1, 1, 1); PG8_SCHED; PG8_LDA(At, 1, 0); PG8_STAGE(PG8_SA(0, 1), a2 + hstep, voffA);
            PG8_WAIT_V(8); PG8_WAIT_L(0); PG8_BAR; PG8_MMA(0, 0, At, B0); PG8_MMA(0, 1, At, B1); PG8_BAR; PG8_SCHED;
            PG8_LDA(At, 1, 1); PG8_STAGE(PG8_SB(1, 0), b3, voffB); PG8_STAGE(PG8_SB(1, 1), b3 + hstep, voffB); PG8_STAGE(PG8_SA(1, 0), a3, voffA);
            PG8_WAIT_V(8); PG8_WAIT_L(0); PG8_BAR; PG8_MMA(1, 0, At, B0); PG8_MMA(1, 1, At, B1); PG8_BAR; PG8_SCHED;
        }
        if constexpr (ALIGN_EPI) { if (wr == 0) PG8_BAR; }
        E(acc, cur, wr, wc, fr, fq);
        if (!has_next) break;
#pragma unroll
        for (int a = 0; a < 2; ++a)
#pragma unroll
            for (int b = 0; b < 2; ++b)
#pragma unroll
                for (int m = 0; m < 4; ++m)
#pragma unroll
                    for (int n = 0; n < 2; ++n) acc[a][b][m][n] = (f32x4){0.f, 0.f, 0.f, 0.f};
        cur = nxt; cA = nA; cB = nB; ++ui;
        if constexpr (ALIGN_EPI) { if (wr == 1) PG8_BAR; }
    }
    PG8_WAIT_V(0);
    if constexpr (!ALIGN_EPI) { if (wr == 0) PG8_BAR; }
    PG8_BAR;
#undef PG8_SA
#undef PG8_SB
#undef PG8_STAGE
#undef PG8_LDA
#undef PG8_LDB
#undef PG8_MMA
#undef PG8_WAIT_V
#undef PG8_WAIT_L
#undef PG8_BAR
#undef PG8_SCHED
}
}

#define XB_TMO      128
#define XB_XCNT(j)  (256  + 64 * (j))
#define XB_XSUB(j)  (1280 + 64 * (j))
#define XB_XGEN(j)  (2304 + 64 * (j))
#define XB_TOP      3328
#define XB_TOPGEN   3392
#define XCD_BAR_WORDS 3456
#define XB_SPIN_CAP (1u << 22)
__device__ __forceinline__ unsigned xb_ld(unsigned* p)              { return __hip_atomic_load(p, __ATOMIC_RELAXED, __HIP_MEMORY_SCOPE_AGENT); }
__device__ __forceinline__ unsigned xb_add(unsigned* p, unsigned v) { return __hip_atomic_fetch_add(p, v, __ATOMIC_RELAXED, __HIP_MEMORY_SCOPE_AGENT); }
__device__ __forceinline__ unsigned xb_xcc_id() { return (unsigned)__builtin_amdgcn_s_getreg((3 << 11) | 20) & 0xFu; }
#define XB_SPIN(cond, bar) do { unsigned _sp = 0; while (cond) { __builtin_amdgcn_s_sleep(1); \
    if ((++_sp & 255u) == 0u) { if (xb_ld(&(bar)[XB_TMO])) break; if (_sp > XB_SPIN_CAP) { atomicAdd(&(bar)[XB_TMO], 1u); break; } } } } while (0)
struct XcdBarrier { unsigned* bar; unsigned x; volatile LAS unsigned* st; };
__device__ __forceinline__ XcdBarrier xcd_barrier_post(unsigned* bar, volatile LAS unsigned* st) {
    XcdBarrier b; b.bar = bar; b.x = xb_xcc_id(); b.st = st;
    if (threadIdx.x == 0) (void)xb_add(&bar[XB_XCNT(b.x)], 1u);
    return b;
}
__device__ __forceinline__ void xcd_barrier_complete(unsigned* bar, unsigned x, unsigned& nloc, unsigned& nx) {
    const unsigned G = gridDim.x * gridDim.y * gridDim.z;
    unsigned sum, cnt, mine, sp = 0u;
    for (;;) {
        sum = 0u; cnt = 0u; mine = 0u;
#pragma unroll
        for (unsigned j = 0; j < 16; ++j) { const unsigned c = xb_ld(&bar[XB_XCNT(j)]); sum += c; cnt += (c > 0u) ? 1u : 0u; mine = (j == x) ? c : mine; }
        if (sum == G) break;
        __builtin_amdgcn_s_sleep(1);
        if ((++sp & 255u) == 0u) { if (xb_ld(&bar[XB_TMO])) break; if (sp > XB_SPIN_CAP) { atomicAdd(&bar[XB_TMO], 1u); break; } }
    }
    nloc = mine > 0u ? mine : 1u; nx = cnt > 0u ? cnt : 1u;
}
__device__ __forceinline__ void xcd_barrier(const XcdBarrier& b) {
    asm volatile("s_waitcnt vmcnt(0)" ::: "memory");
    __syncthreads();
    if (threadIdx.x == 0) {
        unsigned* bar = b.bar;
        __builtin_amdgcn_s_waitcnt(0);
        unsigned nloc = b.st[0], nx = b.st[1];
        if (nloc == 0u) { xcd_barrier_complete(bar, b.x, nloc, nx); b.st[0] = nloc; b.st[1] = nx; }
        const unsigned old = xb_add(&bar[XB_XSUB(b.x)], 1u);
        const unsigned gen = old / nloc;
        if (old + 1u == (gen + 1u) * nloc) {
            __builtin_amdgcn_fence(__ATOMIC_RELEASE, "agent");
            asm volatile("s_waitcnt vmcnt(0)" ::: "memory");
            const unsigned og = xb_add(&bar[XB_TOP], 1u);
            const unsigned tg = og / nx;
            if (og + 1u == (tg + 1u) * nx) xb_add(&bar[XB_TOPGEN], 1u);
            else XB_SPIN(xb_ld(&bar[XB_TOPGEN]) == tg, bar);
            __builtin_amdgcn_fence(__ATOMIC_ACQUIRE, "agent");
            xb_add(&bar[XB_XGEN(b.x)], 1u);
            asm volatile("s_waitcnt vmcnt(0)" ::: "memory");
        } else {
            XB_SPIN(xb_ld(&bar[XB_XGEN(b.x)]) == gen, bar);
            __builtin_amdgcn_fence(__ATOMIC_ACQUIRE, "agent");
            asm volatile("s_waitcnt vmcnt(0)" ::: "memory");
        }
    }
    __syncthreads();
}

constexpr int RING_BYTES = 131072;
constexpr int MISC_OFF = RING_BYTES;
constexpr int LDS_BYTES = 147456;

struct Args { const float* in[29]; float* out; unsigned char* ws; int ph_lo, ph_hi; };

constexpr int PAR_OFF = MISC_OFF + 1024;
constexpr int TS_OFF = MISC_OFF + 512;
constexpr int PTAB_OFF = MISC_OFF + 256;
struct InTab {
    LAS unsigned char* lds;
    __device__ __forceinline__ const float* operator[](int i) const {
        const u32x2 w = *(const LAS u32x2*)(lds + PTAB_OFF + 8 * i);
        const unsigned long long p = ((unsigned long long)(unsigned)__builtin_amdgcn_readfirstlane((int)w.y) << 32) | (unsigned)__builtin_amdgcn_readfirstlane((int)w.x);
        return (const float*)p;
    }
};
struct Ctx {
    LAS unsigned char* lds; volatile LAS unsigned* misc; unsigned char* ws; InTab in; float* out;
    int tid, lane, wave, G, blk;
};

__device__ __forceinline__ void tr_quad0(unsigned a, bf16x8& f0, bf16x8& f1, bf16x8& f2, bf16x8& f3) {
    s16x4 l0, h0, l1, h1, l2, h2, l3, h3;
    asm volatile("ds_read_b64_tr_b16 %0, %8\n\tds_read_b64_tr_b16 %1, %8 offset:544\n\tds_read_b64_tr_b16 %2, %8 offset:32\n\tds_read_b64_tr_b16 %3, %8 offset:576\n\t"
                 "ds_read_b64_tr_b16 %4, %8 offset:64\n\tds_read_b64_tr_b16 %5, %8 offset:608\n\tds_read_b64_tr_b16 %6, %8 offset:96\n\tds_read_b64_tr_b16 %7, %8 offset:640\n\ts_waitcnt lgkmcnt(0)"
                 : "=&v"(l0), "=&v"(h0), "=&v"(l1), "=&v"(h1), "=&v"(l2), "=&v"(h2), "=&v"(l3), "=&v"(h3) : "v"(a) : "memory");
    f0 = __builtin_shufflevector(l0, h0, 0, 1, 2, 3, 4, 5, 6, 7); f1 = __builtin_shufflevector(l1, h1, 0, 1, 2, 3, 4, 5, 6, 7);
    f2 = __builtin_shufflevector(l2, h2, 0, 1, 2, 3, 4, 5, 6, 7); f3 = __builtin_shufflevector(l3, h3, 0, 1, 2, 3, 4, 5, 6, 7);
}
struct TItem { const float* src; bf16* dst; size_t ldw; int K; };
__device__ __forceinline__ void titem_load(f32x4 (&v)[16], const TItem& d, int lane) {
    const int kr = lane >> 4, n4 = (lane & 15) * 4;
#pragma unroll
    for (int i = 0; i < 16; ++i) v[i] = __builtin_nontemporal_load((const f32x4*)(d.src + (size_t)(4 * i + kr) * d.ldw + n4));
}
__device__ __forceinline__ void titem_store(const f32x4 (&v)[16], const TItem& d, LAS unsigned char* scr, int lane) {
    const int kr = lane >> 4, n4 = (lane & 15) * 4;
#pragma unroll
    for (int i = 0; i < 16; ++i) { u32x2 w; w.x = pk2(v[i].x, v[i].y); w.y = pk2(v[i].z, v[i].w); *(LAS u32x2*)(scr + (4 * i + kr) * 136 + n4 * 2) = w; }
    LDS_WAIT(); asm volatile("" ::: "memory");
    const unsigned img = (unsigned)(size_t)scr; const int r = lane & 15, q = lane >> 4;
    bf16x8 f[2][4];
#pragma unroll
    for (int kh = 0; kh < 2; ++kh) {
        const unsigned a0 = img + (32 * kh + 8 * q + (r >> 2)) * 136 + (4 * (r & 3)) * 2;
        tr_quad0(a0, f[kh][0], f[kh][1], f[kh][2], f[kh][3]);
    }
#pragma unroll
    for (int kh = 0; kh < 2; ++kh)
#pragma unroll
        for (int nt = 0; nt < 4; ++nt) *(LAS bf16x8*)(scr + (16 * nt + r) * 144 + (32 * kh + 8 * q) * 2) = f[kh][nt];
    LDS_WAIT(); asm volatile("" ::: "memory");
    const int orow = lane >> 3, och = lane & 7;
#pragma unroll
    for (int j = 0; j < 8; ++j) { const bf16x8 o = *(const LAS bf16x8*)(scr + (8 * j + orow) * 144 + och * 16); *(bf16x8*)(d.dst + (size_t)(8 * j + orow) * d.K + och * 8) = o; }
    LDS_WAIT(); asm volatile("" ::: "memory");
}
__device__ __forceinline__ void wconv_layer(Ctx& C, int l) {
    LAS unsigned char* scr = C.lds + C.wave * 16384;
    const int gw = C.blk * NWAVES + C.wave, NGW = C.G * NWAVES;
    const bool moe = (l & 1) != 0; const int li = l >> 1;
    const int dff = moe ? DFF_E : DFF_D, nexp = moe ? NEXP : 1;
    const int I_A = 16 * (NMAIN / 64), I_B = 32 * 16, I_C1 = 16 * (2 * dff / 64), I_D1 = (dff / 64) * 16;
    const int NIT = I_A + I_B + nexp * (I_C1 + I_D1);
    const float* w_in = C.in[3] + (size_t)l * D * DPROJ; const float* w_out = C.in[17] + (size_t)l * DMIX * D;
    const float* w1 = moe ? C.in[26] + (size_t)li * NEXP * D * DFF_E : C.in[22] + (size_t)li * D * DFF_D;
    const float* w3 = moe ? C.in[27] + (size_t)li * NEXP * D * DFF_E : C.in[23] + (size_t)li * D * DFF_D;
    const float* w2 = moe ? C.in[28] + (size_t)li * NEXP * DFF_E * D : C.in[24] + (size_t)li * DFF_D * D;
    bf16* WinT = (bf16*)(C.ws + WS_WIN); bf16* WoutT = (bf16*)(C.ws + WS_WOUT); bf16* W13T = (bf16*)(C.ws + WS_W13); bf16* W2T = (bf16*)(C.ws + WS_W2);
    auto decode = [&](int it) -> TItem {
        TItem d; int r = it;
        if (r < I_A) { const int nb = r % (NMAIN / 64), kb = r / (NMAIN / 64); const int n0 = 64 * nb; d.src = w_in + (size_t)(64 * kb) * DPROJ + (n0 < 2560 ? n0 : n0 + 32); d.ldw = DPROJ; d.K = D; d.dst = WinT + (size_t)n0 * D + 64 * kb; return d; } r -= I_A;
        if (r < I_B) { const int nb = r % 16, kb = r / 16; d.src = w_out + (size_t)(64 * kb) * D + 64 * nb; d.ldw = D; d.K = DMIX; d.dst = WoutT + (size_t)(64 * nb) * DMIX + 64 * kb; return d; } r -= I_B;
        const int per = I_C1 + I_D1, e = r / per; r -= e * per;
        if (r < I_C1) { const int nbn = 2 * dff / 64, nb = r % nbn, kb = r / nbn; const int n0 = 64 * nb, pn = n0 >> 8, within = n0 & 255, bj = within >> 7, uu = within & 127;
            d.src = (bj ? w3 : w1) + (size_t)e * D * dff + (size_t)(64 * kb) * dff + 128 * pn + uu; d.ldw = dff; d.K = D; d.dst = W13T + (size_t)e * 2 * dff * D + (size_t)n0 * D + 64 * kb; return d; } r -= I_C1;
        { const int nb = r % 16, kb = r / 16; d.src = w2 + (size_t)e * dff * D + (size_t)(64 * kb) * D + 64 * nb; d.ldw = D; d.K = dff; d.dst = W2T + (size_t)e * D * dff + (size_t)(64 * nb) * dff + 64 * kb; return d; }
    };
    f32x4 va[16], vb[16]; TItem da, db;
    int it = gw;
    if (it < NIT) { da = decode(it); titem_load(va, da, C.lane); }
    while (it < NIT) {
        const int i1 = it + NGW, i2 = it + 2 * NGW;
        if (i1 < NIT) { db = decode(i1); titem_load(vb, db, C.lane); }
        titem_store(va, da, scr, C.lane);
        if (i1 >= NIT) break;
        if (i2 < NIT) { da = decode(i2); titem_load(va, da, C.lane); }
        titem_store(vb, db, scr, C.lane);
        it = i2;
    }
}

template <int MODE, int SK>
__device__ __forceinline__ void ln_phase(Ctx& C, const float* src, const float* gam, const float* bet, float* dst_f32, int lsk) {
    LAS float* Aimg = (LAS float*)C.lds;
    LAS float* part = (LAS float*)(C.lds + 65792);
    LAS float* lgt = (LAS float*)(C.lds + 90368);
    constexpr int NCT = (SK == 1) ? 3 : 1;
    bf16* HB = (bf16*)(C.ws + WS_HBF);
    const bf16* Y = (const bf16*)(C.ws + B_Y); const bf16* YE = (const bf16*)(C.ws + B_YE);
    const unsigned* route = (const unsigned*)(C.ws + WS_ROUTE);
    unsigned* gcnt = (unsigned*)(C.ws + WS_CTL) + CW_CNT + 64 * (lsk >> 1);
    const int lane = C.lane, rr = lane & 15, q = lane >> 4;
    LAS float* gl = (LAS float*)(C.lds + 92160);
    if (C.tid < 256) { *(LAS f32x4*)(gl + 4 * C.tid) = *(const f32x4*)(gam + 4 * C.tid); *(LAS f32x4*)(gl + 1024 + 4 * C.tid) = *(const f32x4*)(bet + 4 * C.tid); }
    __syncthreads();
    const float* Wc[NCT]; size_t ldw = 0; bool wvalid = true;
    if (SK == 1) { const float* w_in = C.in[3] + (size_t)lsk * D * DPROJ; ldw = DPROJ;
#pragma unroll
        for (int ct = 0; ct < NCT; ++ct) Wc[ct] = w_in + (ct < 2 ? 2560 + 16 * ct + rr : 7200 + rr); }
    else if (SK == 2) { Wc[0] = C.in[25] + (size_t)(lsk >> 1) * D * NEXP + (rr & 7); ldw = NEXP; wvalid = rr < 8; }
    else { Wc[0] = nullptr; }
    float bw[32][NCT];
    if (SK != 0) {
#pragma unroll
        for (int ks = 0; ks < 32; ++ks)
#pragma unroll
            for (int ct = 0; ct < NCT; ++ct) bw[ks][ct] = wvalid ? Wc[ct][(size_t)(128 * C.wave + q + 4 * ks) * ldw] : 0.f;
    }
    constexpr size_t YELIM = (size_t)32768 * D;
    constexpr bool PREY = true;
    f32x4 rx[2][4]; u32x2 ra[2][4], rb[2][4], rh[2][4];
    auto load_rows = [&](int it2) {
#pragma unroll
        for (int r = 0; r < 2; ++r) {
            const size_t ro = (size_t)(it2 * 16 + C.wave * 2 + r) * D + 4 * lane;
#pragma unroll
            for (int j = 0; j < 4; ++j) {
                if (MODE == 0) rx[r][j] = *(const f32x4*)(src + ro + 256 * j);
                else if (MODE == 1 || MODE == 2) ra[r][j] = *(const u32x2*)(Y + ro + 256 * j);
                else { const unsigned* rt = route + (size_t)(it2 * 16 + C.wave * 2 + r) * 8; const size_t o0 = (size_t)rt[6] * D, o1 = (size_t)rt[7] * D;
                    rh[r][j] = *(const u32x2*)(HB + ro + 256 * j);
                    if (PREY && o0 < YELIM) ra[r][j] = *(const u32x2*)(YE + o0 + 4 * lane + 256 * j);
                    if (PREY && o1 < YELIM) rb[r][j] = *(const u32x2*)(YE + o1 + 4 * lane + 256 * j); }
            }
        }
    };
    constexpr bool EARLY = (SK == 0);
    if (C.blk < T / 16) load_rows(C.blk);
    for (int it = C.blk; it < T / 16; it += C.G) {
        const int row0 = it * 16 + C.wave * 2;
        const int itn = it + C.G; const bool hasn = itn < T / 16;
        f32x4 vv[2][4];
#pragma unroll
        for (int r = 0; r < 2; ++r) {
            if (MODE == 0) {
#pragma unroll
                for (int j = 0; j < 4; ++j) vv[r][j] = rx[r][j];
            } else if (MODE == 1 || MODE == 2) {
#pragma unroll
                for (int j = 0; j < 4; ++j) { const u32x2 yw = ra[r][j]; vv[r][j] = (f32x4){bflo(yw.x), bfhi(yw.x), bflo(yw.y), bfhi(yw.y)}; }
            } else {
                const unsigned* rt = route + (size_t)(row0 + r) * 8; const size_t o0 = (size_t)rt[6] * D, o1 = (size_t)rt[7] * D; const float g0 = __builtin_bit_cast(float, rt[4]), g1 = __builtin_bit_cast(float, rt[5]);
#pragma unroll
                for (int j = 0; j < 4; ++j) {
                    const u32x2 hw = rh[r][j];
                    f32x4 y0, y1;
                    if (o0 < YELIM) { const u32x2 w0 = PREY ? ra[r][j] : *(const u32x2*)(YE + o0 + 4 * lane + 256 * j); y0 = (f32x4){bflo(w0.x), bfhi(w0.x), bflo(w0.y), bfhi(w0.y)}; }
                    else { const float* pp = (const float*)(C.ws + B_PART) + (o0 - YELIM) + 4 * lane + 256 * j; y0 = *(const f32x4*)pp;
#pragma unroll
                        for (int kp = 1; kp < 7; ++kp) y0 += *(const f32x4*)(pp + (size_t)kp * 2048 * D);
                        { const unsigned a_ = pk2(y0[0], y0[1]), b_ = pk2(y0[2], y0[3]); y0 = (f32x4){bflo(a_), bfhi(a_), bflo(b_), bfhi(b_)}; } }
                    if (o1 < YELIM) { const u32x2 w1 = PREY ? rb[r][j] : *(const u32x2*)(YE + o1 + 4 * lane + 256 * j); y1 = (f32x4){bflo(w1.x), bfhi(w1.x), bflo(w1.y), bfhi(w1.y)}; }
                    else { const float* pp = (const float*)(C.ws + B_PART) + (o1 - YELIM) + 4 * lane + 256 * j; y1 = *(const f32x4*)pp;
#pragma unroll
                        for (int kp = 1; kp < 7; ++kp) y1 += *(const f32x4*)(pp + (size_t)kp * 2048 * D);
                        { const unsigned a_ = pk2(y1[0], y1[1]), b_ = pk2(y1[2], y1[3]); y1 = (f32x4){bflo(a_), bfhi(a_), bflo(b_), bfhi(b_)}; } }
                    vv[r][j] = ALPHA * (f32x4){bflo(hw.x), bfhi(hw.x), bflo(hw.y), bfhi(hw.y)} + g0 * y0 + g1 * y1;
                }
            }
        }
        if (EARLY && hasn) load_rows(itn);
#pragma unroll
        for (int r = 0; r < 2; ++r) {
            const int row = row0 + r;
            f32x4 v[4];
#pragma unroll
            for (int j = 0; j < 4; ++j) v[j] = vv[r][j];
            float s = 0.f;
#pragma unroll
            for (int j = 0; j < 4; ++j) s += (v[j].x + v[j].y) + (v[j].z + v[j].w);
            const float mean = wave_sum(s) * (1.f / D); float s2 = 0.f;
#pragma unroll
            for (int j = 0; j < 4; ++j) { v[j] = v[j] - mean; s2 += (v[j].x * v[j].x + v[j].y * v[j].y) + (v[j].z * v[j].z + v[j].w * v[j].w); }
            const float rstd = 1.f / sqrtf(wave_sum(s2) * (1.f / D) + LN_EPS);
#pragma unroll
            for (int j = 0; j < 4; ++j) {
                const f32x4 o = v[j] * rstd * *(const LAS f32x4*)(gl + 4 * lane + 256 * j) + *(const LAS f32x4*)(gl + 1024 + 4 * lane + 256 * j);
                if (dst_f32) *(f32x4*)(dst_f32 + (size_t)row * D + 4 * lane + 256 * j) = o;
                u32x2 w; w.x = pk2(o.x, o.y); w.y = pk2(o.z, o.w);
                *(u32x2*)(HB + (size_t)row * D + 4 * lane + 256 * j) = w;
                if (SK != 0) *(LAS f32x4*)(Aimg + (C.wave * 2 + r) * 1028 + 4 * lane + 256 * j) = o;
            }
        }
        if (!EARLY && hasn) load_rows(itn);
        if (SK != 0) {
            __syncthreads();
            f32x4 acc[NCT];
#pragma unroll
            for (int ct = 0; ct < NCT; ++ct) acc[ct] = (f32x4){0.f, 0.f, 0.f, 0.f};
            const int kb = 128 * C.wave + q;
#pragma unroll
            for (int ks = 0; ks < 32; ++ks) {
                const float a = Aimg[rr * 1028 + kb + 4 * ks];
#pragma unroll
                for (int ct = 0; ct < NCT; ++ct) acc[ct] = __builtin_amdgcn_mfma_f32_16x16x4f32(a, bw[ks][ct], acc[ct], 0, 0, 0);
            }
#pragma unroll
            for (int ct = 0; ct < NCT; ++ct) *(LAS f32x4*)(part + ((C.wave * NCT + ct) * 64 + lane) * 4) = acc[ct];
            __syncthreads();
            for (int te = C.tid; te < 256 * NCT; te += NTHR) {
                const int ct = te >> 8, e = te & 255, ln = e >> 2, i = e & 3; float sum = 0.f;
#pragma unroll
                for (int w2 = 0; w2 < 8; ++w2) sum += part[((w2 * NCT + ct) * 64 + ln) * 4 + i];
                const int row = 4 * (ln >> 4) + i, col = 16 * ct + (ln & 15);
                if (SK == 1) ((float*)(C.ws + WS_GATES))[(size_t)(it * 16 + row) * NGATE + col] = sum;
                else if (col < 8) lgt[row * 8 + col] = sum;
            }
            if (SK == 2) {
                LAS int* esel = (LAS int*)(C.lds + 90368 + 512);
                __syncthreads();
                int e0 = 0, e1 = 1; float g0 = 0.f, g1 = 0.f;
                if (C.tid < 16) {
                    float my[8];
#pragma unroll
                    for (int c = 0; c < 8; ++c) my[c] = lgt[C.tid * 8 + c];
                    float v0 = my[0];
#pragma unroll
                    for (int c = 1; c < 8; ++c) if (my[c] > v0) { v0 = my[c]; e0 = c; }
                    float v1 = -3.0e38f; e1 = -1;
#pragma unroll
                    for (int c = 0; c < 8; ++c) if (c != e0 && my[c] > v1) { v1 = my[c]; e1 = c; }
                    g0 = 1.0f / (1.0f + __expf(v1 - v0)); g1 = 1.0f - g0;
                    esel[2 * C.tid] = e0; esel[2 * C.tid + 1] = e1;
                }
                __syncthreads();
                if (C.tid < 16) {
                    unsigned lr0 = 0, lr1 = 0;
                    for (int r2 = 0; r2 < C.tid; ++r2) { const int a0 = esel[2 * r2], a1 = esel[2 * r2 + 1]; lr0 += (a0 == e0) + (a1 == e0); lr1 += (a0 == e1) + (a1 == e1); }
                    unsigned* rt = (unsigned*)(C.ws + WS_ROUTE) + (size_t)(it * 16 + C.tid) * 8;
                    rt[0] = (unsigned)e0; rt[1] = (unsigned)e1; rt[2] = lr0; rt[3] = lr1; rt[4] = __builtin_bit_cast(unsigned, g0); rt[5] = __builtin_bit_cast(unsigned, g1);
                } else if (C.tid >= 64 && C.tid < 72) {
                    const int e = C.tid - 64; unsigned hcount = 0;
                    for (int i = 0; i < 32; ++i) hcount += (esel[i] == e);
                    ((unsigned*)(C.ws + WS_ROUTE + 524288))[it * 8 + e] = hcount;
                }
            }
            __syncthreads();
        }
    }
}

__device__ __forceinline__ int moe_cum_table(Ctx& C, int lm, bool moe) {
    if (C.tid == 0) {
        const unsigned* gcnt = (const unsigned*)(C.ws + WS_CTL) + CW_CNT + 64 * lm; int acc = 0;
        for (int e = 0; e < 8; ++e) { const int nb = moe ? (int)((__hip_atomic_load(gcnt + e, __ATOMIC_RELAXED, __HIP_MEMORY_SCOPE_AGENT) + 255u) >> 8) : (e == 0 ? T / 256 : 0); acc += nb; C.misc[e] = (unsigned)acc; }
    }
    __syncthreads();
    return (int)C.misc[7];
}
__device__ __forceinline__ void moe_dispatch(Ctx& C, int lm) {
    LAS unsigned* P = (LAS unsigned*)C.lds;
    LAS unsigned* segs = (LAS unsigned*)(C.lds + 32768);
    const unsigned* IH = (const unsigned*)(C.ws + WS_ROUTE + 524288);
    for (int i = C.tid; i < 8192 / 4; i += NTHR) *(LAS u32x4*)(P + 4 * i) = *(const u32x4*)(IH + 4 * i);
    __syncthreads();
    {
        const int e = C.tid & 7, seg = C.tid >> 3; unsigned run = 0;
        for (int i = 0; i < 16; ++i) { const int idx = (seg * 16 + i) * 8 + e; const unsigned v = P[idx]; P[idx] = run; run += v; }
        segs[seg * 8 + e] = run;
    }
    __syncthreads();
    if (C.tid < 8) { unsigned run = 0; for (int sgi = 0; sgi < 64; ++sgi) { const unsigned v = segs[sgi * 8 + C.tid]; segs[sgi * 8 + C.tid] = run; run += v; }
        C.misc[16 + C.tid] = run;
        if (C.blk == 0) __hip_atomic_store((unsigned*)(C.ws + WS_CTL) + CW_CNT + 64 * lm + C.tid, run, __ATOMIC_RELAXED, __HIP_MEMORY_SCOPE_AGENT); }
    __syncthreads();
    { const int e = C.tid & 7, seg = C.tid >> 3; const unsigned off = segs[seg * 8 + e];
      for (int i = 0; i < 16; ++i) P[(seg * 16 + i) * 8 + e] += off; }
    if (C.tid == 0) { int acc = 0; for (int e = 0; e < 8; ++e) { acc += (int)((C.misc[16 + e] + 255u) >> 8); C.misc[e] = (unsigned)acc; } }
    __syncthreads();
    unsigned* route = (unsigned*)(C.ws + WS_ROUTE); const bf16* HB = (const bf16*)(C.ws + WS_HBF); bf16* XS = (bf16*)(C.ws + B_XS);
    const int gw = C.blk * NWAVES + C.wave, NGW = C.G * NWAVES;
    for (int t = gw; t < T; t += NGW) {
        unsigned* rt = route + (size_t)t * 8;
        const unsigned e0 = rt[0], e1 = rt[1]; const int it = t >> 4;
        const unsigned d0 = (e0 ? C.misc[e0 - 1] : 0u) * 256u + P[it * 8 + e0] + rt[2], d1 = (e1 ? C.misc[e1 - 1] : 0u) * 256u + P[it * 8 + e1] + rt[3];
        if (C.lane == 0) { rt[6] = d0; rt[7] = d1; }
        const u32x4* s = (const u32x4*)(HB + (size_t)t * D); u32x4* p0 = (u32x4*)(XS + (size_t)d0 * D); u32x4* p1 = (u32x4*)(XS + (size_t)d1 * D);
        const u32x4 a = s[C.lane], b = s[C.lane + 64];
        p0[C.lane] = a; p0[C.lane + 64] = b; p1[C.lane] = a; p1[C.lane + 64] = b;
    }
}

__device__ __forceinline__ void conv_phase(Ctx& C, int l) {
    const bf16* XR = (const bf16*)(C.ws + B_XBCR); const bf16* QR = (const bf16*)(C.ws + B_MQKR); bf16* XC = (bf16*)(C.ws + B_XBCC); bf16* QC = (bf16*)(C.ws + B_MQKC);
    const float* cw1 = C.in[4] + (size_t)l * 5 * 1536; const float* cb1 = C.in[5] + (size_t)l * 1536;
    const float* cw2 = C.in[12] + (size_t)l * 5 * 1024; const float* cb2 = C.in[13] + (size_t)l * 1024;
    const int NIT = (T / 8) * 320;
    for (int it = C.blk * NTHR + C.tid; it < NIT; it += C.G * NTHR) {
        const int tb = it / 320, gi = it - tb * 320; const int tok0 = tb * 8, t0 = tok0 & (SEQ - 1);
        const bool second = gi >= 192; const int c0 = second ? (gi - 192) * 8 : gi * 8; const int ld = second ? 1024 : 1536;
        const bf16* src = (second ? QR : XR) + c0; const float* cw = (second ? cw2 : cw1) + c0; const float* cb = (second ? cb2 : cb1) + c0;
        float wk[5][8], bias[8];
#pragma unroll
        for (int k = 0; k < 5; ++k) { const f32x4 wa = *(const f32x4*)(cw + (size_t)k * ld), wb = *(const f32x4*)(cw + (size_t)k * ld + 4);
            wk[k][0] = wa.x; wk[k][1] = wa.y; wk[k][2] = wa.z; wk[k][3] = wa.w; wk[k][4] = wb.x; wk[k][5] = wb.y; wk[k][6] = wb.z; wk[k][7] = wb.w; }
        { const f32x4 ba = *(const f32x4*)cb, bb = *(const f32x4*)(cb + 4); bias[0] = ba.x; bias[1] = ba.y; bias[2] = ba.z; bias[3] = ba.w; bias[4] = bb.x; bias[5] = bb.y; bias[6] = bb.z; bias[7] = bb.w; }
        u32x4 xr[12];
#pragma unroll
        for (int i = 0; i < 12; ++i) { const int tt = t0 + i - 2; xr[i] = (tt >= 0 && tt < SEQ) ? *(const u32x4*)(src + (size_t)(tok0 + i - 2) * ld) : (u32x4){0u, 0u, 0u, 0u}; }
#pragma unroll
        for (int o = 0; o < 8; ++o) {
            float acc[8];
#pragma unroll
            for (int j = 0; j < 8; ++j) acc[j] = bias[j];
#pragma unroll
            for (int k = 0; k < 5; ++k) { const u32x4 x = xr[o + k];
                acc[0] += bflo(x.x) * wk[k][0]; acc[1] += bfhi(x.x) * wk[k][1]; acc[2] += bflo(x.y) * wk[k][2]; acc[3] += bfhi(x.y) * wk[k][3];
                acc[4] += bflo(x.z) * wk[k][4]; acc[5] += bfhi(x.z) * wk[k][5]; acc[6] += bflo(x.w) * wk[k][6]; acc[7] += bfhi(x.w) * wk[k][7]; }
            u32x4 ov; ov.x = pk2(siluf_(acc[0]), siluf_(acc[1])); ov.y = pk2(siluf_(acc[2]), siluf_(acc[3])); ov.z = pk2(siluf_(acc[4]), siluf_(acc[5])); ov.w = pk2(siluf_(acc[6]), siluf_(acc[7]));
            *(u32x4*)((second ? QC : XC) + (size_t)(tok0 + o) * ld + c0) = ov;
        }
    }
    u32x4* z = (u32x4*)(C.ws + B_YBUF); const size_t NZ = (FAST_SSD && FAST_HG && FAST_ML) ? 0 : (size_t)160 * MiB / 16;
    for (size_t i = (size_t)C.blk * NTHR + C.tid; i < NZ; i += (size_t)C.G * NTHR) z[i] = (u32x4){0u, 0u, 0u, 0u};
}

__device__ __forceinline__ void naive_mixers(Ctx& C, int l) {
    const float* Gt = (const float*)(C.ws + WS_GATES);
    const bf16* XC = (const bf16*)(C.ws + B_XBCC); const bf16* QC = (const bf16*)(C.ws + B_MQKC);
    const bf16* HQ = (const bf16*)(C.ws + B_HQ); const bf16* HFR = (const bf16*)(C.ws + B_HFR); const bf16* HI = (const bf16*)(C.ws + B_HI); const bf16* MV = (const bf16*)(C.ws + B_MV);
    float* YB = (float*)(C.ws + B_YBUF); float* OB = (float*)(C.ws + B_OBUF); float* HBf = (float*)(C.ws + B_HBUF);
    const int tid = C.tid;
    for (int u = C.blk; u < 96; u += C.G) {
        if ((u < 64 && FAST_SSD) || (u >= 64 && u < 80 && FAST_HG) || (u >= 80 && FAST_ML)) continue;
        if (u < 64) {
            const int b = u >> 5, dir = (u >> 4) & 1, h = u & 15, g = h >> 3;
            const int p = tid >> 3, nq = tid & 7;
            const float dtb = C.in[6][(l * 2 + dir) * 16 + h], Aneg = -__expf(C.in[7][(l * 2 + dir) * 16 + h]);
            float st[16];
#pragma unroll
            for (int i = 0; i < 16; ++i) st[i] = 0.f;
            for (int s = 0; s < SEQ; ++s) {
                const int t = dir ? (SEQ - 1 - s) : s; const size_t tok = (size_t)b * SEQ + t;
                const float dt = softplusf_(Gt[tok * NGATE + dir * 16 + h] + dtb), dec = __expf(dt * Aneg);
                const float xv = dt * bf2f(XC[tok * 1536 + h * 64 + p]);
                const u32x4 b0 = *(const u32x4*)(XC + tok * 1536 + 1024 + g * 128 + nq * 16), b1 = *(const u32x4*)(XC + tok * 1536 + 1024 + g * 128 + nq * 16 + 8);
                const u32x4 c0 = *(const u32x4*)(XC + tok * 1536 + 1280 + g * 128 + nq * 16), c1 = *(const u32x4*)(XC + tok * 1536 + 1280 + g * 128 + nq * 16 + 8);
                const unsigned bw[8] = {b0.x, b0.y, b0.z, b0.w, b1.x, b1.y, b1.z, b1.w}, cwv[8] = {c0.x, c0.y, c0.z, c0.w, c1.x, c1.y, c1.z, c1.w};
                float y = 0.f;
#pragma unroll
                for (int i = 0; i < 8; ++i) {
                    st[2 * i] = st[2 * i] * dec + xv * bflo(bw[i]); st[2 * i + 1] = st[2 * i + 1] * dec + xv * bfhi(bw[i]);
                    y += st[2 * i] * bflo(cwv[i]) + st[2 * i + 1] * bfhi(cwv[i]);
                }
                y += __shfl_xor(y, 1); y += __shfl_xor(y, 2); y += __shfl_xor(y, 4);
                if (nq == 0) atomicAdd(YB + tok * 1024 + h * 64 + p, y);
            }
        } else if (u < 80) {
            const int uu = u - 64, b = uu >> 3, dir = (uu >> 2) & 1, hd = uu & 3;
            const int v = tid >> 2, kq = tid & 3;
            float st[32], oml[32];
#pragma unroll
            for (int i = 0; i < 32; ++i) {
                const int ch = hd * 128 + kq * 32 + i;
                const float x0 = C.in[10][0 * 512 + ch], x1 = C.in[10][1 * 512 + ch], x2 = C.in[10][2 * 512 + ch], x3 = C.in[10][3 * 512 + ch];
                const float mx = fmaxf(fmaxf(x0, x1), fmaxf(x2, x3)); const float e0 = __expf(x0 - mx), e1 = __expf(x1 - mx), e2 = __expf(x2 - mx), e3 = __expf(x3 - mx); const float inv = 1.0f / (e0 + e1 + e2 + e3);
                float lb = 0.f; if (l >= 1) lb += e1 * inv; if (l >= 2) lb += e2 * inv; if (l >= 3) lb += e3 * inv;
                oml[i] = 1.0f - lb; st[i] = 0.f;
            }
            for (int s = 0; s < SEQ; ++s) {
                const int t = dir ? (SEQ - 1 - s) : s; const size_t tok = (size_t)b * SEQ + t;
                const float vv = bf2f(HI[tok * 512 + hd * 128 + v]);
                float o = 0.f;
#pragma unroll
                for (int c4 = 0; c4 < 4; ++c4) {
                    const u32x4 fw = *(const u32x4*)(HFR + tok * 1024 + dir * 512 + hd * 128 + kq * 32 + c4 * 8);
                    const u32x4 qw = *(const u32x4*)(HQ + tok * 512 + hd * 128 + kq * 32 + c4 * 8);
                    const unsigned fa[4] = {fw.x, fw.y, fw.z, fw.w}, qa[4] = {qw.x, qw.y, qw.z, qw.w};
#pragma unroll
                    for (int i = 0; i < 4; ++i) {
                        const int k0 = c4 * 8 + 2 * i;
                        const float key0 = oml[k0] * sigmoidf_(-bflo(fa[i])), key1 = oml[k0 + 1] * sigmoidf_(-bfhi(fa[i]));
                        st[k0] = (1.0f - key0) * st[k0] + key0 * vv; st[k0 + 1] = (1.0f - key1) * st[k0 + 1] + key1 * vv;
                        o += siluf_(bflo(qa[i])) * st[k0] + siluf_(bfhi(qa[i])) * st[k0 + 1];
                    }
                }
                o += __shfl_xor(o, 1); o += __shfl_xor(o, 2);
                if (kq == 0) atomicAdd(OB + tok * 512 + hd * 128 + v, o);
            }
        } else {
            const int uu = u - 80, b = uu >> 3, dir = (uu >> 2) & 1, hd = uu & 3;
            const int v = tid >> 2, kq = tid & 3;
            const float igb = C.in[14][(l * 2 + dir) * 4 + hd], fgb = C.in[15][(l * 2 + dir) * 4 + hd];
            float cs[32], ns[32];
#pragma unroll
            for (int i = 0; i < 32; ++i) { cs[i] = 0.f; ns[i] = 0.f; }
            for (int s = 0; s < SEQ; ++s) {
                const int t = dir ? (SEQ - 1 - s) : s; const size_t tok = (size_t)b * SEQ + t;
                const float ei = __expf(Gt[tok * NGATE + 32 + dir * 4 + hd] + igb);
                const float f = __expf(-softplusf_(-(Gt[tok * NGATE + 40 + dir * 4 + hd] + fgb)));
                const float vv = bf2f(MV[tok * 512 + hd * 128 + v]);
                float num = 0.f, den = 0.f;
#pragma unroll
                for (int c4 = 0; c4 < 4; ++c4) {
                    const u32x4 qw = *(const u32x4*)(QC + tok * 1024 + hd * 128 + kq * 32 + c4 * 8);
                    const u32x4 kw = *(const u32x4*)(QC + tok * 1024 + 512 + hd * 128 + kq * 32 + c4 * 8);
                    const unsigned qa[4] = {qw.x, qw.y, qw.z, qw.w}, ka[4] = {kw.x, kw.y, kw.z, kw.w};
#pragma unroll
                    for (int i = 0; i < 4; ++i) {
                        const int k0 = c4 * 8 + 2 * i;
                        const float ka0 = ei * bflo(ka[i]), ka1 = ei * bfhi(ka[i]);
                        cs[k0] = f * cs[k0] + ka0 * vv; cs[k0 + 1] = f * cs[k0 + 1] + ka1 * vv;
                        ns[k0] = f * ns[k0] + ka0; ns[k0 + 1] = f * ns[k0 + 1] + ka1;
                        const float q0 = bflo(qa[i]) * 0.08838834764831845f, q1 = bfhi(qa[i]) * 0.08838834764831845f;
                        num += q0 * cs[k0] + q1 * cs[k0 + 1]; den += q0 * ns[k0] + q1 * ns[k0 + 1];
                    }
                }
                num += __shfl_xor(num, 1); num += __shfl_xor(num, 2); den += __shfl_xor(den, 1); den += __shfl_xor(den, 2);
                if (kq == 0) atomicAdd(HBf + tok * 512 + hd * 128 + v, num / fmaxf(fabsf(den), 1.0f));
            }
        }
    }
}
__device__ __forceinline__ void naive_combine(Ctx& C, int l) {
    const float* YB = (const float*)(C.ws + B_YBUF); const float* OB = (const float*)(C.ws + B_OBUF); const float* HBf = (const float*)(C.ws + B_HBUF);
    const bf16* XC = (const bf16*)(C.ws + B_XBCC); const bf16* Z = (const bf16*)(C.ws + B_Z); const bf16* HG = (const bf16*)(C.ws + B_HG); const bf16* MO = (const bf16*)(C.ws + B_MO);
    bf16* MIX = (bf16*)(C.ws + B_MIX);
    const float* dsk = C.in[8] + l * 16; const float* nw1 = C.in[9] + l * 1024; const float* nw2 = C.in[11] + l * 512; const float* nw3 = C.in[16] + l * 512;
    const int gw = C.blk * NWAVES + C.wave, NGW = C.G * NWAVES, lane = C.lane;
    for (int tok = gw; tok < T; tok += NGW) {
        if (!FAST_SSD) { float y[16]; float ss = 0.f; const int c0 = 16 * lane; const float dk = dsk[c0 >> 6];
#pragma unroll
          for (int j = 0; j < 16; ++j) { const float x = bf2f(XC[(size_t)tok * 1536 + c0 + j]); const float z = bf2f(Z[(size_t)tok * 1024 + c0 + j]);
              y[j] = (YB[(size_t)tok * 1024 + c0 + j] + x * dk) * siluf_(z); ss += y[j] * y[j]; }
#pragma unroll
          for (int o = 1; o < 32; o <<= 1) ss += __shfl_xor(ss, o);
          const float r = 1.0f / sqrtf(ss * (1.f / 512.f) + RMS_EPS);
#pragma unroll
          for (int j = 0; j < 16; ++j) MIX[(size_t)tok * 2048 + c0 + j] = (bf16)f2bf(y[j] * r * nw1[c0 + j]); }
        if (!FAST_HG) { float o[8]; float ss = 0.f; const int c0 = 8 * lane;
#pragma unroll
          for (int j = 0; j < 8; ++j) { o[j] = OB[(size_t)tok * 512 + c0 + j]; ss += o[j] * o[j]; }
#pragma unroll
          for (int q = 1; q < 16; q <<= 1) ss += __shfl_xor(ss, q);
          const float r = 1.0f / sqrtf(ss * (1.f / 128.f) + RMS_EPS);
#pragma unroll
          for (int j = 0; j < 8; ++j) MIX[(size_t)tok * 2048 + 1024 + c0 + j] = (bf16)f2bf(o[j] * r * nw2[c0 + j] * siluf_(bf2f(HG[(size_t)tok * 512 + c0 + j]))); }
        if (!FAST_ML) { float o[8]; float s = 0.f; const int c0 = 8 * lane;
#pragma unroll
          for (int j = 0; j < 8; ++j) { o[j] = HBf[(size_t)tok * 512 + c0 + j]; s += o[j]; }
#pragma unroll
          for (int q = 1; q < 16; q <<= 1) s += __shfl_xor(s, q);
          const float mean = s * (1.f / 128.f); float ss = 0.f;
#pragma unroll
          for (int j = 0; j < 8; ++j) { o[j] -= mean; ss += o[j] * o[j]; }
#pragma unroll
          for (int q = 1; q < 16; q <<= 1) ss += __shfl_xor(ss, q);
          const float r = 1.0f / sqrtf(ss * (1.f / 128.f) + LN_EPS);
#pragma unroll
          for (int j = 0; j < 8; ++j) MIX[(size_t)tok * 2048 + 1536 + c0 + j] = (bf16)f2bf(o[j] * r * nw3[c0 + j] * sigmoidf_(bf2f(MO[(size_t)tok * 512 + c0 + j]))); }
    }
}


#define MFMA16(a, b, c) __builtin_amdgcn_mfma_f32_16x16x32_bf16((a), (b), (c), 0, 0, 0)
__device__ __forceinline__ unsigned lds_addr(const LAS unsigned char* p) { return (unsigned)(size_t)p; }
__device__ __forceinline__ bf16x8 frag_row(const LAS unsigned char* img, int stride, int row, int kel) { return *(const LAS bf16x8*)(img + row * stride + kel * 2); }
__device__ __forceinline__ bf16x8 tr2(unsigned a0, unsigned a1) {
    s16x4 lo, hi;
    asm volatile("ds_read_b64_tr_b16 %0, %2\n\tds_read_b64_tr_b16 %1, %3\n\ts_waitcnt lgkmcnt(0)" : "=&v"(lo), "=&v"(hi) : "v"(a0), "v"(a1) : "memory");
    return __builtin_shufflevector(lo, hi, 0, 1, 2, 3, 4, 5, 6, 7);
}
template <int DB>
__device__ __forceinline__ void tr_quad(unsigned a, bf16x8& f0, bf16x8& f1, bf16x8& f2, bf16x8& f3) {
    s16x4 l0, h0, l1, h1, l2, h2, l3, h3;
    asm volatile("ds_read_b64_tr_b16 %0, %8\n\tds_read_b64_tr_b16 %1, %8 offset:%9\n\tds_read_b64_tr_b16 %2, %8 offset:32\n\tds_read_b64_tr_b16 %3, %8 offset:%10\n\t"
                 "ds_read_b64_tr_b16 %4, %8 offset:64\n\tds_read_b64_tr_b16 %5, %8 offset:%11\n\tds_read_b64_tr_b16 %6, %8 offset:96\n\tds_read_b64_tr_b16 %7, %8 offset:%12\n\ts_waitcnt lgkmcnt(0)"
                 : "=&v"(l0), "=&v"(h0), "=&v"(l1), "=&v"(h1), "=&v"(l2), "=&v"(h2), "=&v"(l3), "=&v"(h3)
                 : "v"(a), "n"(DB), "n"(DB + 32), "n"(DB + 64), "n"(DB + 96) : "memory");
    f0 = __builtin_shufflevector(l0, h0, 0, 1, 2, 3, 4, 5, 6, 7); f1 = __builtin_shufflevector(l1, h1, 0, 1, 2, 3, 4, 5, 6, 7);
    f2 = __builtin_shufflevector(l2, h2, 0, 1, 2, 3, 4, 5, 6, 7); f3 = __builtin_shufflevector(l3, h3, 0, 1, 2, 3, 4, 5, 6, 7);
}
template <bool ACC, int STRIDE>
__device__ __forceinline__ void frag_tr4(unsigned img, int k0, int n0, int r, int q, bf16x8 (&f)[4]) {
    const unsigned a = img + (k0 + (ACC ? 4 : 8) * q + (r >> 2)) * STRIDE + (n0 + 4 * (r & 3)) * 2;
    tr_quad<(ACC ? 16 : 4) * STRIDE>(a, f[0], f[1], f[2], f[3]);
}
__device__ __forceinline__ bf16x8 frag_tr(unsigned img, int stride, int k0, int n0, int r, int q) { const unsigned a = img + (k0 + 8 * q + (r >> 2)) * stride + (n0 + 4 * (r & 3)) * 2; return tr2(a, a + 4 * stride); }
__device__ __forceinline__ bf16x8 frag_tr_acc(unsigned img, int stride, int k0, int n0, int r, int q) { const unsigned a = img + (k0 + 4 * q + (r >> 2)) * stride + (n0 + 4 * (r & 3)) * 2; return tr2(a, a + 16 * stride); }
__device__ __forceinline__ bf16x8 pack8(const float (&v)[8]) { u32x4 w; w.x = pk2(v[0], v[1]); w.y = pk2(v[2], v[3]); w.z = pk2(v[4], v[5]); w.w = pk2(v[6], v[7]); return __builtin_bit_cast(bf16x8, w); }
__device__ __forceinline__ void unpack8(const bf16x8 f, float (&v)[8]) { const u32x4 w = __builtin_bit_cast(u32x4, f); v[0] = bflo(w.x); v[1] = bfhi(w.x); v[2] = bflo(w.y); v[3] = bfhi(w.y); v[4] = bflo(w.z); v[5] = bfhi(w.z); v[6] = bflo(w.w); v[7] = bfhi(w.w); }
__device__ __forceinline__ u32x2 pack4(const f32x4 v) { u32x2 w; w.x = pk2(v[0], v[1]); w.y = pk2(v[2], v[3]); return w; }
template <int ROWS, int COLS> struct TileRegs { u32x4 v[ROWS * COLS / 8 / NTHR]; };
template <int ROWS, int COLS>
__device__ __forceinline__ void tile_gload(TileRegs<ROWS, COLS>& t, const bf16* src, size_t ld, int tid) {
    constexpr int CPR = COLS / 8, NI = ROWS * COLS / 8 / NTHR;
#pragma unroll
    for (int i = 0; i < NI; ++i) { const int idx = tid + i * NTHR, row = idx / CPR, ch = idx - row * CPR; t.v[i] = *(const u32x4*)(src + (size_t)row * ld + ch * 8); }
}
template <int ROWS, int COLS, int STRIDE>
__device__ __forceinline__ void tile_sstore(const TileRegs<ROWS, COLS>& t, LAS unsigned char* img, int tid) {
    constexpr int CPR = COLS / 8, NI = ROWS * COLS / 8 / NTHR;
#pragma unroll
    for (int i = 0; i < NI; ++i) { const int idx = tid + i * NTHR, row = idx / CPR, ch = idx - row * CPR; *(LAS u32x4*)(img + row * STRIDE + ch * 16) = t.v[i]; }
}
__device__ __forceinline__ void scan128(float a0, float a1, int lane, float& i0, float& i1, float& tot) {
    float s = a0 + a1;
#pragma unroll
    for (int o = 1; o < 64; o <<= 1) { const float t = __shfl_up(s, o); if (lane >= o) s += t; }
    i1 = s; i0 = s - a1; tot = __shfl(s, 63);
}
__device__ __forceinline__ float hg_lb(const float* lbl, int l, int ch) {
    const float x0 = lbl[0 * 512 + ch], x1 = lbl[1 * 512 + ch], x2 = lbl[2 * 512 + ch], x3 = lbl[3 * 512 + ch];
    const float mx = fmaxf(fmaxf(x0, x1), fmaxf(x2, x3)); const float e0 = __expf(x0 - mx), e1 = __expf(x1 - mx), e2 = __expf(x2 - mx), e3 = __expf(x3 - mx); const float inv = 1.0f / (e0 + e1 + e2 + e3);
    float lb = 0.f; if (l >= 1) lb += e1 * inv; if (l >= 2) lb += e2 * inv; if (l >= 3) lb += e3 * inv; return lb;
}

__device__ __forceinline__ void mix_params(Ctx& C, int l) {
    LAS float* P = (LAS float*)(C.lds + PAR_OFF);
    if (C.tid < 512) P[C.tid] = 1.0f - hg_lb(C.in[10], l, C.tid);
    if (C.tid < 32) { P[512 + C.tid] = C.in[6][l * 32 + C.tid]; P[544 + C.tid] = -__expf(C.in[7][l * 32 + C.tid]); }
    if (C.tid < 16) P[576 + C.tid] = C.in[8][l * 16 + C.tid];
    if (C.tid < 8) { P[592 + C.tid] = C.in[14][l * 8 + C.tid]; P[600 + C.tid] = C.in[15][l * 8 + C.tid]; }
    __syncthreads();
}
#define UNIT_PROLOG() Ctx C = C0_; { int ln_; asm volatile("v_mbcnt_lo_u32_b32 %0, -1, 0\n\tv_mbcnt_hi_u32_b32 %0, -1, %0" : "=v"(ln_)); C.lane = ln_; C.tid = C.wave * 64 + ln_; C.ws = (unsigned char*)C0_.in[30]; }
__device__ __forceinline__ void ssdC_seq(Ctx& C0_, int l, int u0, int nu, int ustride) { UNIT_PROLOG();
    const int tid = C.tid, lane = C.lane, w = C.wave, r = lane & 15, q = lane >> 4;
    LAS unsigned char* Bimg = C.lds; LAS unsigned char* Ximg = C.lds + 34816; LAS float* wv = (LAS float*)(C.lds + 102400);
    const bf16* XC = (const bf16*)(C.ws + B_XBCC);
    TileRegs<128, 128> tB; TileRegs<128, 256> tX;
    { const int half = u0 & 1, g = (u0 >> 1) & 1, c = (u0 >> 2) & 63, b = u0 >> 8; const size_t tok0 = (size_t)b * SEQ + c * 128;
      tile_gload(tB, XC + tok0 * 1536 + 1024 + g * 128, 1536, tid); tile_gload(tX, XC + tok0 * 1536 + (g * 8 + half * 4) * 64, 1536, tid); }
#pragma unroll 1
    for (int iu = 0; iu < nu; ++iu) {
        const int u = u0 + iu * ustride;
        const int half = u & 1, g = (u >> 1) & 1, c = (u >> 2) & 63, b = u >> 8;
        const size_t tok0 = (size_t)b * SEQ + c * 128;
        {
            const int hh = w >> 1, dir = w & 1, h = g * 8 + half * 4 + hh;
            const float dtb = ((const LAS float*)(C.lds + PAR_OFF))[512 + dir * 16 + h], Aneg = ((const LAS float*)(C.lds + PAR_OFF))[544 + dir * 16 + h];
            const float* Gt = (const float*)(C.ws + WS_GATES);
            const float d0 = softplusf_(Gt[(tok0 + 2 * lane) * NGATE + dir * 16 + h] + dtb), d1 = softplusf_(Gt[(tok0 + 2 * lane + 1) * NGATE + dir * 16 + h] + dtb);
            const float a0 = d0 * Aneg, a1 = d1 * Aneg; float i0, i1, tot; scan128(a0, a1, lane, i0, i1, tot);
            const float c0 = dir ? tot - i0 + a0 : i0, c1 = dir ? tot - i1 + a1 : i1;
            wv[w * 128 + 2 * lane] = d0 * __expf(tot - c0); wv[w * 128 + 2 * lane + 1] = d1 * __expf(tot - c1);
            if (lane == 0) ((float*)(C.ws + B_DECS))[((b * 64 + c) * 2 + dir) * 16 + h] = __expf(tot);
        }
        tile_sstore<128, 128, 272>(tB, Bimg, tid); tile_sstore<128, 256, 528>(tX, Ximg, tid);
        if (iu + 1 < nu) {
            const int u2 = u + ustride; const int half2 = u2 & 1, g2 = (u2 >> 1) & 1, c2 = (u2 >> 2) & 63, b2 = u2 >> 8; const size_t tk2 = (size_t)b2 * SEQ + c2 * 128;
            tile_gload(tB, XC + tk2 * 1536 + 1024 + g2 * 128, 1536, tid); tile_gload(tX, XC + tk2 * 1536 + (g2 * 8 + half2 * 4) * 64, 1536, tid);
        }
        __syncthreads();
        const unsigned bimg = lds_addr(Bimg), ximg = lds_addr(Ximg);
        bf16x8 bfr[4];
#pragma unroll
        for (int ks = 0; ks < 4; ++ks) bfr[ks] = frag_tr(bimg, 272, 32 * ks, 16 * w, r, q);
        bf16* ST = (bf16*)(C.ws + B_STS);
#pragma unroll 1
        for (int hh = 0; hh < 4; ++hh) {
            const int h = g * 8 + half * 4 + hh;
            f32x4 acc[2][4];
#pragma unroll
            for (int d = 0; d < 2; ++d)
#pragma unroll
                for (int pt = 0; pt < 4; ++pt) acc[d][pt] = (f32x4){0.f, 0.f, 0.f, 0.f};
#pragma unroll
            for (int ks = 0; ks < 4; ++ks) {
                bf16x8 xf[4]; frag_tr4<false, 528>(ximg, 32 * ks, hh * 64, r, q, xf);
                float bv[8]; unpack8(bfr[ks], bv);
#pragma unroll
                for (int d = 0; d < 2; ++d) {
                    const f32x4 w0 = *(const LAS f32x4*)(wv + (hh * 2 + d) * 128 + 32 * ks + 8 * q), w1 = *(const LAS f32x4*)(wv + (hh * 2 + d) * 128 + 32 * ks + 8 * q + 4);
                    float sv[8] = {bv[0] * w0.x, bv[1] * w0.y, bv[2] * w0.z, bv[3] * w0.w, bv[4] * w1.x, bv[5] * w1.y, bv[6] * w1.z, bv[7] * w1.w};
                    const bf16x8 bs = pack8(sv);
#pragma unroll
                    for (int pt = 0; pt < 4; ++pt) acc[d][pt] = MFMA16(bs, xf[pt], acc[d][pt]);
                }
            }
            LAS unsigned char* Oimg = C.lds + 106496;
#pragma unroll
            for (int d = 0; d < 2; ++d) {
#pragma unroll
                for (int pt = 0; pt < 4; ++pt) *(LAS u32x2*)(Oimg + (16 * pt + r) * 272 + (16 * w + 4 * q) * 2) = pack4(acc[d][pt]);
                __syncthreads();
                bf16* dstp = ST + (size_t)(((b * 64 + c) * 2 + d) * 16 + h) * 8192;
#pragma unroll
                for (int i = 0; i < 2; ++i) { const int idx = tid + i * NTHR, row = idx >> 4, ch = idx & 15; *(u32x4*)(dstp + row * 128 + ch * 8) = *(const LAS u32x4*)(Oimg + row * 272 + ch * 16); }
                __syncthreads();
            }
        }
        __syncthreads();
    }
}
__device__ __forceinline__ void mlC_seq(Ctx& C0_, int l, int u0, int nu, int ustride) { UNIT_PROLOG();
    const int tid = C.tid, lane = C.lane, w = C.wave, r = lane & 15, q = lane >> 4;
    LAS unsigned char* Kimg = C.lds; LAS unsigned char* Vimg = C.lds + 34816; LAS float* wv = (LAS float*)(C.lds + 69632);
    TileRegs<128, 128> tK, tV;
    { const int hd = u0 & 3, c = (u0 >> 2) & 63, b = u0 >> 8; const size_t tok0 = (size_t)b * SEQ + c * 128;
      tile_gload(tK, (const bf16*)(C.ws + B_MQKC) + tok0 * 1024 + 512 + hd * 128, 1024, tid); tile_gload(tV, (const bf16*)(C.ws + B_MV) + tok0 * 512 + hd * 128, 512, tid); }
    float gf0 = 0.f, gf1 = 0.f, gi0 = 0.f, gi1 = 0.f;
    if (w < 2) { const int hd = u0 & 3, c = (u0 >> 2) & 63, b = u0 >> 8; const size_t tok0 = (size_t)b * SEQ + c * 128; const float* Gt = (const float*)(C.ws + WS_GATES);
        gf0 = Gt[(tok0 + 2 * lane) * NGATE + 40 + w * 4 + hd]; gf1 = Gt[(tok0 + 2 * lane + 1) * NGATE + 40 + w * 4 + hd]; gi0 = Gt[(tok0 + 2 * lane) * NGATE + 32 + w * 4 + hd]; gi1 = Gt[(tok0 + 2 * lane + 1) * NGATE + 32 + w * 4 + hd]; }
#pragma unroll 1
    for (int iu = 0; iu < nu; ++iu) {
        const int u = u0 + iu * ustride;
        const int hd = u & 3, c = (u >> 2) & 63, b = u >> 8;
        const size_t tok0 = (size_t)b * SEQ + c * 128;
        if (w < 2) {
            const int dir = w; const float igb = ((const LAS float*)(C.lds + PAR_OFF))[592 + dir * 4 + hd], fgb = ((const LAS float*)(C.lds + PAR_OFF))[600 + dir * 4 + hd];
            const float f0 = -softplusf_(-(gf0 + fgb)), f1 = -softplusf_(-(gf1 + fgb));
            const float li0 = gi0 + igb, li1 = gi1 + igb;
            float i0, i1, tot; scan128(f0, f1, lane, i0, i1, tot);
            const float c0 = dir ? tot - i0 + f0 : i0, c1 = dir ? tot - i1 + f1 : i1;
            wv[dir * 128 + 2 * lane] = __expf(tot - c0 + li0); wv[dir * 128 + 2 * lane + 1] = __expf(tot - c1 + li1);
            if (lane == 0) ((float*)(C.ws + B_DECM))[((b * 64 + c) * 2 + dir) * 4 + hd] = __expf(tot);
        }
        tile_sstore<128, 128, 272>(tK, Kimg, tid); tile_sstore<128, 128, 272>(tV, Vimg, tid);
        if (iu + 1 < nu) { const int u2 = u + ustride; const int hd2 = u2 & 3, c2 = (u2 >> 2) & 63, b2 = u2 >> 8; const size_t tk2 = (size_t)b2 * SEQ + c2 * 128;
            tile_gload(tK, (const bf16*)(C.ws + B_MQKC) + tk2 * 1024 + 512 + hd2 * 128, 1024, tid); tile_gload(tV, (const bf16*)(C.ws + B_MV) + tk2 * 512 + hd2 * 128, 512, tid);
            if (w < 2) { const float* Gt = (const float*)(C.ws + WS_GATES);
                gf0 = Gt[(tk2 + 2 * lane) * NGATE + 40 + w * 4 + hd2]; gf1 = Gt[(tk2 + 2 * lane + 1) * NGATE + 40 + w * 4 + hd2]; gi0 = Gt[(tk2 + 2 * lane) * NGATE + 32 + w * 4 + hd2]; gi1 = Gt[(tk2 + 2 * lane + 1) * NGATE + 32 + w * 4 + hd2]; } }
        __syncthreads();
        const unsigned kimg = lds_addr(Kimg), vimg = lds_addr(Vimg);
        bf16* ST = (bf16*)(C.ws + B_STM); float* NM = (float*)(C.ws + B_NM);
#pragma unroll 1
        for (int d = 0; d < 2; ++d) {
            f32x4 acc[8]; f32x4 nac = (f32x4){0.f, 0.f, 0.f, 0.f};
#pragma unroll
            for (int kt = 0; kt < 8; ++kt) acc[kt] = (f32x4){0.f, 0.f, 0.f, 0.f};
#pragma unroll 1
            for (int ks = 0; ks < 4; ++ks) {
                const f32x4 w0 = *(const LAS f32x4*)(wv + d * 128 + 32 * ks + 8 * q), w1 = *(const LAS f32x4*)(wv + d * 128 + 32 * ks + 8 * q + 4);
                const bf16x8 vf = frag_tr(vimg, 272, 32 * ks, 16 * w, r, q);
                const bf16x8 kown = frag_tr(kimg, 272, 32 * ks, 16 * w, r, q);
                bf16x8 kfa[4], kfb[4]; frag_tr4<false, 272>(kimg, 32 * ks, 0, r, q, kfa); frag_tr4<false, 272>(kimg, 32 * ks, 64, r, q, kfb);
                float vv[8]; unpack8(vf, vv);
                float wl[8] = {w0.x, w0.y, w0.z, w0.w, w1.x, w1.y, w1.z, w1.w};
                float sv[8], wlo[8];
#pragma unroll
                for (int j = 0; j < 8; ++j) sv[j] = vv[j] * wl[j];
                const bf16x8 vs = pack8(sv), whi = pack8(wl);
                { float wh[8]; unpack8(whi, wh);
#pragma unroll
                  for (int j = 0; j < 8; ++j) wlo[j] = wl[j] - wh[j]; }
                const bf16x8 wlf = pack8(wlo);
#pragma unroll
                for (int kt = 0; kt < 8; ++kt) acc[kt] = MFMA16(kt < 4 ? kfa[kt & 3] : kfb[kt & 3], vs, acc[kt]);
                nac = MFMA16(kown, whi, nac); nac = MFMA16(kown, wlf, nac);
            }
            const size_t sb = (size_t)(((b * 64 + c) * 2 + d) * 4 + hd);
            LAS unsigned char* Oimg = C.lds + 71680;
#pragma unroll
            for (int kt = 0; kt < 8; ++kt) *(LAS u32x2*)(Oimg + (16 * w + r) * 272 + (16 * kt + 4 * q) * 2) = pack4(acc[kt]);
            if (r == 0) *(f32x4*)(NM + sb * 128 + 16 * w + 4 * q) = nac;
            __syncthreads();
#pragma unroll
            for (int i = 0; i < 4; ++i) { const int idx = tid + i * NTHR, row = idx >> 4, ch = idx & 15; *(u32x4*)(ST + (sb * 128 + row) * 128 + ch * 8) = *(const LAS u32x4*)(Oimg + row * 272 + ch * 16); }
            __syncthreads();
        }
    }
}
template <int MODE>
__device__ __forceinline__ float hg_gates(Ctx& C, int l, int hd, int dir, LAS float*  , LAS unsigned char* Kimg, LAS float* segtot) {
    const int k = C.tid & 127, seg = C.tid >> 7;
    const float oml = ((const LAS float*)(C.lds + PAR_OFF))[hd * 128 + k];
    __syncthreads();
    float key[16], P[16]; float run = 1.f;
#pragma unroll
    for (int i = 0; i < 16; ++i) {
        const int t = dir ? (seg * 16 + 15 - i) : (seg * 16 + i);
        key[i] = oml * sigmoidf_(-bf2f(*(const LAS bf16*)(Kimg + t * 272 + k * 2)));
        run *= 1.0f - key[i]; P[i] = run;
    }
    segtot[seg * 128 + k] = run;
    __syncthreads();
    float rest = 1.f, tot = 1.f;
#pragma unroll
    for (int s2 = 0; s2 < 4; ++s2) { const float v = segtot[s2 * 128 + k]; tot *= v; if (dir ? (s2 < seg) : (s2 > seg)) rest *= v; }
    const float R = run * rest;
#pragma unroll
    for (int i = 0; i < 16; ++i) {
        const int t = dir ? (seg * 16 + 15 - i) : (seg * 16 + i);
        *(LAS bf16*)(Kimg + t * 272 + k * 2) = (bf16)f2bf(key[i] * R * __builtin_amdgcn_rcpf(fmaxf(P[i], 1e-30f)));
    }
    __syncthreads();
    return tot;
}
__device__ __forceinline__ void hgC_seq(Ctx& C0_, int l, int u0, int nu, int ustride) { UNIT_PROLOG();
    const int tid = C.tid, lane = C.lane, w = C.wave, r = lane & 15, q = lane >> 4;
    LAS float* Gimg = (LAS float*)C.lds; LAS unsigned char* Kimg = C.lds + 33792; LAS unsigned char* Vimg = C.lds + 51200; LAS float* segtot = (LAS float*)(C.lds + 68608);
    const unsigned kimg = lds_addr(Kimg), vimg = lds_addr(Vimg);
    bf16* ST = (bf16*)(C.ws + B_STH); float* DH = (float*)(C.ws + B_DECH);
    TileRegs<64, 128> tV, tF0, tF1;
    { const int hd = u0 & 3, c = (u0 >> 2) & 127, b = u0 >> 9; const size_t tok0 = (size_t)b * SEQ + c * 64;
      tile_gload(tV, (const bf16*)(C.ws + B_HI) + tok0 * 512 + hd * 128, 512, tid);
      tile_gload(tF0, (const bf16*)(C.ws + B_HFR) + tok0 * 1024 + hd * 128, 1024, tid); tile_gload(tF1, (const bf16*)(C.ws + B_HFR) + tok0 * 1024 + 512 + hd * 128, 1024, tid); }
#pragma unroll 1
    for (int iu = 0; iu < nu; ++iu) {
        const int u = u0 + iu * ustride;
        const int hd = u & 3, c = (u >> 2) & 127, b = u >> 9;
        tile_sstore<64, 128, 272>(tV, Vimg, tid);
#pragma unroll
        for (int d = 0; d < 2; ++d) {
            tile_sstore<64, 128, 272>(d ? tF1 : tF0, Kimg, tid);
            if (d == 1 && iu + 1 < nu) {
                const int u2 = u + ustride; const int hd2 = u2 & 3, c2 = (u2 >> 2) & 127, b2 = u2 >> 9; const size_t tk2 = (size_t)b2 * SEQ + c2 * 64;
                tile_gload(tV, (const bf16*)(C.ws + B_HI) + tk2 * 512 + hd2 * 128, 512, tid);
                tile_gload(tF0, (const bf16*)(C.ws + B_HFR) + tk2 * 1024 + hd2 * 128, 1024, tid); tile_gload(tF1, (const bf16*)(C.ws + B_HFR) + tk2 * 1024 + 512 + hd2 * 128, 1024, tid);
            }
            const float dec = hg_gates<1>(C, l, hd, d, Gimg, Kimg, segtot);
            const size_t sb = (size_t)(((b * 128 + c) * 2 + d) * 4 + hd);
            if (tid < 128) DH[sb * 128 + tid] = dec;
            f32x4 acc[8];
#pragma unroll
            for (int kt = 0; kt < 8; ++kt) acc[kt] = (f32x4){0.f, 0.f, 0.f, 0.f};
#pragma unroll
            for (int ks = 0; ks < 2; ++ks) {
                const bf16x8 vf = frag_tr(vimg, 272, 32 * ks, 16 * w, r, q);
                bf16x8 kfa[4], kfb[4]; frag_tr4<false, 272>(kimg, 32 * ks, 0, r, q, kfa); frag_tr4<false, 272>(kimg, 32 * ks, 64, r, q, kfb);
#pragma unroll
                for (int kt = 0; kt < 8; ++kt) acc[kt] = MFMA16(kt < 4 ? kfa[kt & 3] : kfb[kt & 3], vf, acc[kt]);
            }
            LAS unsigned char* Oimg = C.lds + 71680;
#pragma unroll
            for (int kt = 0; kt < 8; ++kt) *(LAS u32x2*)(Oimg + (16 * w + r) * 272 + (16 * kt + 4 * q) * 2) = pack4(acc[kt]);
            __syncthreads();
#pragma unroll
            for (int i = 0; i < 4; ++i) { const int idx = tid + i * NTHR, row = idx >> 4, ch = idx & 15; *(u32x4*)(ST + (sb * 128 + row) * 128 + ch * 8) = *(const LAS u32x4*)(Oimg + row * 272 + ch * 16); }
            __syncthreads();
        }
    }
}
__device__ __forceinline__ void deal_range(int blk, int G, int lo, int hi, int& first, int& cnt) {
    int j0 = (lo > blk) ? (lo - blk + G - 1) / G : 0; const int u0 = blk + j0 * G;
    if (u0 >= hi) { first = 0; cnt = 0; return; }
    first = u0 - lo; cnt = (hi - 1 - u0) / G + 1;
}
__device__ __forceinline__ void mixC_phase(Ctx& C, int l) {
    int f, n;
    mix_params(C, l);
    if (FAST_SSD) { deal_range(C.blk, C.G, 0, 512, f, n); if (n) ssdC_seq(C, l, f, n, C.G); }
    if (FAST_ML) { deal_range(C.blk, C.G, 512, 1024, f, n); if (n) mlC_seq(C, l, f, n, C.G); }
    if (FAST_HG) { deal_range(C.blk, C.G, 1024, 2048, f, n); if (n) hgC_seq(C, l, f, n, C.G); }
}

template <int NCH, int DECMODE  >
__device__ __forceinline__ void scan_items(bf16* ST, const float* DEC, size_t base, size_t cstride, size_t dbase, size_t dstride, int dir) {
    constexpr int PF = (DECMODE == 0) ? 8 : 8;
    float run[8];
#pragma unroll
    for (int j = 0; j < 8; ++j) run[j] = 0.f;
    u32x4 Lb[PF]; f32x4 Da[PF], Db[PF]; float Ds[PF];
#pragma unroll
    for (int j = 0; j < PF; ++j) { const int c = dir ? NCH - 1 - j : j; Lb[j] = *(const u32x4*)(ST + base + c * cstride);
        if (DECMODE == 0) Ds[j] = DEC[dbase + c * dstride]; else { Da[j] = *(const f32x4*)(DEC + dbase + c * dstride); Db[j] = *(const f32x4*)(DEC + dbase + c * dstride + 4); } }
#pragma unroll 1
    for (int st = 0; st < NCH; st += PF) {
#pragma unroll
        for (int j = 0; j < PF; ++j) {
            const int c = dir ? NCH - 1 - (st + j) : st + j;
            u32x4 o; o.x = pk2(run[0], run[1]); o.y = pk2(run[2], run[3]); o.z = pk2(run[4], run[5]); o.w = pk2(run[6], run[7]);
            const u32x4 L = Lb[j]; f32x4 da, db; float d = 0.f;
            if (DECMODE == 0) d = Ds[j]; else { da = Da[j]; db = Db[j]; }
            if (st + j + PF < NCH) { const int c2 = dir ? NCH - 1 - (st + j + PF) : st + j + PF; Lb[j] = *(const u32x4*)(ST + base + c2 * cstride);
                if (DECMODE == 0) Ds[j] = DEC[dbase + c2 * dstride]; else { Da[j] = *(const f32x4*)(DEC + dbase + c2 * dstride); Db[j] = *(const f32x4*)(DEC + dbase + c2 * dstride + 4); } }
            *(u32x4*)(ST + base + c * cstride) = o;
            if (DECMODE == 0) {
                run[0] = run[0] * d + bflo(L.x); run[1] = run[1] * d + bfhi(L.x); run[2] = run[2] * d + bflo(L.y); run[3] = run[3] * d + bfhi(L.y);
                run[4] = run[4] * d + bflo(L.z); run[5] = run[5] * d + bfhi(L.z); run[6] = run[6] * d + bflo(L.w); run[7] = run[7] * d + bfhi(L.w);
            } else {
                run[0] = run[0] * da.x + bflo(L.x); run[1] = run[1] * da.y + bfhi(L.x); run[2] = run[2] * da.z + bflo(L.y); run[3] = run[3] * da.w + bfhi(L.y);
                run[4] = run[4] * db.x + bflo(L.z); run[5] = run[5] * db.y + bfhi(L.z); run[6] = run[6] * db.z + bflo(L.w); run[7] = run[7] * db.w + bfhi(L.w);
            }
        }
    }
}
template <int NCH, int PF>
__device__ __forceinline__ void scan_items_lds(bf16* ST, LAS const float* dl, size_t base, size_t cstride, int dir) {
    float run[8];
#pragma unroll
    for (int j = 0; j < 8; ++j) run[j] = 0.f;
    u32x4 Lb[PF];
#pragma unroll
    for (int j = 0; j < PF; ++j) { const int c = dir ? NCH - 1 - j : j; Lb[j] = *(const u32x4*)(ST + base + c * cstride); }
#pragma unroll 1
    for (int st = 0; st < NCH; st += PF) {
#pragma unroll
        for (int j = 0; j < PF; ++j) {
            const int c = dir ? NCH - 1 - (st + j) : st + j;
            u32x4 o; o.x = pk2(run[0], run[1]); o.y = pk2(run[2], run[3]); o.z = pk2(run[4], run[5]); o.w = pk2(run[6], run[7]);
            const u32x4 L = Lb[j];
            const f32x4 da = *(LAS const f32x4*)(dl + c * 128), db = *(LAS const f32x4*)(dl + c * 128 + 4);
            if (st + j + PF < NCH) { const int c2 = dir ? NCH - 1 - (st + j + PF) : st + j + PF; Lb[j] = *(const u32x4*)(ST + base + c2 * cstride); }
            *(u32x4*)(ST + base + c * cstride) = o;
            run[0] = run[0] * da.x + bflo(L.x); run[1] = run[1] * da.y + bfhi(L.x); run[2] = run[2] * da.z + bflo(L.y); run[3] = run[3] * da.w + bfhi(L.y);
            run[4] = run[4] * db.x + bflo(L.z); run[5] = run[5] * db.y + bfhi(L.z); run[6] = run[6] * db.z + bflo(L.w); run[7] = run[7] * db.w + bfhi(L.w);
        }
    }
}
__device__ __forceinline__ void scan_phase(Ctx& C) {
    for (int vb = C.blk; vb < 256; vb += C.G) {
        const int t = C.tid;
        if (FAST_HG) {
            const int seq = vb >> 4, b = seq >> 3, dir = (seq >> 2) & 1, hd = seq & 3; const float* DH = (const float*)(C.ws + B_DECH);
#pragma unroll
            for (int i = 0; i < 8; ++i) { const int idx = t + i * NTHR, c = idx >> 5, k4 = idx & 31; *(LAS f32x4*)((LAS float*)C.lds + c * 128 + k4 * 4) = *(const f32x4*)(DH + ((size_t)((b * 128 + c) * 2 + dir) * 4 + hd) * 128 + k4 * 4); }
            __syncthreads();
        }
        if (t < 256) {
            if (FAST_SSD) { const int it = vb * 256 + t, seq = it >> 10, e8 = it & 1023, b = seq >> 5, dir = (seq >> 4) & 1, h = seq & 15;
                scan_items<64, 0>((bf16*)(C.ws + B_STS), (const float*)(C.ws + B_DECS), ((size_t)(b * 64 * 2 + dir) * 16 + h) * 8192 + e8 * 8, (size_t)2 * 16 * 8192, (size_t)(b * 64 * 2 + dir) * 16 + h, 32, dir); }
        } else if (t < 384) {
            if (FAST_ML) { const int i2 = vb * 128 + (t - 256), seq = i2 >> 11, e8 = i2 & 2047, b = seq >> 3, dir = (seq >> 2) & 1, hd = seq & 3;
                scan_items<64, 0>((bf16*)(C.ws + B_STM), (const float*)(C.ws + B_DECM), ((size_t)(b * 64 * 2 + dir) * 4 + hd) * 16384 + e8 * 8, (size_t)2 * 4 * 16384, (size_t)(b * 64 * 2 + dir) * 4 + hd, 8, dir);
                if (vb < 16) {
                    const int i3 = vb * 128 + (t - 256), seq2 = i3 >> 7, k = i3 & 127, b2 = seq2 >> 3, dir2 = (seq2 >> 2) & 1, hd2 = seq2 & 3;
                    float* NM = (float*)(C.ws + B_NM); const float* DM = (const float*)(C.ws + B_DECM); float run = 0.f;
#pragma unroll 1
                    for (int s0 = 0; s0 < 64; s0 += 32) {
                        float lv[32], dd[32];
#pragma unroll
                        for (int j = 0; j < 32; ++j) { const int c = dir2 ? 63 - (s0 + j) : s0 + j; const size_t sb = (size_t)((b2 * 64 + c) * 2 + dir2) * 4 + hd2; lv[j] = NM[sb * 128 + k]; dd[j] = DM[sb]; }
#pragma unroll
                        for (int j = 0; j < 32; ++j) { const int c = dir2 ? 63 - (s0 + j) : s0 + j; const size_t sb = (size_t)((b2 * 64 + c) * 2 + dir2) * 4 + hd2; NM[sb * 128 + k] = run; run = run * dd[j] + lv[j]; }
                    }
                } }
        } else {
            if (FAST_HG) { const int i2 = vb * 128 + (t - 384), seq = i2 >> 11, e8 = i2 & 2047, b = seq >> 3, dir = (seq >> 2) & 1, hd = seq & 3;
                scan_items_lds<128, 16>((bf16*)(C.ws + B_STH), (LAS const float*)C.lds + ((e8 * 8) & 127), ((size_t)(b * 128 * 2 + dir) * 4 + hd) * 16384 + e8 * 8, (size_t)2 * 4 * 16384, dir); }
        }
        __syncthreads();
    }
}

__device__ __forceinline__ void decay_tables(float c0, float c1, int dir, int lane, LAS float* av, LAS float* VV, LAS float* WW, float& loc0, float& loc1) {
    const int I = lane >> 3;
    const float rsrc = dir ? __shfl(c0, (8 * (I + 1)) & 63) : __shfl(c1, (8 * I - 1) & 63);
    const float refI = dir ? (I < 7 ? rsrc : 0.f) : (I > 0 ? rsrc : 0.f);
    loc0 = c0 - refI; loc1 = c1 - refI;
    av[2 * lane] = __expf(loc0); av[2 * lane + 1] = __expf(loc1);
    {
        const int I2 = lane >> 3, J2 = lane & 7;
        const float ra = dir ? __shfl(c0, (8 * (I2 + 1)) & 63) : __shfl(c1, (8 * I2 - 1) & 63), rb = dir ? __shfl(c0, (8 * (J2 + 1)) & 63) : __shfl(c1, (8 * J2 - 1) & 63);
        const float rI = dir ? (I2 < 7 ? ra : 0.f) : (I2 > 0 ? ra : 0.f), rJ = dir ? (J2 < 7 ? rb : 0.f) : (J2 > 0 ? rb : 0.f);
        VV[lane] = __expf(fminf(rI - rJ, 0.f));
        if (J2 == 0) WW[I2] = __expf(rI);
    }
}
__device__ __forceinline__ void ssdE_unit(Ctx& C0_, int l, int u) { UNIT_PROLOG();
    const int g = u & 1, c = (u >> 1) & 63, b = u >> 7;
    const int tid = C.tid, lane = C.lane, w = C.wave, r = lane & 15, q = lane >> 4;
    const size_t tok0 = (size_t)b * SEQ + c * 128;
    LAS unsigned char* Cimg = C.lds; LAS unsigned char* Bimg = C.lds + 34816; LAS unsigned char* Ximg = C.lds + 34816; LAS unsigned char* S0 = C.lds + 69632;
    LAS float* av = (LAS float*)(C.lds + 104448); LAS float* bv = (LAS float*)(C.lds + 112640);
    LAS float* VV = (LAS float*)(C.lds + 120832); LAS float* WW = (LAS float*)(C.lds + 124928);
    const bf16* XC = (const bf16*)(C.ws + B_XBCC);
    TileRegs<128, 128> tB, tC; tile_gload(tB, XC + tok0 * 1536 + 1024 + g * 128, 1536, tid); tile_gload(tC, XC + tok0 * 1536 + 1280 + g * 128, 1536, tid);
    {
        const int h = g * 8 + w; const float* Gt = (const float*)(C.ws + WS_GATES);
#pragma unroll
        for (int dir = 0; dir < 2; ++dir) {
            const float dtb = ((const LAS float*)(C.lds + PAR_OFF))[512 + dir * 16 + h], Aneg = ((const LAS float*)(C.lds + PAR_OFF))[544 + dir * 16 + h];
            const float d0 = softplusf_(Gt[(tok0 + 2 * lane) * NGATE + dir * 16 + h] + dtb), d1 = softplusf_(Gt[(tok0 + 2 * lane + 1) * NGATE + dir * 16 + h] + dtb);
            const float a0 = d0 * Aneg, a1 = d1 * Aneg; float i0, i1, tot; scan128(a0, a1, lane, i0, i1, tot);
            const float c0 = dir ? tot - i0 + a0 : i0, c1 = dir ? tot - i1 + a1 : i1;
            const int hd = w * 2 + dir; float l0, l1;
            decay_tables(c0, c1, dir, lane, av + hd * 128, VV + hd * 64, WW + hd * 8, l0, l1);
            bv[hd * 128 + 2 * lane] = __expf(fminf(-l0, 80.f)) * d0; bv[hd * 128 + 2 * lane + 1] = __expf(fminf(-l1, 80.f)) * d1;
        }
    }
    tile_sstore<128, 128, 272>(tB, Bimg, tid); tile_sstore<128, 128, 272>(tC, Cimg, tid);
    __syncthreads();
    const bf16* STS = (const bf16*)(C.ws + B_STS);
    TileRegs<128, 64> tX; TileRegs<64, 128> tS0, tS1;
    tile_gload(tX, XC + tok0 * 1536 + (g * 8) * 64, 1536, tid);
    tile_gload(tS0, STS + (size_t)(((b * 64 + c) * 2 + 0) * 16 + g * 8) * 8192, 128, tid); tile_gload(tS1, STS + (size_t)(((b * 64 + c) * 2 + 1) * 16 + g * 8) * 8192, 128, tid);
    f32x4 cbT[8]; bf16x8 cfr[4];
#pragma unroll
    for (int ks = 0; ks < 4; ++ks) cfr[ks] = frag_row(Cimg, 272, 16 * w + r, 32 * ks + 8 * q);
#pragma unroll
    for (int st = 0; st < 8; ++st) { cbT[st] = (f32x4){0.f, 0.f, 0.f, 0.f};
#pragma unroll
        for (int ks = 0; ks < 4; ++ks) cbT[st] = MFMA16(frag_row(Bimg, 272, 16 * st + r, 32 * ks + 8 * q), cfr[ks], cbT[st]); }
    __syncthreads();
    const unsigned ximg = lds_addr(Ximg);
    const int lrow = 16 * w + r; const size_t tok = tok0 + lrow;
    bf16* MIX = (bf16*)(C.ws + B_MIX); const bf16* Z = (const bf16*)(C.ws + B_Z);
    float ssq = 0.f;
#pragma unroll 1
    for (int hh = 0; hh < 8; ++hh) {
        const int h = g * 8 + hh;
        tile_sstore<128, 64, 144>(tX, Ximg, tid); tile_sstore<64, 128, 272>(tS0, S0, tid); tile_sstore<64, 128, 272>(tS1, S0 + 17408, tid);
        if (hh < 7) {
            tile_gload(tX, XC + tok0 * 1536 + (h + 1) * 64, 1536, tid);
            tile_gload(tS0, STS + (size_t)(((b * 64 + c) * 2 + 0) * 16 + h + 1) * 8192, 128, tid); tile_gload(tS1, STS + (size_t)(((b * 64 + c) * 2 + 1) * 16 + h + 1) * 8192, 128, tid);
        }
        u32x2 zw4[4];
#pragma unroll
        for (int pt = 0; pt < 4; ++pt) zw4[pt] = *(const u32x2*)(Z + tok * 1024 + h * 64 + 16 * pt + 4 * q);
        const float dk = ((const LAS float*)(C.lds + PAR_OFF))[576 + h];
        __syncthreads();
        f32x4 y[4];
#pragma unroll
        for (int pt = 0; pt < 4; ++pt) y[pt] = (f32x4){0.f, 0.f, 0.f, 0.f};
        const float al0 = av[(hh * 2 + 0) * 128 + lrow], al1 = av[(hh * 2 + 1) * 128 + lrow];
#pragma unroll
        for (int ks = 0; ks < 4; ++ks) {
            bf16x8 xf[4]; frag_tr4<true, 144>(ximg, 32 * ks, 0, r, q, xf);
#pragma unroll
            for (int dir = 0; dir < 2; ++dir) {
                const bool active = dir ? (32 * ks + 31 >= 16 * w) : (32 * ks <= 16 * w + 15);
                if (active) {
                    const int hd = hh * 2 + dir;
                    const f32x4 ba = *(const LAS f32x4*)(bv + hd * 128 + 32 * ks + 4 * q), bb = *(const LAS f32x4*)(bv + hd * 128 + 32 * ks + 16 + 4 * q);
                    const float al = dir ? al1 : al0; const float va = al * VV[hd * 64 + w * 8 + 2 * ks], vb = al * VV[hd * 64 + w * 8 + 2 * ks + 1];
                    float m[8];
#pragma unroll
                    for (int j = 0; j < 8; ++j) {
                        const int s2 = 32 * ks + 16 * (j >> 2) + 4 * q + (j & 3);
                        const bool keep = dir ? (s2 >= lrow) : (s2 <= lrow);
                        m[j] = keep ? cbT[2 * ks + (j >> 2)][j & 3] * ((j < 4) ? va * ba[j & 3] : vb * bb[j & 3]) : 0.f;
                    }
                    const bf16x8 mf = pack8(m);
#pragma unroll
                    for (int pt = 0; pt < 4; ++pt) y[pt] = MFMA16(xf[pt], mf, y[pt]);
                }
            }
        }
#pragma unroll
        for (int dir = 0; dir < 2; ++dir) {
            f32x4 yo[4];
#pragma unroll
            for (int pt = 0; pt < 4; ++pt) yo[pt] = (f32x4){0.f, 0.f, 0.f, 0.f};
#pragma unroll
            for (int ks = 0; ks < 4; ++ks)
#pragma unroll
                for (int pt = 0; pt < 4; ++pt) yo[pt] = MFMA16(frag_row(S0 + dir * 17408, 272, 16 * pt + r, 32 * ks + 8 * q), cfr[ks], yo[pt]);
            const float e = (dir ? al1 : al0) * WW[(hh * 2 + dir) * 8 + w];
#pragma unroll
            for (int pt = 0; pt < 4; ++pt) y[pt] += yo[pt] * e;
        }
#pragma unroll
        for (int pt = 0; pt < 4; ++pt) {
            const u32x2 xw = *(const LAS u32x2*)(Ximg + lrow * 144 + (16 * pt + 4 * q) * 2);
            const u32x2 zw = zw4[pt];
            f32x4 v;
            v[0] = (y[pt][0] + bflo(xw.x) * dk) * siluf_(bflo(zw.x)); v[1] = (y[pt][1] + bfhi(xw.x) * dk) * siluf_(bfhi(zw.x));
            v[2] = (y[pt][2] + bflo(xw.y) * dk) * siluf_(bflo(zw.y)); v[3] = (y[pt][3] + bfhi(xw.y) * dk) * siluf_(bfhi(zw.y));
            ssq += (v[0] * v[0] + v[1] * v[1]) + (v[2] * v[2] + v[3] * v[3]);
            *(u32x2*)(MIX + tok * 2048 + h * 64 + 16 * pt + 4 * q) = pack4(v);
        }
        __syncthreads();
    }
    ssq += __shfl_xor(ssq, 16); ssq += __shfl_xor(ssq, 32);
    const float rs = 1.0f / sqrtf(ssq * (1.f / 512.f) + RMS_EPS);
    const float* nw = C.in[9] + l * 1024 + g * 512;
#pragma unroll 1
    for (int i0 = 0; i0 < 32; i0 += 16) {
        u32x2 vw[16]; f32x4 nv[16];
#pragma unroll
        for (int i = 0; i < 16; ++i) { vw[i] = *(const u32x2*)(MIX + tok * 2048 + g * 512 + (i0 + i) * 16 + 4 * q); nv[i] = *(const f32x4*)(nw + (i0 + i) * 16 + 4 * q); }
#pragma unroll
        for (int i = 0; i < 16; ++i) {
            f32x4 v; v[0] = bflo(vw[i].x) * rs * nv[i][0]; v[1] = bfhi(vw[i].x) * rs * nv[i][1]; v[2] = bflo(vw[i].y) * rs * nv[i][2]; v[3] = bfhi(vw[i].y) * rs * nv[i][3];
            *(u32x2*)(MIX + tok * 2048 + g * 512 + (i0 + i) * 16 + 4 * q) = pack4(v);
        }
    }
}
__device__ __forceinline__ void mlE_unit(Ctx& C0_, int l, int u) { UNIT_PROLOG();
    const int hd = u & 3, c = (u >> 2) & 63, b = u >> 8;
    const int tid = C.tid, lane = C.lane, w = C.wave, r = lane & 15, q = lane >> 4;
    const size_t tok0 = (size_t)b * SEQ + c * 128;
    LAS unsigned char* Qimg = C.lds; LAS unsigned char* Kimg = C.lds + 34816; LAS unsigned char* Vimg = C.lds + 69632;
    LAS float* cum = (LAS float*)(C.lds + 104448); LAS float* liv = (LAS float*)(C.lds + 105472); LAS float* nent = (LAS float*)(C.lds + 106496);
    const size_t sb0 = (size_t)(((b * 64 + c) * 2 + 0) * 4 + hd), sb1 = (size_t)(((b * 64 + c) * 2 + 1) * 4 + hd);
    TileRegs<128, 128> tS0, tS1;
    { TileRegs<128, 128> tQ, tK, tV;
      tile_gload(tQ, (const bf16*)(C.ws + B_MQKC) + tok0 * 1024 + hd * 128, 1024, tid); tile_gload(tK, (const bf16*)(C.ws + B_MQKC) + tok0 * 1024 + 512 + hd * 128, 1024, tid);
      tile_gload(tV, (const bf16*)(C.ws + B_MV) + tok0 * 512 + hd * 128, 512, tid);
      tile_gload(tS0, (const bf16*)(C.ws + B_STM) + sb0 * 16384, 128, tid); tile_gload(tS1, (const bf16*)(C.ws + B_STM) + sb1 * 16384, 128, tid);
      float gf0 = 0.f, gf1 = 0.f, gi0 = 0.f, gi1 = 0.f;
      if (w < 2) { const float* Gt = (const float*)(C.ws + WS_GATES);
          gf0 = Gt[(tok0 + 2 * lane) * NGATE + 40 + w * 4 + hd]; gf1 = Gt[(tok0 + 2 * lane + 1) * NGATE + 40 + w * 4 + hd]; gi0 = Gt[(tok0 + 2 * lane) * NGATE + 32 + w * 4 + hd]; gi1 = Gt[(tok0 + 2 * lane + 1) * NGATE + 32 + w * 4 + hd]; }
      tile_sstore<128, 128, 272>(tQ, Qimg, tid); tile_sstore<128, 128, 272>(tK, Kimg, tid); tile_sstore<128, 128, 272>(tV, Vimg, tid);
      if (w < 2) {
        const int dir = w; const float igb = ((const LAS float*)(C.lds + PAR_OFF))[592 + dir * 4 + hd], fgb = ((const LAS float*)(C.lds + PAR_OFF))[600 + dir * 4 + hd];
        const float f0 = -softplusf_(-(gf0 + fgb)), f1 = -softplusf_(-(gf1 + fgb));
        float i0, i1, tot; scan128(f0, f1, lane, i0, i1, tot);
        cum[dir * 128 + 2 * lane] = dir ? tot - i0 + f0 : i0; cum[dir * 128 + 2 * lane + 1] = dir ? tot - i1 + f1 : i1;
        liv[dir * 128 + 2 * lane] = gi0 + igb; liv[dir * 128 + 2 * lane + 1] = gi1 + igb;
      } }
    __syncthreads();
    const float SC = 0.08838834764831845f;
    f32x4 sT[8]; bf16x8 qfr[4];
#pragma unroll
    for (int ks = 0; ks < 4; ++ks) qfr[ks] = frag_row(Qimg, 272, 16 * w + r, 32 * ks + 8 * q);
#pragma unroll
    for (int st = 0; st < 8; ++st) { sT[st] = (f32x4){0.f, 0.f, 0.f, 0.f};
#pragma unroll
        for (int ks = 0; ks < 4; ++ks) sT[st] = MFMA16(frag_row(Kimg, 272, 16 * st + r, 32 * ks + 8 * q), qfr[ks], sT[st]);
        sT[st] *= SC; }
    __syncthreads();
    const unsigned vimg = lds_addr(Vimg);
    const int lrow = 16 * w + r; const size_t tok = tok0 + lrow;
    {
        tile_sstore<128, 128, 272>(tS0, Kimg, tid); tile_sstore<128, 128, 272>(tS1, Qimg, tid);
        if (tid < 256) nent[tid] = ((const float*)(C.ws + B_NM))[(tid < 128 ? sb0 : sb1) * 128 + (tid & 127)];
    }
    __syncthreads();
    const float cl0 = cum[lrow], cl1 = cum[128 + lrow];
    u32x2 ow8[8];
    { const bf16* MOp = (const bf16*)(C.ws + B_MO) + tok * 512 + hd * 128;
#pragma unroll
      for (int vt = 0; vt < 8; ++vt) ow8[vt] = *(const u32x2*)(MOp + 16 * vt + 4 * q); }
    f32x4 num[2][8]; float denp0 = 0.f, denp1 = 0.f;
#pragma unroll
    for (int d = 0; d < 2; ++d)
#pragma unroll
        for (int vt = 0; vt < 8; ++vt) num[d][vt] = (f32x4){0.f, 0.f, 0.f, 0.f};
#pragma unroll
    for (int ks = 0; ks < 4; ++ks) {
        const bool act0 = (32 * ks <= 16 * w + 15), act1 = (32 * ks + 31 >= 16 * w);
        bf16x8 mf0, mf1;
#pragma unroll
        for (int dir = 0; dir < 2; ++dir) {
            float m[8]; float ds = 0.f;
            if (dir ? act1 : act0) {
                const LAS float* cm = cum + dir * 128; const LAS float* lv = liv + dir * 128; const float cl = dir ? cl1 : cl0;
                const f32x4 ca = *(const LAS f32x4*)(cm + 32 * ks + 4 * q), cb = *(const LAS f32x4*)(cm + 32 * ks + 16 + 4 * q);
                const f32x4 la = *(const LAS f32x4*)(lv + 32 * ks + 4 * q), lb = *(const LAS f32x4*)(lv + 32 * ks + 16 + 4 * q);
#pragma unroll
                for (int j = 0; j < 8; ++j) {
                    const int s2 = 32 * ks + 16 * (j >> 2) + 4 * q + (j & 3);
                    const float cs = (j < 4) ? ca[j & 3] : cb[j & 3], ls = (j < 4) ? la[j & 3] : lb[j & 3];
                    const bool keep = dir ? (s2 >= lrow) : (s2 <= lrow);
                    m[j] = keep ? sT[2 * ks + (j >> 2)][j & 3] * __expf(cl - cs + ls) : 0.f; ds += m[j];
                }
            } else {
#pragma unroll
                for (int j = 0; j < 8; ++j) m[j] = 0.f;
            }
            if (dir) { denp1 += ds; mf1 = pack8(m); } else { denp0 += ds; mf0 = pack8(m); }
        }
#pragma unroll
        for (int half = 0; half < 2; ++half) {
            bf16x8 vf[4]; frag_tr4<true, 272>(vimg, 32 * ks, 64 * half, r, q, vf);
            if (act0) {
#pragma unroll
                for (int vt = 0; vt < 4; ++vt) num[0][4 * half + vt] = MFMA16(vf[vt], mf0, num[0][4 * half + vt]);
            }
            if (act1) {
#pragma unroll
                for (int vt = 0; vt < 4; ++vt) num[1][4 * half + vt] = MFMA16(vf[vt], mf1, num[1][4 * half + vt]);
            }
        }
        asm volatile("" ::: "memory");
    }
    float inv0 = 0.f, inv1 = 0.f;
#pragma unroll
    for (int dir = 0; dir < 2; ++dir) {
        const LAS unsigned char* Simg = dir ? Qimg : Kimg; const float e = __expf(dir ? cl1 : cl0) * SC;
        float qn = 0.f;
#pragma unroll
        for (int ks = 0; ks < 4; ++ks) {
            asm volatile("" ::: "memory");
            float qv[8]; unpack8(qfr[ks], qv);
            const f32x4 n0 = *(const LAS f32x4*)(nent + dir * 128 + 32 * ks + 8 * q), n1 = *(const LAS f32x4*)(nent + dir * 128 + 32 * ks + 8 * q + 4);
            qn += (qv[0] * n0.x + qv[1] * n0.y + qv[2] * n0.z + qv[3] * n0.w) + (qv[4] * n1.x + qv[5] * n1.y + qv[6] * n1.z + qv[7] * n1.w);
#pragma unroll
            for (int j = 0; j < 8; ++j) qv[j] *= e;
            const bf16x8 qe = pack8(qv);
#pragma unroll
            for (int vt = 0; vt < 8; ++vt) num[dir][vt] = MFMA16(frag_row(Simg, 272, 16 * vt + r, 32 * ks + 8 * q), qe, num[dir][vt]);
        }
        float denp = dir ? denp1 : denp0;
        denp += __shfl_xor(denp, 16); denp += __shfl_xor(denp, 32); qn += __shfl_xor(qn, 16); qn += __shfl_xor(qn, 32);
        const float den = denp + e * qn; const float inv = 1.0f / fmaxf(fabsf(den), 1.0f);
        if (dir) inv1 = inv; else inv0 = inv;
    }
    f32x4 hs[8];
#pragma unroll
    for (int vt = 0; vt < 8; ++vt) hs[vt] = num[0][vt] * inv0 + num[1][vt] * inv1;
    float s1 = 0.f;
#pragma unroll
    for (int vt = 0; vt < 8; ++vt) s1 += (hs[vt][0] + hs[vt][1]) + (hs[vt][2] + hs[vt][3]);
    s1 += __shfl_xor(s1, 16); s1 += __shfl_xor(s1, 32);
    const float mean = s1 * (1.f / 128.f); float s2 = 0.f;
#pragma unroll
    for (int vt = 0; vt < 8; ++vt) { hs[vt] -= mean; s2 += (hs[vt][0] * hs[vt][0] + hs[vt][1] * hs[vt][1]) + (hs[vt][2] * hs[vt][2] + hs[vt][3] * hs[vt][3]); }
    s2 += __shfl_xor(s2, 16); s2 += __shfl_xor(s2, 32);
    const float rs = 1.0f / sqrtf(s2 * (1.f / 128.f) + LN_EPS);
    const float* nw = C.in[16] + l * 512 + hd * 128; bf16* MIX = (bf16*)(C.ws + B_MIX) + tok * 2048 + 1536 + hd * 128;
#pragma unroll
    for (int vt = 0; vt < 8; ++vt) {
        const int v0 = 16 * vt + 4 * q; const f32x4 nv = *(const f32x4*)(nw + v0); const u32x2 ow = ow8[vt];
        f32x4 o; o[0] = hs[vt][0] * rs * nv[0] * sigmoidf_(bflo(ow.x)); o[1] = hs[vt][1] * rs * nv[1] * sigmoidf_(bfhi(ow.x)); o[2] = hs[vt][2] * rs * nv[2] * sigmoidf_(bflo(ow.y)); o[3] = hs[vt][3] * rs * nv[3] * sigmoidf_(bfhi(ow.y));
        *(u32x2*)(MIX + v0) = pack4(o);
    }
    __syncthreads();
}
__device__ __forceinline__ void hg_gates_e(Ctx& C, int l, int hd, int dir, const LAS unsigned char* Qimg, LAS unsigned char* QLimg, LAS unsigned char* Kimg, LAS float* segtot, LAS float* VV) {
    const int k = C.tid & 127, seg = C.tid >> 7;
    const float oml = ((const LAS float*)(C.lds + PAR_OFF))[hd * 128 + k];
    __syncthreads();
    float run = 1.f;
#pragma unroll
    for (int i = 0; i < 16; ++i) {
        const int t = dir ? (seg * 16 + 15 - i) : (seg * 16 + i);
        const float key = oml * sigmoidf_(-bf2f(*(const LAS bf16*)(Kimg + t * 272 + k * 2)));
        run *= 1.0f - key;
        const float qv = bf2f(*(const LAS bf16*)(Qimg + t * 272 + k * 2));
        *(LAS bf16*)(Kimg + t * 272 + k * 2) = (bf16)f2bf(key * __builtin_amdgcn_rcpf(fmaxf(run, 1e-30f)));
        *(LAS bf16*)(QLimg + t * 272 + k * 2) = (bf16)f2bf(qv * run);
    }
    segtot[seg * 128 + k] = run;
    __syncthreads();
    {
        float acc = 1.f;
        if (dir == 0) { for (int J = seg - 1; J >= 0; --J) { acc *= segtot[J * 128 + k]; VV[(seg * 4 + J) * 128 + k] = acc; } }
        else { for (int J = seg + 1; J < 4; ++J) { acc *= segtot[J * 128 + k]; VV[(seg * 4 + J) * 128 + k] = acc; } }
        VV[(seg * 4 + seg) * 128 + k] = acc;
    }
    __syncthreads();
}
__device__ __forceinline__ void hgE_seq(Ctx& C0_, int l, int u0, int nu, int ustride) { UNIT_PROLOG();
    const int tid = C.tid, lane = C.lane, w = C.wave, r = lane & 15, q = lane >> 4, I = w & 3, vh = w >> 2;
    LAS unsigned char* Qimg = C.lds; LAS unsigned char* Vimg = C.lds + 17408; LAS unsigned char* QLimg = C.lds + 34816; LAS unsigned char* Kimg = C.lds + 52224; LAS unsigned char* Simg = C.lds + 69632;
    LAS float* segtot = (LAS float*)(C.lds + 104448); LAS float* VV = (LAS float*)(C.lds + 106496); LAS float* xch = (LAS float*)(C.lds + 114688);
    const unsigned vimg = lds_addr(Vimg);
    const int lrow = 16 * I + r;
    TileRegs<64, 128> tQ, tV, tF0, tF1; TileRegs<128, 128> tS0, tS1;
#define HGE_ISSUE(uu) do { const int hd_ = (uu) & 3, c_ = ((uu) >> 2) & 127, b_ = (uu) >> 9; const size_t tk_ = (size_t)b_ * SEQ + c_ * 64; \
        tile_gload(tQ, (const bf16*)(C.ws + B_HQ) + tk_ * 512 + hd_ * 128, 512, tid); tile_gload(tV, (const bf16*)(C.ws + B_HI) + tk_ * 512 + hd_ * 128, 512, tid); \
        tile_gload(tF0, (const bf16*)(C.ws + B_HFR) + tk_ * 1024 + hd_ * 128, 1024, tid); tile_gload(tF1, (const bf16*)(C.ws + B_HFR) + tk_ * 1024 + 512 + hd_ * 128, 1024, tid); \
        tile_gload(tS0, (const bf16*)(C.ws + B_STH) + (size_t)(((b_ * 128 + c_) * 2 + 0) * 4 + hd_) * 16384, 128, tid); tile_gload(tS1, (const bf16*)(C.ws + B_STH) + (size_t)(((b_ * 128 + c_) * 2 + 1) * 4 + hd_) * 16384, 128, tid); } while (0)
    HGE_ISSUE(u0);
#pragma unroll 1
    for (int iu = 0; iu < nu; ++iu) {
        const int u = u0 + iu * ustride;
        const int hd = u & 3, c = (u >> 2) & 127, b = u >> 9;
        const size_t tok0 = (size_t)b * SEQ + c * 64; const size_t tok = tok0 + lrow;
#pragma unroll
        for (int i = 0; i < 2; ++i) { const u32x4 x = tQ.v[i];
            tQ.v[i].x = pk2(siluf_(bflo(x.x)), siluf_(bfhi(x.x))); tQ.v[i].y = pk2(siluf_(bflo(x.y)), siluf_(bfhi(x.y))); tQ.v[i].z = pk2(siluf_(bflo(x.z)), siluf_(bfhi(x.z))); tQ.v[i].w = pk2(siluf_(bflo(x.w)), siluf_(bfhi(x.w))); }
        tile_sstore<64, 128, 272>(tQ, Qimg, tid); tile_sstore<64, 128, 272>(tV, Vimg, tid);
        f32x4 o[4];
#pragma unroll
        for (int vt = 0; vt < 4; ++vt) o[vt] = (f32x4){0.f, 0.f, 0.f, 0.f};
        u32x2 gw4[4];
        { const bf16* HGp = (const bf16*)(C.ws + B_HG) + tok * 512 + hd * 128;
#pragma unroll
          for (int vt = 0; vt < 4; ++vt) gw4[vt] = *(const u32x2*)(HGp + 64 * vh + 16 * vt + 4 * q); }
#pragma unroll
        for (int dir = 0; dir < 2; ++dir) {
            tile_sstore<64, 128, 272>(dir ? tF1 : tF0, Kimg, tid); tile_sstore<128, 128, 272>(dir ? tS1 : tS0, Simg, tid);
            if (dir == 1 && iu + 1 < nu) HGE_ISSUE(u + ustride);
            hg_gates_e(C, l, hd, dir, Qimg, QLimg, Kimg, segtot, VV);
            bf16x8 qd[4];
#pragma unroll
            for (int ks = 0; ks < 4; ++ks) qd[ks] = frag_row(QLimg, 272, lrow, 32 * ks + 8 * q);
            f32x4 att[4];
#pragma unroll
            for (int J = 0; J < 4; ++J) {
                att[J] = (f32x4){0.f, 0.f, 0.f, 0.f};
                const bool inr = dir ? (J >= I) : (J <= I);
                if (inr) {
#pragma unroll
                    for (int ks = 0; ks < 4; ++ks) {
                        const int k0 = 32 * ks + 8 * q;
                        bf16x8 qf = qd[ks];
                        if (J != I) { float qv[8]; unpack8(qd[ks], qv);
                            const f32x4 v0 = *(const LAS f32x4*)(VV + (I * 4 + J) * 128 + k0), v1 = *(const LAS f32x4*)(VV + (I * 4 + J) * 128 + k0 + 4);
                            qv[0] *= v0.x; qv[1] *= v0.y; qv[2] *= v0.z; qv[3] *= v0.w; qv[4] *= v1.x; qv[5] *= v1.y; qv[6] *= v1.z; qv[7] *= v1.w; qf = pack8(qv); }
                        att[J] = MFMA16(frag_row(Kimg, 272, 16 * J + r, k0), qf, att[J]);
                    }
                    if (J == I) {
#pragma unroll
                        for (int i = 0; i < 4; ++i) { const bool keep = dir ? (4 * q + i >= r) : (4 * q + i <= r); att[J][i] = keep ? att[J][i] : 0.f; }
                    }
                }
            }
#pragma unroll
            for (int k2 = 0; k2 < 2; ++k2) {
                float m[8] = {att[2 * k2][0], att[2 * k2][1], att[2 * k2][2], att[2 * k2][3], att[2 * k2 + 1][0], att[2 * k2 + 1][1], att[2 * k2 + 1][2], att[2 * k2 + 1][3]};
                const bf16x8 mf = pack8(m);
                bf16x8 vf4[4]; frag_tr4<true, 272>(vimg, 32 * k2, 64 * vh, r, q, vf4);
#pragma unroll
                for (int vt = 0; vt < 4; ++vt) o[vt] = MFMA16(vf4[vt], mf, o[vt]);
            }
#pragma unroll
            for (int ks = 0; ks < 4; ++ks) {
                const int k0 = 32 * ks + 8 * q;
                float qv[8]; unpack8(qd[ks], qv);
                const f32x4 v0 = *(const LAS f32x4*)(VV + (I * 4 + I) * 128 + k0), v1 = *(const LAS f32x4*)(VV + (I * 4 + I) * 128 + k0 + 4);
                qv[0] *= v0.x; qv[1] *= v0.y; qv[2] *= v0.z; qv[3] *= v0.w; qv[4] *= v1.x; qv[5] *= v1.y; qv[6] *= v1.z; qv[7] *= v1.w;
                const bf16x8 qh = pack8(qv);
#pragma unroll
                for (int vt = 0; vt < 4; ++vt) o[vt] = MFMA16(frag_row(Simg, 272, 64 * vh + 16 * vt + r, k0), qh, o[vt]);
            }
            __syncthreads();
        }
        float ss = 0.f;
#pragma unroll
        for (int vt = 0; vt < 4; ++vt) ss += (o[vt][0] * o[vt][0] + o[vt][1] * o[vt][1]) + (o[vt][2] * o[vt][2] + o[vt][3] * o[vt][3]);
        ss += __shfl_xor(ss, 16); ss += __shfl_xor(ss, 32);
        if (q == 0) xch[vh * 64 + lrow] = ss;
        __syncthreads();
        const float rs = 1.0f / sqrtf((xch[lrow] + xch[64 + lrow]) * (1.f / 128.f) + RMS_EPS);
        const float* nw = C.in[11] + l * 512 + hd * 128; bf16* MIX = (bf16*)(C.ws + B_MIX) + tok * 2048 + 1024 + hd * 128;
#pragma unroll
        for (int vt = 0; vt < 4; ++vt) {
            const int v0 = 64 * vh + 16 * vt + 4 * q; const f32x4 nv = *(const f32x4*)(nw + v0); const u32x2 gw = gw4[vt];
            f32x4 v; v[0] = o[vt][0] * rs * nv[0] * siluf_(bflo(gw.x)); v[1] = o[vt][1] * rs * nv[1] * siluf_(bfhi(gw.x)); v[2] = o[vt][2] * rs * nv[2] * siluf_(bflo(gw.y)); v[3] = o[vt][3] * rs * nv[3] * siluf_(bfhi(gw.y));
            *(u32x2*)(MIX + v0) = pack4(v);
        }
        __syncthreads();
    }
#undef HGE_ISSUE
}
__device__ __forceinline__ void mixE_phase(Ctx& C, int l) {
    int f, n;
    const int rot = (C.blk >> 3) % 3;
    mix_params(C, l);
#pragma unroll 1
    for (int k3 = 0; k3 < 3; ++k3) {
        int ty = k3 + rot; if (ty >= 3) ty -= 3;
        if (ty == 0) { if (FAST_SSD) { deal_range(C.blk, C.G, 0, 256, f, n); for (int i = 0; i < n; ++i) ssdE_unit(C, l, f + i * C.G); } }
        else if (ty == 1) { if (FAST_ML) { deal_range(C.blk, C.G, 256, 768, f, n); for (int i = 0; i < n; ++i) mlE_unit(C, l, f + i * C.G); } }
        else { if (FAST_HG) { deal_range(C.blk, C.G, 768, 1792, f, n); if (n) hgE_seq(C, l, f, n, C.G); } }
    }
}

constexpr int PH_PER_LAYER = 11, NPHASES = 1 + DEPTH * PH_PER_LAYER;
__global__ void __launch_bounds__(NTHR, 2) fwd_kernel(Args args) {
    extern __shared__ __attribute__((aligned(16))) unsigned char lds_raw[];
    Ctx C;
    C.lds = (LAS unsigned char*)lds_raw; C.misc = (volatile LAS unsigned*)(C.lds + MISC_OFF);
    C.ws = args.ws; C.in.lds = C.lds; C.out = args.out;
    C.tid = threadIdx.x; C.lane = C.tid & 63; C.wave = __builtin_amdgcn_readfirstlane(C.tid >> 6); C.G = gridDim.x; C.blk = blockIdx.x;
    if (C.tid < 64) C.misc[C.tid] = 0u;
    if (C.tid < 31) { const unsigned long long p = C.tid < 29 ? (unsigned long long)args.in[C.tid] : (C.tid == 29 ? (unsigned long long)args.out : (unsigned long long)args.ws);
        *(LAS u32x2*)(C.lds + PTAB_OFF + 8 * C.tid) = (u32x2){(unsigned)p, (unsigned)(p >> 32)}; }
    __syncthreads();
    const int lo = args.ph_lo, hi = args.ph_hi;
#if MK_ONE_LAUNCH
    XcdBarrier bar = xcd_barrier_post((unsigned*)(C.ws + WS_CTL) + CW_BAR, C.misc + 32);
#define GRID_BAR() do { XcdBarrier b2_ = bar; b2_.bar = (unsigned*)C.in[30] + CW_BAR; asm volatile("" : "+s"(b2_.x)); xcd_barrier(b2_); } while (0)
#else
#define GRID_BAR() do { } while (0)
#endif
#define IN(k) (lo <= (k) && (k) < hi)
#if PROFILE_A || PROFILE_B
#define STAMP(i) do { int l2_; asm volatile("v_mbcnt_lo_u32_b32 %0, -1, 0\n\tv_mbcnt_hi_u32_b32 %0, -1, %0" : "=v"(l2_)); if (l2_ == 0 && C.wave == 0) ((volatile LAS unsigned long long*)(C.lds + TS_OFF))[i] = __builtin_amdgcn_s_memrealtime(); } while (0)
#define SEAM(k) do { GRID_BAR(); STAMP((k) + 1); } while (0)
#else
#define STAMP(i) do { } while (0)
#define SEAM(k) do { if (IN((k) + 1)) GRID_BAR(); } while (0)
#endif
#define LAUNDER() do { __syncthreads(); C.out = (float*)C.in[29]; C.ws = (unsigned char*)C.in[30]; int ln_; asm volatile("v_mbcnt_lo_u32_b32 %0, -1, 0\n\tv_mbcnt_hi_u32_b32 %0, -1, %0" : "=v"(ln_)); C.lane = ln_; C.tid = C.wave * 64 + ln_; asm volatile("" : "+s"(C.blk), "+s"(C.G)); } while (0)

    STAMP(0);
    if (IN(0)) { LAUNDER();
        ln_phase<0, 1>(C, C.in[0], C.in[1], C.in[2], nullptr, 0);
        __syncthreads();
        wconv_layer(C, 0);
        SEAM(0);
    }
    for (int l = 0; l < DEPTH; ++l) {
        const int pb = 1 + l * PH_PER_LAYER; const bool moe = (l & 1) != 0; const int lm = l >> 1;
        const int dff = moe ? DFF_E : DFF_D;
        if (IN(pb + 0)) { LAUNDER();
            pg8::GOrder S; S.init(C.ws + WS_HBF, C.ws + WS_WIN, D, T / 256, NMAIN / 256, C.G, C.blk, 0, nullptr);
            pg8::EpiProj E{C.ws};
            pg8::gemm_phase<pg8::EpiProj, pg8::GOrder>(C.lds, D, D, S, E, C.tid);
            SEAM(pb + 0);
        }
        if (IN(pb + 1)) { LAUNDER(); conv_phase(C, l); SEAM(pb + 1); }
        if (IN(pb + 2)) { LAUNDER(); if (!(FAST_SSD && FAST_HG && FAST_ML)) naive_mixers(C, l); __syncthreads(); mixC_phase(C, l); SEAM(pb + 2); }
        if (IN(pb + 3)) { LAUNDER(); scan_phase(C); SEAM(pb + 3); }
        if (IN(pb + 4)) { LAUNDER(); if (!(FAST_SSD && FAST_HG && FAST_ML)) naive_combine(C, l); __syncthreads(); mixE_phase(C, l); SEAM(pb + 4); }
        if (IN(pb + 5)) { LAUNDER();
            pg8::GOrder S; S.init(C.ws + B_MIX, C.ws + WS_WOUT, DMIX, T / 256, D / 256, C.G, C.blk, 0, nullptr);
            pg8::EpiBf16Res E{(bf16*)(C.ws + B_Y), (const bf16*)(C.ws + WS_HBF), D};
            pg8::gemm_phase<pg8::EpiBf16Res, pg8::GOrder>(C.lds, DMIX, DMIX, S, E, C.tid);
            SEAM(pb + 5);
        }
        if (IN(pb + 6)) { LAUNDER();
            if (moe) ln_phase<1, 2>(C, nullptr, C.in[18] + l * D, C.in[19] + l * D, nullptr, l);
            else ln_phase<1, 0>(C, nullptr, C.in[18] + l * D, C.in[19] + l * D, nullptr, l);
            SEAM(pb + 6);
        }
        if (IN(pb + 7) && (moe || PROFILE_A || PROFILE_B)) { LAUNDER(); if (moe) moe_dispatch(C, lm); SEAM(pb + 7); }
        if (IN(pb + 8)) { LAUNDER();
            __syncthreads();
            const int nblk = moe_cum_table(C, lm, moe);
            pg8::GOrder S; S.init(moe ? C.ws + B_XS : C.ws + WS_HBF, C.ws + WS_W13, D, nblk, 2 * dff / 256, C.G, C.blk, (size_t)2 * dff * D * 2, (const LAS int*)(C.lds + MISC_OFF));
            pg8::EpiSwiglu E{(bf16*)(C.ws + B_HID), dff};
            pg8::gemm_phase<pg8::EpiSwiglu, pg8::GOrder>(C.lds, D, D, S, E, C.tid);
            SEAM(pb + 8);
        }
        if (IN(pb + 9)) { LAUNDER();
            __syncthreads();
            const int nblk = moe_cum_table(C, lm, moe);
            const int nfull = nblk < 128 ? nblk : 128;
            pg8::GOrder S; S.init(C.ws + B_HID, C.ws + WS_W2, dff, nfull, D / 256, C.G, C.blk, (size_t)D * dff * 2, (const LAS int*)(C.lds + MISC_OFF));
            pg8::EpiBf16Res E{moe ? (bf16*)(C.ws + B_YE) : (bf16*)(C.ws + B_Y), moe ? nullptr : (const bf16*)(C.ws + WS_HBF), D};
            pg8::gemm_phase<pg8::EpiBf16Res, pg8::GOrder>(C.lds, dff, dff, S, E, C.tid);
            if (nblk > 128) {
                __syncthreads();
                pg8::TailOrder S2; S2.init(C.ws + B_HID, C.ws + WS_W2, dff, nblk - 128, C.G, C.blk, (size_t)D * dff * 2, (const LAS int*)(C.lds + MISC_OFF));
                pg8::EpiF32 E2{(float*)(C.ws + B_PART), D};
                pg8::gemm_phase<pg8::EpiF32, pg8::TailOrder>(C.lds, 512, dff, S2, E2, C.tid);
            }
            SEAM(pb + 9);
        }
        if (IN(pb + 10)) { LAUNDER();
            float* dst = (l == DEPTH - 1) ? C.out : nullptr;
            const float* g = C.in[20] + l * D; const float* b = C.in[21] + l * D;
            if (l == DEPTH - 1) { if (moe) ln_phase<3, 0>(C, nullptr, g, b, dst, l); else ln_phase<2, 0>(C, nullptr, g, b, dst, l); }
            else { if (moe) ln_phase<3, 1>(C, nullptr, g, b, dst, l + 1); else ln_phase<2, 1>(C, nullptr, g, b, dst, l + 1);
                __syncthreads(); wconv_layer(C, l + 1); }
            SEAM(pb + 10);
        }
    }
#if PROFILE_A || PROFILE_B
    {
        int l3_; asm volatile("v_mbcnt_lo_u32_b32 %0, -1, 0\n\tv_mbcnt_hi_u32_b32 %0, -1, %0" : "=v"(l3_));
        if (l3_ == 0 && C.wave == 0 && __builtin_amdgcn_readfirstlane(C.blk) == 0) {
            volatile LAS unsigned long long* ts = (volatile LAS unsigned long long*)(C.lds + TS_OFF);
            unsigned long long dsum = 0;
            for (int p = 0; p < NPHASES; ++p) { const int cls = (p == 0) ? 0 : 1 + (p - 1) % PH_PER_LAYER; if ((PROFILE_A >> cls) & 1) dsum += ts[p + 1] - ts[p]; }
            const unsigned long long t0 = __builtin_amdgcn_s_memrealtime();
            while (__builtin_amdgcn_s_memrealtime() - t0 < dsum) __builtin_amdgcn_s_sleep(8);
        }
    }
#endif
#undef IN
#undef SEAM
}

extern "C" void kernel_launch(void* const* d_in, const int* in_sizes, int n_in, void* d_out, int out_size, void* d_ws, size_t ws_size, hipStream_t stream) {
    static int grid = 0;
    if (grid == 0) {
        if (n_in != 29 || out_size != T * D || ws_size < WS_END) { fprintf(stderr, "kernel_launch: unexpected shapes (n_in %d out %d ws %zu need %zu)\n", n_in, out_size, ws_size, (size_t)WS_END); grid = -1; return; }
        int dev = 0, cus = 0, per_cu = 0;
        if (hipGetDevice(&dev) != hipSuccess || hipDeviceGetAttribute(&cus, hipDeviceAttributeMultiprocessorCount, dev) != hipSuccess) { grid = -1; return; }
        if (hipFuncSetAttribute((const void*)fwd_kernel, hipFuncAttributeMaxDynamicSharedMemorySize, LDS_BYTES) != hipSuccess) { grid = -1; return; }
        if (hipOccupancyMaxActiveBlocksPerMultiprocessor(&per_cu, (const void*)fwd_kernel, NTHR, LDS_BYTES) != hipSuccess || per_cu < 1) fprintf(stderr, "kernel_launch: occupancy query says %d\n", per_cu);
        (void)hipGetLastError();
        grid = cus;
    }
    if (grid < 0) return;
    (void)hipMemsetAsync((char*)d_ws + WS_CTL, 0, CTL_ZERO_BYTES, stream);
    Args a{};
    for (int i = 0; i < 29; ++i) a.in[i] = (const float*)d_in[i];
    a.out = (float*)d_out; a.ws = (unsigned char*)d_ws;
#if MK_ONE_LAUNCH
    a.ph_lo = 0; a.ph_hi = NPHASES;
    hipLaunchKernelGGL(fwd_kernel, dim3(grid), dim3(NTHR), LDS_BYTES, stream, a);
#else
    for (int p = 0; p < NPHASES; ++p) {
        if (p >= 1) { const int k = (p - 1) % PH_PER_LAYER, l = (p - 1) / PH_PER_LAYER; if (k == 7 && !(l & 1)) continue; }
        a.ph_lo = p; a.ph_hi = p + 1;
        hipLaunchKernelGGL(fwd_kernel, dim3(grid), dim3(NTHR), LDS_BYTES, stream, a);
    }
#endif
}
```

```cpp
#include <hip/hip_runtime.h>
#include <cstdio>
#include <cstdint>

#ifndef PROFILE_A
#define PROFILE_A 0
#define PROFILE_B 0
#endif
#ifndef MK_ONE_LAUNCH
#define MK_ONE_LAUNCH 1
#endif

#ifndef FAST_SSD
#define FAST_SSD 1
#endif
#ifndef FAST_HG
#define FAST_HG 1
#endif
#ifndef FAST_ML
#define FAST_ML 1
#endif

#define LAS __attribute__((address_space(3)))
#define GAS __attribute__((address_space(1)))
typedef unsigned short bf16;
typedef short bf16x8 __attribute__((ext_vector_type(8)));
typedef float f32x4 __attribute__((ext_vector_type(4)));
typedef float f32x2 __attribute__((ext_vector_type(2)));
typedef unsigned u32x4 __attribute__((ext_vector_type(4)));
typedef unsigned u32x2 __attribute__((ext_vector_type(2)));
typedef short s16x4 __attribute__((ext_vector_type(4)));

constexpr int T = 16384, SEQ = 8192, D = 1024, DEPTH = 4, DPROJ = 7216, NMAIN = 7168, DMIX = 2048;
constexpr int DFF_D = 2816, DFF_E = 3584, NEXP = 8, NGATE = 48;
constexpr int NWAVES = 8, NTHR = 512;
constexpr float ALPHA = 1.681792830507429f;
constexpr float LN_EPS = 1e-5f, RMS_EPS = 1e-6f;
constexpr int MOE_ROWS = 34816;

constexpr size_t MiB = 1u << 20;
constexpr size_t WS_CTL = 0, CTL_ZERO_BYTES = 1 * MiB;
constexpr size_t WS_HF32 = 1 * MiB, WS_HBF = 65 * MiB, WS_GATES = 97 * MiB, WS_ROUTE = 100 * MiB;
constexpr size_t WS_WIN = 101 * MiB, WS_WOUT = 115 * MiB, WS_W13 = 119 * MiB, WS_W2 = 231 * MiB, WS_BIG = 287 * MiB;
constexpr size_t B_Z = WS_BIG + 0 * MiB, B_XBCR = WS_BIG + 32 * MiB, B_HQ = WS_BIG + 80 * MiB, B_HFR = WS_BIG + 96 * MiB, B_HI = WS_BIG + 128 * MiB, B_HG = WS_BIG + 144 * MiB;
constexpr size_t B_MQKR = WS_BIG + 160 * MiB, B_MV = WS_BIG + 192 * MiB, B_MO = WS_BIG + 208 * MiB;
constexpr size_t B_XBCC = WS_BIG + 224 * MiB, B_MQKC = WS_BIG + 272 * MiB;
constexpr size_t B_YBUF = WS_BIG + 304 * MiB, B_OBUF = WS_BIG + 368 * MiB, B_HBUF = WS_BIG + 432 * MiB;
constexpr size_t B_MIX = WS_BIG + 464 * MiB;
constexpr size_t B_Y = WS_BIG + 0 * MiB;
constexpr size_t B_XS = WS_BIG + 64 * MiB, B_HID = WS_BIG + 136 * MiB, B_YE = WS_BIG + 376 * MiB;
constexpr size_t B_PART = B_XS;
constexpr size_t B_STS = WS_BIG + 304 * MiB, B_STH = WS_BIG + 368 * MiB, B_STM = WS_BIG + 432 * MiB;
constexpr size_t B_DECS = WS_BIG + 528 * MiB, B_DECM = B_DECS + 65536, B_NM = B_DECS + 131072, B_DECH = B_DECS + 1 * MiB;
constexpr size_t WS_END = WS_BIG + 532 * MiB;
constexpr int CW_TMO = 0, CW_BAR = 4096, CW_CNT = 8192;

#define LDS_WAIT() asm volatile("s_waitcnt lgkmcnt(0)" ::: "memory")
#define VM_WAIT() asm volatile("s_waitcnt vmcnt(0)" ::: "memory")
__device__ __forceinline__ unsigned f2bf(float f) { unsigned u = __builtin_bit_cast(unsigned, f); return (u + 0x7fffu + ((u >> 16) & 1u)) >> 16; }
typedef __bf16 nbf16x2 __attribute__((ext_vector_type(2)));
__device__ __forceinline__ unsigned pk2(float lo, float hi) { const f32x2 v = {lo, hi}; return __builtin_bit_cast(unsigned, __builtin_convertvector(v, nbf16x2)); }
__device__ __forceinline__ float bf2f(unsigned short b) { return __builtin_bit_cast(float, ((unsigned)b) << 16); }
__device__ __forceinline__ float bflo(unsigned w) { return __builtin_bit_cast(float, w << 16); }
__device__ __forceinline__ float bfhi(unsigned w) { return __builtin_bit_cast(float, w & 0xffff0000u); }
__device__ __forceinline__ float sigmoidf_(float x) { return __builtin_amdgcn_rcpf(1.0f + __expf(-x)); }
__device__ __forceinline__ float siluf_(float x) { return x * __builtin_amdgcn_rcpf(1.0f + __expf(-x)); }
__device__ __forceinline__ float softplusf_(float x) { return fmaxf(x, 0.f) + log1pf(__expf(-fabsf(x))); }
__device__ __forceinline__ float wave_sum(float v) {
#pragma unroll
    for (int o = 1; o < 64; o <<= 1) v += __shfl_xor(v, o);
    return v;
}

namespace pg8 {
#define PG8_LAS __attribute__((address_space(3)))
typedef unsigned short bf16_t;
constexpr int BM = 256, BK = 64, HALF = 128, HTB = HALF * BK * 2, STAGE_BYTES = 8 * HTB, NXCD = 8, WGM = 8;
__host__ __device__ __forceinline__ int lds_byte(int r, int c) { const int st = (r >> 4) * 2 + (c >> 5), rr = r & 15, cc = c & 31, ob = rr * 64 + cc * 2; return st * 1024 + (ob ^ (((ob >> 9) & 1) << 5)); }
__host__ __device__ __forceinline__ void stage_rc(int b, int& R, int& C) { const int st = b / 1024, sb = b % 1024, swz = sb ^ (((sb >> 9) & 1) << 5); R = (st >> 1) * 16 + swz / 64; C = (st & 1) * 32 + (swz % 64) / 2; }
__host__ __device__ __forceinline__ int perm32(int rho) { const int n = rho >> 4, i = rho & 15; return 8 * (i >> 2) + 4 * n + (i & 3); }

struct Unit { const char* A; const char* B; int pm, pn; };

struct GOrder {
    const char* A; const char* Bt; int K; int nM, nN, nwg, G, c; size_t bexp; const PG8_LAS int* cum;
    __device__ void init(const void* A_, const void* Bt_, int K_, int nM_, int nN_, int G_, int c_, size_t bexp_, const PG8_LAS int* cum_) { A = (const char*)A_; Bt = (const char*)Bt_; K = K_; nM = nM_; nN = nN_; nwg = nM * nN; G = G_; c = c_; bexp = bexp_; cum = cum_; }
    __device__ bool next(int i, Unit& u) const {
        const long L = (long)i * G + c; if (L >= nwg) return false;
        int wgid = (int)L; { const int q = nwg / NXCD, r = nwg % NXCD, xcd = wgid % NXCD, off = wgid / NXCD; wgid = (xcd < r ? xcd * (q + 1) : r * (q + 1) + (xcd - r) * q) + off; }
        const int nig = WGM * nN, gid = wgid / nig, fm = gid * WGM, gsz = (nM - fm) < WGM ? (nM - fm) : WGM;
        u.pm = fm + ((wgid % nig) % gsz); u.pn = (wgid % nig) / gsz;
        int e = 0; if (cum) { for (int j = 0; j < 8; ++j) e += (cum[j] <= u.pm) ? 1 : 0; if (e > 7) e = 7; }
        u.A = A + (size_t)u.pm * 256 * K * 2; u.B = Bt + (size_t)e * bexp + (size_t)u.pn * 256 * K * 2; return true;
    }
};
struct TailOrder {
    const char* A; const char* Bt; int KS, npieces, G, c; size_t bexp; const PG8_LAS int* cum;
    __device__ void init(const void* A_, const void* Bt_, int KS_, int ntail, int G_, int c_, size_t bexp_, const PG8_LAS int* cum_) { A = (const char*)A_; Bt = (const char*)Bt_; KS = KS_; npieces = ntail * 28; G = G_; c = c_; bexp = bexp_; cum = cum_; }
    __device__ bool next(int i, Unit& u) const {
        const long L = (long)i * G + c; if (L >= npieces) return false;
        const int p = (int)L, kp = p % 7, pn = (p / 7) & 3, rbi = p / 28, rb = 128 + rbi;
        int e = 0; for (int j = 0; j < 8; ++j) e += (cum[j] <= rb) ? 1 : 0; if (e > 7) e = 7;
        u.pm = kp * 8 + rbi; u.pn = pn;
        u.A = A + ((size_t)rb * 256 * KS + (size_t)kp * 512) * 2; u.B = Bt + (size_t)e * bexp + ((size_t)pn * 256 * KS + (size_t)kp * 512) * 2; return true;
    }
};
__device__ __forceinline__ unsigned cvt_pk_bf16(float lo, float hi) { unsigned r; asm volatile("v_cvt_pk_bf16_f32 %0, %1, %2" : "=v"(r) : "v"(lo), "v"(hi)); return r; }

struct EpiF32 {
    static constexpr bool PERM = false;
    float* C; int ldc;
    __device__ __forceinline__ void operator()(const f32x4 (&acc)[2][2][4][2], const Unit& u, int wr, int wc, int fr, int fq) const {
        const int row0 = u.pm * BM + wr * 64 + fr, col0 = u.pn * BM + wc * 32 + 4 * fq;
#pragma unroll
        for (int ai = 0; ai < 2; ++ai)
#pragma unroll
            for (int m = 0; m < 4; ++m) { float* rowp = C + (size_t)(row0 + ai * HALF + m * 16) * ldc + col0;
#pragma unroll
                for (int bj = 0; bj < 2; ++bj)
#pragma unroll
                    for (int n = 0; n < 2; ++n) *(f32x4*)(rowp + bj * HALF + n * 16) = acc[ai][bj][m][n]; }
    }
};
struct EpiBf16Res {
    static constexpr bool PERM = true;
    bf16_t* O; const bf16_t* res; int ldc;
    __device__ __forceinline__ void operator()(const f32x4 (&acc)[2][2][4][2], const Unit& u, int wr, int wc, int fr, int fq) const {
        const int row0 = u.pm * BM + wr * 64 + fr, col0 = u.pn * BM + wc * 32 + 8 * fq;
#pragma unroll
        for (int ai = 0; ai < 2; ++ai)
#pragma unroll
            for (int m = 0; m < 4; ++m) { const size_t off = (size_t)(row0 + ai * HALF + m * 16) * ldc + col0;
#pragma unroll
                for (int bj = 0; bj < 2; ++bj) { f32x4 v0 = acc[ai][bj][m][0], v1 = acc[ai][bj][m][1];
                    if (res) { const u32x4 rw = *(const u32x4*)(res + off + bj * HALF);
                        v0[0] += ALPHA * bflo(rw.x); v0[1] += ALPHA * bfhi(rw.x); v0[2] += ALPHA * bflo(rw.y); v0[3] += ALPHA * bfhi(rw.y);
                        v1[0] += ALPHA * bflo(rw.z); v1[1] += ALPHA * bfhi(rw.z); v1[2] += ALPHA * bflo(rw.w); v1[3] += ALPHA * bfhi(rw.w); }
                    u32x4 w; w.x = cvt_pk_bf16(v0[0], v0[1]); w.y = cvt_pk_bf16(v0[2], v0[3]); w.z = cvt_pk_bf16(v1[0], v1[1]); w.w = cvt_pk_bf16(v1[2], v1[3]);
                    *(u32x4*)(O + off + bj * HALF) = w; } }
    }
};
struct EpiProj {
    static constexpr bool PERM = true;
    unsigned char* ws;
    __device__ __forceinline__ void operator()(const f32x4 (&acc)[2][2][4][2], const Unit& u, int wr, int wc, int fr, int fq) const {
        const int pn = u.pn; size_t off; int ldc, c0;
        if (pn < 4) { off = B_Z; ldc = 1024; c0 = pn; } else if (pn < 10) { off = B_XBCR; ldc = 1536; c0 = pn - 4; } else if (pn < 12) { off = B_HQ; ldc = 512; c0 = pn - 10; }
        else if (pn < 16) { off = B_HFR; ldc = 1024; c0 = pn - 12; } else if (pn < 18) { off = B_HI; ldc = 512; c0 = pn - 16; } else if (pn < 20) { off = B_HG; ldc = 512; c0 = pn - 18; }
        else if (pn < 24) { off = B_MQKR; ldc = 1024; c0 = pn - 20; } else if (pn < 26) { off = B_MV; ldc = 512; c0 = pn - 24; } else { off = B_MO; ldc = 512; c0 = pn - 26; }
        bf16_t* base = (bf16_t*)(ws + off);
        const int row0 = u.pm * BM + wr * 64 + fr, col0 = c0 * BM + wc * 32 + 8 * fq;
#pragma unroll
        for (int ai = 0; ai < 2; ++ai)
#pragma unroll
            for (int m = 0; m < 4; ++m) { bf16_t* rowp = base + (size_t)(row0 + ai * HALF + m * 16) * ldc + col0;
#pragma unroll
                for (int bj = 0; bj < 2; ++bj) { const f32x4 v0 = acc[ai][bj][m][0], v1 = acc[ai][bj][m][1];
                    u32x4 w; w.x = cvt_pk_bf16(v0[0], v0[1]); w.y = cvt_pk_bf16(v0[2], v0[3]); w.z = cvt_pk_bf16(v1[0], v1[1]); w.w = cvt_pk_bf16(v1[2], v1[3]);
                    *(u32x4*)(rowp + bj * HALF) = w; } }
    }
};
struct EpiSwiglu {
    static constexpr bool PERM = true;
    bf16_t* O; int ldc;
    __device__ __forceinline__ void operator()(const f32x4 (&acc)[2][2][4][2], const Unit& u, int wr, int wc, int fr, int fq) const {
        const int row0 = u.pm * BM + wr * 64 + fr, col0 = u.pn * HALF + wc * 32 + 8 * fq;
#pragma unroll
        for (int ai = 0; ai < 2; ++ai)
#pragma unroll
            for (int m = 0; m < 4; ++m) { bf16_t* rowp = O + (size_t)(row0 + ai * HALF + m * 16) * ldc + col0;
                float o[8];
#pragma unroll
                for (int n = 0; n < 2; ++n)
#pragma unroll
                    for (int j = 0; j < 4; ++j) { const float a = acc[ai][0][m][n][j], b = acc[ai][1][m][n][j]; o[n * 4 + j] = a * __builtin_amdgcn_rcpf(1.0f + __expf(-a)) * b; }
                u32x4 w; w.x = cvt_pk_bf16(o[0], o[1]); w.y = cvt_pk_bf16(o[2], o[3]); w.z = cvt_pk_bf16(o[4], o[5]); w.w = cvt_pk_bf16(o[6], o[7]);
                *(u32x4*)rowp = w; }
    }
};

template <class Epi, class Sched, bool ALIGN_EPI = true>
__device__ __forceinline__ void gemm_phase(PG8_LAS unsigned char* lds, const int K, const int KS, const Sched& S, const Epi& E, const int tid) {
    const int wid = __builtin_amdgcn_readfirstlane(tid >> 6), lane = tid & 63, wr = wid >> 2, wc = wid & 3, fr = lane & 15, fq = lane >> 4;
    const int nt = K / BK;
    unsigned voffA[2], voffB[2];
#pragma unroll
    for (int i = 0; i < 2; ++i) { int R, C; stage_rc(tid * 16 + i * 8192, R, C); const int Rb = Epi::PERM ? ((R & ~31) + perm32(R & 31)) : R;
        voffA[i] = (unsigned)(R * KS + C) * 2u; voffB[i] = (unsigned)(Rb * KS + C) * 2u; }
    const size_t kstep = (size_t)(BK * 2);
    const size_t hstep = (size_t)HALF * KS * 2;
    const unsigned ldsw = (unsigned)wid * 1024u;
    const int aoff = lds_byte(wr * 64 + fr, fq * 8), boff = lds_byte(wc * 32 + fr, fq * 8);
#define PG8_SA(b, h) (((b) * 2 + (h)) * HTB)
#define PG8_SB(b, h) ((4 + (b) * 2 + (h)) * HTB)
#define PG8_STAGE(bufoff, gbase, voff) do { _Pragma("unroll") for (int _i = 0; _i < 2; ++_i) \
        __builtin_amdgcn_global_load_lds((const unsigned*)((const char*)(gbase) + (voff)[_i]), (PG8_LAS unsigned*)(lds + (bufoff) + ldsw + _i * 8192), 16, 0, 0); } while (0)
#define PG8_LDA(dst, b, h) do { _Pragma("unroll") for (int m = 0; m < 4; ++m) _Pragma("unroll") for (int k = 0; k < 2; ++k) dst[m][k] = *(const PG8_LAS bf16x8*)(lds + PG8_SA(b, h) + aoff + m * 2048 + k * 1024); } while (0)
#define PG8_LDB(dst, b, h) do { _Pragma("unroll") for (int n = 0; n < 2; ++n) _Pragma("unroll") for (int k = 0; k < 2; ++k) dst[n][k] = *(const PG8_LAS bf16x8*)(lds + PG8_SB(b, h) + boff + n * 2048 + k * 1024); } while (0)
#define PG8_MMA(ai, bj, At, Bt) do { __builtin_amdgcn_s_setprio(1); _Pragma("unroll") for (int m = 0; m < 4; ++m) _Pragma("unroll") for (int n = 0; n < 2; ++n) _Pragma("unroll") for (int k = 0; k < 2; ++k) \
        acc[ai][bj][m][n] = __builtin_amdgcn_mfma_f32_16x16x32_bf16(Bt[n][k], At[m][k], acc[ai][bj][m][n], 0, 0, 0); __builtin_amdgcn_s_setprio(0); } while (0)
#define PG8_WAIT_V(n) asm volatile("s_waitcnt vmcnt(" #n ")" ::: "memory")
#define PG8_WAIT_L(n) asm volatile("s_waitcnt lgkmcnt(" #n ")" ::: "memory")
#define PG8_BAR __builtin_amdgcn_s_barrier()
#define PG8_SCHED __builtin_amdgcn_sched_barrier(0)
    Unit cur, nxt; int ui = 0;
    if (!S.next(0, cur)) return;
    f32x4 acc[2][2][4][2];
#pragma unroll
    for (int a = 0; a < 2; ++a)
#pragma unroll
        for (int b = 0; b < 2; ++b)
#pragma unroll
            for (int m = 0; m < 4; ++m)
#pragma unroll
                for (int n = 0; n < 2; ++n) acc[a][b][m][n] = (f32x4){0.f, 0.f, 0.f, 0.f};
    bf16x8 At[4][2], B0[2][2], B1[2][2];
    const char* cA = cur.A; const char* cB = cur.B;
    PG8_STAGE(PG8_SB(0, 0), cB, voffB); PG8_STAGE(PG8_SB(0, 1), cB + hstep, voffB); PG8_STAGE(PG8_SA(0, 0), cA, voffA); PG8_STAGE(PG8_SA(0, 1), cA + hstep, voffA);
    if (wr == 1) PG8_BAR;
    PG8_WAIT_V(2); PG8_BAR;
    PG8_STAGE(PG8_SB(1, 0), cB + kstep, voffB); PG8_STAGE(PG8_SA(1, 0), cA + kstep, voffA); PG8_STAGE(PG8_SB(1, 1), cB + hstep + kstep, voffB);
    PG8_WAIT_V(6); PG8_BAR;
    for (;;) {
        const bool has_next = S.next(ui + 1, nxt);
        const char* nA = has_next ? nxt.A : cA; const char* nB = has_next ? nxt.B : cB;
        for (int t = 0; t < nt; t += 2) {
            const bool last = (t == nt - 2);
            const char* a1 = cA + (size_t)(t + 1) * kstep;
            const char* a2 = last ? nA : cA + (size_t)(t + 2) * kstep; const char* b2 = last ? nB : cB + (size_t)(t + 2) * kstep;
            const char* a3 = a2 + kstep; const char* b3 = b2 + kstep;
            PG8_LDB(B0, 0, 0); PG8_LDB(B1, 0, 1); PG8_SCHED; PG8_LDA(At, 0, 0); PG8_STAGE(PG8_SA(1, 1), a1 + hstep, voffA);
            PG8_WAIT_V(8); PG8_WAIT_L(0); PG8_BAR; PG8_MMA(0, 0, At, B0); PG8_MMA(0, 1, At, B1); PG8_BAR; PG8_SCHED;
            PG8_LDA(At, 0, 1); PG8_STAGE(PG8_SB(0, 0), b2, voffB); PG8_STAGE(PG8_SB(0, 1), b2 + hstep, voffB); PG8_STAGE(PG8_SA(0, 0), a2, voffA);
            PG8_WAIT_V(8); PG8_WAIT_L(0); PG8_BAR; PG8_MMA(1, 0, At, B0); PG8_MMA(1, 1, At, B1); PG8_BAR; PG8_SCHED;
            PG8_LDB(B0, 1, 0); PG8_LDB(B1, 1, 1); PG8_SCHED; PG8_LDA(At, 1, 0); PG8_STAGE(PG8_SA(0, 1), a2 + hstep, voffA);
            PG8_WAIT_V(8); PG8_WAIT_L(0); PG8_BAR; PG8_MMA(0, 0, At, B0); PG8_MMA(0, 1, At, B1); PG8_BAR; PG8_SCHED;
            PG8_LDA(At, 1, 1); PG8_STAGE(PG8_SB(1, 0), b3, voffB); PG8_STAGE(PG8_SB(1, 1), b3 + hstep, voffB); PG8_STAGE(PG8_SA(1, 0), a3, voffA);
            PG8_WAIT_V(8); PG8_WAIT_L(0); PG8_BAR; PG8_MMA(1, 0, At, B0); PG8_MMA(1, 1, At, B1); PG8_BAR; PG8_SCHED;
        }
        if constexpr (ALIGN_EPI) { if (wr == 0) PG8_BAR; }
        E(acc, cur, wr, wc, fr, fq);
        if (!has_next) break;
#pragma unroll
        for (int a = 0; a < 2; ++a)
#pragma unroll
            for (int b = 0; b < 2; ++b)
#pragma unroll
                for (int m = 0; m < 4; ++m)
#pragma unroll
                    for (int n = 0; n < 2; ++n) acc[a][b][m][n] = (f32x4){0.f, 0.f, 0.f, 0.f};
        cur = nxt; cA = nA; cB = nB; ++ui;
        if constexpr (ALIGN_EPI) { if (wr == 1) PG8_BAR; }
    }
    PG8_WAIT_V(0);
    if constexpr (!ALIGN_EPI) { if (wr == 0) PG8_BAR; }
    PG8_BAR;
#undef PG8_SA
#undef PG8_SB
#undef PG8_STAGE
#undef PG8_LDA
#undef PG8_LDB
#undef PG8_MMA
#undef PG8_WAIT_V
#undef PG8_WAIT_L
#undef PG8_BAR
#undef PG8_SCHED
}
}

#define XB_TMO      128
#define XB_XCNT(j)  (256  + 64 * (j))
#define XB_XSUB(j)  (1280 + 64 * (j))
#define XB_XGEN(j)  (2304 + 64 * (j))
#define XB_TOP      3328
#define XB_TOPGEN   3392
#define XCD_BAR_WORDS 3456
#define XB_SPIN_CAP (1u << 22)
__device__ __forceinline__ unsigned xb_ld(unsigned* p)              { return __hip_atomic_load(p, __ATOMIC_RELAXED, __HIP_MEMORY_SCOPE_AGENT); }
__device__ __forceinline__ unsigned xb_add(unsigned* p, unsigned v) { return __hip_atomic_fetch_add(p, v, __ATOMIC_RELAXED, __HIP_MEMORY_SCOPE_AGENT); }
__device__ __forceinline__ unsigned xb_xcc_id() { return (unsigned)__builtin_amdgcn_s_getreg((3 << 11) | 20) & 0xFu; }
#define XB_SPIN(cond, bar) do { unsigned _sp = 0; while (cond) { __builtin_amdgcn_s_sleep(1); \
    if ((++_sp & 255u) == 0u) { if (xb_ld(&(bar)[XB_TMO])) break; if (_sp > XB_SPIN_CAP) { atomicAdd(&(bar)[XB_TMO], 1u); break; } } } } while (0)
struct XcdBarrier { unsigned* bar; unsigned x; volatile LAS unsigned* st; };
__device__ __forceinline__ XcdBarrier xcd_barrier_post(unsigned* bar, volatile LAS unsigned* st) {
    XcdBarrier b; b.bar = bar; b.x = xb_xcc_id(); b.st = st;
    if (threadIdx.x == 0) (void)xb_add(&bar[XB_XCNT(b.x)], 1u);
    return b;
}
__device__ __forceinline__ void xcd_barrier_complete(unsigned* bar, unsigned x, unsigned& nloc, unsigned& nx) {
    const unsigned G = gridDim.x * gridDim.y * gridDim.z;
    unsigned sum, cnt, mine, sp = 0u;
    for (;;) {
        sum = 0u; cnt = 0u; mine = 0u;
#pragma unroll
        for (unsigned j = 0; j < 16; ++j) { const unsigned c = xb_ld(&bar[XB_XCNT(j)]); sum += c; cnt += (c > 0u) ? 1u : 0u; mine = (j == x) ? c : mine; }
        if (sum == G) break;
        __builtin_amdgcn_s_sleep(1);
        if ((++sp & 255u) == 0u) { if (xb_ld(&bar[XB_TMO])) break; if (sp > XB_SPIN_CAP) { atomicAdd(&bar[XB_TMO], 1u); break; } }
    }
    nloc = mine > 0u ? mine : 1u; nx = cnt > 0u ? cnt : 1u;
}
__device__ __forceinline__ void xcd_barrier(const XcdBarrier& b) {
    asm volatile("s_waitcnt vmcnt(0)" ::: "memory");
    __syncthreads();
    if (threadIdx.x == 0) {
        unsigned* bar = b.bar;
        __builtin_amdgcn_s_waitcnt(0);
        unsigned nloc = b.st[0], nx = b.st[1];
        if (nloc == 0u) { xcd_barrier_complete(bar, b.x, nloc, nx); b.st[0] = nloc; b.st[1] = nx; }
        const unsigned old = xb_add(&bar[XB_XSUB(b.x)], 1u);
        const unsigned gen = old / nloc;
        if (old + 1u == (gen + 1u) * nloc) {
            __builtin_amdgcn_fence(__ATOMIC_RELEASE, "agent");
            asm volatile("s_waitcnt vmcnt(0)" ::: "memory");
            const unsigned og = xb_add(&bar[XB_TOP], 1u);
            const unsigned tg = og / nx;
            if (og + 1u == (tg + 1u) * nx) xb_add(&bar[XB_TOPGEN], 1u);
            else XB_SPIN(xb_ld(&bar[XB_TOPGEN]) == tg, bar);
            __builtin_amdgcn_fence(__ATOMIC_ACQUIRE, "agent");
            xb_add(&bar[XB_XGEN(b.x)], 1u);
            asm volatile("s_waitcnt vmcnt(0)" ::: "memory");
        } else {
            XB_SPIN(xb_ld(&bar[XB_XGEN(b.x)]) == gen, bar);
            __builtin_amdgcn_fence(__ATOMIC_ACQUIRE, "agent");
            asm volatile("s_waitcnt vmcnt(0)" ::: "memory");
        }
    }
    __syncthreads();
}

constexpr int RING_BYTES = 131072;
constexpr int MISC_OFF = RING_BYTES;
constexpr int LDS_BYTES = 147456;

struct Args { const float* in[29]; float* out; unsigned char* ws; int ph_lo, ph_hi; };

constexpr int PAR_OFF = MISC_OFF + 1024;
constexpr int TS_OFF = MISC_OFF + 512;
constexpr int PTAB_OFF = MISC_OFF + 256;
struct InTab {
    LAS unsigned char* lds;
    __device__ __forceinline__ const float* operator[](int i) const {
        const u32x2 w = *(const LAS u32x2*)(lds + PTAB_OFF + 8 * i);
        const unsigned long long p = ((unsigned long long)(unsigned)__builtin_amdgcn_readfirstlane((int)w.y) << 32) | (unsigned)__builtin_amdgcn_readfirstlane((int)w.x);
        return (const float*)p;
    }
};
struct Ctx {
    LAS unsigned char* lds; volatile LAS unsigned* misc; unsigned char* ws; InTab in; float* out;
    int tid, lane, wave, G, blk;
};

__device__ __forceinline__ void tr_quad0(unsigned a, bf16x8& f0, bf16x8& f1, bf16x8& f2, bf16x8& f3) {
    s16x4 l0, h0, l1, h1, l2, h2, l3, h3;
    asm volatile("ds_read_b64_tr_b16 %0, %8\n\tds_read_b64_tr_b16 %1, %8 offset:544\n\tds_read_b64_tr_b16 %2, %8 offset:32\n\tds_read_b64_tr_b16 %3, %8 offset:576\n\t"
                 "ds_read_b64_tr_b16 %4, %8 offset:64\n\tds_read_b64_tr_b16 %5, %8 offset:608\n\tds_read_b64_tr_b16 %6, %8 offset:96\n\tds_read_b64_tr_b16 %7, %8 offset:640\n\ts_waitcnt lgkmcnt(0)"
                 : "=&v"(l0), "=&v"(h0), "=&v"(l1), "=&v"(h1), "=&v"(l2), "=&v"(h2), "=&v"(l3), "=&v"(h3) : "v"(a) : "memory");
    f0 = __builtin_shufflevector(l0, h0, 0, 1, 2, 3, 4, 5, 6, 7); f1 = __builtin_shufflevector(l1, h1, 0, 1, 2, 3, 4, 5, 6, 7);
    f2 = __builtin_shufflevector(l2, h2, 0, 1, 2, 3, 4, 5, 6, 7); f3 = __builtin_shufflevector(l3, h3, 0, 1, 2, 3, 4, 5, 6, 7);
}
struct TItem { const float* src; bf16* dst; size_t ldw; int K; };
__device__ __forceinline__ void titem_load(f32x4 (&v)[16], const TItem& d, int lane) {
    const int kr = lane >> 4, n4 = (lane & 15) * 4;
#pragma unroll
    for (int i = 0; i < 16; ++i) v[i] = __builtin_nontemporal_load((const f32x4*)(d.src + (size_t)(4 * i + kr) * d.ldw + n4));
}
__device__ __forceinline__ void titem_store(const f32x4 (&v)[16], const TItem& d, LAS unsigned char* scr, int lane) {
    const int kr = lane >> 4, n4 = (lane & 15) * 4;
#pragma unroll
    for (int i = 0; i < 16; ++i) { u32x2 w; w.x = pk2(v[i].x, v[i].y); w.y = pk2(v[i].z, v[i].w); *(LAS u32x2*)(scr + (4 * i + kr) * 136 + n4 * 2) = w; }
    LDS_WAIT(); asm volatile("" ::: "memory");
    const unsigned img = (unsigned)(size_t)scr; const int r = lane & 15, q = lane >> 4;
    bf16x8 f[2][4];
#pragma unroll
    for (int kh = 0; kh < 2; ++kh) {
        const unsigned a0 = img + (32 * kh + 8 * q + (r >> 2)) * 136 + (4 * (r & 3)) * 2;
        tr_quad0(a0, f[kh][0], f[kh][1], f[kh][2], f[kh][3]);
    }
#pragma unroll
    for (int kh = 0; kh < 2; ++kh)
#pragma unroll
        for (int nt = 0; nt < 4; ++nt) *(LAS bf16x8*)(scr + (16 * nt + r) * 144 + (32 * kh + 8 * q) * 2) = f[kh][nt];
    LDS_WAIT(); asm volatile("" ::: "memory");
    const int orow = lane >> 3, och = lane & 7;
#pragma unroll
    for (int j = 0; j < 8; ++j) { const bf16x8 o = *(const LAS bf16x8*)(scr + (8 * j + orow) * 144 + och * 16); *(bf16x8*)(d.dst + (size_t)(8 * j + orow) * d.K + och * 8) = o; }
    LDS_WAIT(); asm volatile("" ::: "memory");
}
__device__ __forceinline__ void wconv_layer(Ctx& C, int l) {
    LAS unsigned char* scr = C.lds + C.wave * 16384;
    const int gw = C.blk * NWAVES + C.wave, NGW = C.G * NWAVES;
    const bool moe = (l & 1) != 0; const int li = l >> 1;
    const int dff = moe ? DFF_E : DFF_D, nexp = moe ? NEXP : 1;
    const int I_A = 16 * (NMAIN / 64), I_B = 32 * 16, I_C1 = 16 * (2 * dff / 64), I_D1 = (dff / 64) * 16;
    const int NIT = I_A + I_B + nexp * (I_C1 + I_D1);
    const float* w_in = C.in[3] + (size_t)l * D * DPROJ; const float* w_out = C.in[17] + (size_t)l * DMIX * D;
    const float* w1 = moe ? C.in[26] + (size_t)li * NEXP * D * DFF_E : C.in[22] + (size_t)li * D * DFF_D;
    const float* w3 = moe ? C.in[27] + (size_t)li * NEXP * D * DFF_E : C.in[23] + (size_t)li * D * DFF_D;
    const float* w2 = moe ? C.in[28] + (size_t)li * NEXP * DFF_E * D : C.in[24] + (size_t)li * DFF_D * D;
    bf16* WinT = (bf16*)(C.ws + WS_WIN); bf16* WoutT = (bf16*)(C.ws + WS_WOUT); bf16* W13T = (bf16*)(C.ws + WS_W13); bf16* W2T = (bf16*)(C.ws + WS_W2);
    auto decode = [&](int it) -> TItem {
        TItem d; int r = it;
        if (r < I_A) { const int nb = r % (NMAIN / 64), kb = r / (NMAIN / 64); const int n0 = 64 * nb; d.src = w_in + (size_t)(64 * kb) * DPROJ + (n0 < 2560 ? n0 : n0 + 32); d.ldw = DPROJ; d.K = D; d.dst = WinT + (size_t)n0 * D + 64 * kb; return d; } r -= I_A;
        if (r < I_B) { const int nb = r % 16, kb = r / 16; d.src = w_out + (size_t)(64 * kb) * D + 64 * nb; d.ldw = D; d.K = DMIX; d.dst = WoutT + (size_t)(64 * nb) * DMIX + 64 * kb; return d; } r -= I_B;
        const int per = I_C1 + I_D1, e = r / per; r -= e * per;
        if (r < I_C1) { const int nbn = 2 * dff / 64, nb = r % nbn, kb = r / nbn; const int n0 = 64 * nb, pn = n0 >> 8, within = n0 & 255, bj = within >> 7, uu = within & 127;
            d.src = (bj ? w3 : w1) + (size_t)e * D * dff + (size_t)(64 * kb) * dff + 128 * pn + uu; d.ldw = dff; d.K = D; d.dst = W13T + (size_t)e * 2 * dff * D + (size_t)n0 * D + 64 * kb; return d; } r -= I_C1;
        { const int nb = r % 16, kb = r / 16; d.src = w2 + (size_t)e * dff * D + (size_t)(64 * kb) * D + 64 * nb; d.ldw = D; d.K = dff; d.dst = W2T + (size_t)e * D * dff + (size_t)(64 * nb) * dff + 64 * kb; return d; }
    };
    f32x4 va[16], vb[16]; TItem da, db;
    int it = gw;
    if (it < NIT) { da = decode(it); titem_load(va, da, C.lane); }
    while (it < NIT) {
        const int i1 = it + NGW, i2 = it + 2 * NGW;
        if (i1 < NIT) { db = decode(i1); titem_load(vb, db, C.lane); }
        titem_store(va, da, scr, C.lane);
        if (i1 >= NIT) break;
        if (i2 < NIT) { da = decode(i2); titem_load(va, da, C.lane); }
        titem_store(vb, db, scr, C.lane);
        it = i2;
    }
}

template <int MODE, int SK>
__device__ __forceinline__ void ln_phase(Ctx& C, const float* src, const float* gam, const float* bet, float* dst_f32, int lsk) {
    LAS float* Aimg = (LAS float*)C.lds;
    LAS float* part = (LAS float*)(C.lds + 65792);
    LAS float* lgt = (LAS float*)(C.lds + 90368);
    constexpr int NCT = (SK == 1) ? 3 : 1;
    bf16* HB = (bf16*)(C.ws + WS_HBF);
    const bf16* Y = (const bf16*)(C.ws + B_Y); const bf16* YE = (const bf16*)(C.ws + B_YE);
    const unsigned* route = (const unsigned*)(C.ws + WS_ROUTE);
    unsigned* gcnt = (unsigned*)(C.ws + WS_CTL) + CW_CNT + 64 * (lsk >> 1);
    const int lane = C.lane, rr = lane & 15, q = lane >> 4;
    LAS float* gl = (LAS float*)(C.lds + 92160);
    if (C.tid < 256) { *(LAS f32x4*)(gl + 4 * C.tid) = *(const f32x4*)(gam + 4 * C.tid); *(LAS f32x4*)(gl + 1024 + 4 * C.tid) = *(const f32x4*)(bet + 4 * C.tid); }
    __syncthreads();
    const float* Wc[NCT]; size_t ldw = 0; bool wvalid = true;
    if (SK == 1) { const float* w_in = C.in[3] + (size_t)lsk * D * DPROJ; ldw = DPROJ;
#pragma unroll
        for (int ct = 0; ct < NCT; ++ct) Wc[ct] = w_in + (ct < 2 ? 2560 + 16 * ct + rr : 7200 + rr); }
    else if (SK == 2) { Wc[0] = C.in[25] + (size_t)(lsk >> 1) * D * NEXP + (rr & 7); ldw = NEXP; wvalid = rr < 8; }
    else { Wc[0] = nullptr; }
    float bw[32][NCT];
    if (SK == 2) {
#pragma unroll
        for (int ks = 0; ks < 32; ++ks)
#pragma unroll
            for (int ct = 0; ct < NCT; ++ct) bw[ks][ct] = wvalid ? Wc[ct][(size_t)(128 * C.wave + q + 4 * ks) * ldw] : 0.f;
    }
    bf16x8 bwh[4][NCT], bwl[4][NCT];
    if (SK == 1) {
#pragma unroll
        for (int ks = 0; ks < 4; ++ks)
#pragma unroll
            for (int ct = 0; ct < NCT; ++ct) {
                float wv[8];
#pragma unroll
                for (int j = 0; j < 8; ++j) wv[j] = Wc[ct][(size_t)(128 * C.wave + 32 * ks + 8 * q + j) * ldw];
                u32x4 h; h.x = pk2(wv[0], wv[1]); h.y = pk2(wv[2], wv[3]); h.z = pk2(wv[4], wv[5]); h.w = pk2(wv[6], wv[7]);
                u32x4 lo; lo.x = pk2(wv[0] - bflo(h.x), wv[1] - bfhi(h.x)); lo.y = pk2(wv[2] - bflo(h.y), wv[3] - bfhi(h.y)); lo.z = pk2(wv[4] - bflo(h.z), wv[5] - bfhi(h.z)); lo.w = pk2(wv[6] - bflo(h.w), wv[7] - bfhi(h.w));
                bwh[ks][ct] = __builtin_bit_cast(bf16x8, h); bwl[ks][ct] = __builtin_bit_cast(bf16x8, lo);
            }
    }
    constexpr size_t YELIM = (size_t)32768 * D;
    constexpr bool PREY = true;
    f32x4 rx[2][4]; u32x2 ra[2][4], rb[2][4], rh[2][4];
    auto load_rows = [&](int it2) {
#pragma unroll
        for (int r = 0; r < 2; ++r) {
            const size_t ro = (size_t)(it2 * 16 + C.wave * 2 + r) * D + 4 * lane;
#pragma unroll
            for (int j = 0; j < 4; ++j) {
                if (MODE == 0) rx[r][j] = *(const f32x4*)(src + ro + 256 * j);
                else if (MODE == 1 || MODE == 2) ra[r][j] = *(const u32x2*)(Y + ro + 256 * j);
                else { const unsigned* rt = route + (size_t)(it2 * 16 + C.wave * 2 + r) * 8; const size_t o0 = (size_t)rt[6] * D, o1 = (size_t)rt[7] * D;
                    rh[r][j] = *(const u32x2*)(HB + ro + 256 * j);
                    if (PREY && o0 < YELIM) ra[r][j] = *(const u32x2*)(YE + o0 + 4 * lane + 256 * j);
                    if (PREY && o1 < YELIM) rb[r][j] = *(const u32x2*)(YE + o1 + 4 * lane + 256 * j); }
            }
        }
    };
    constexpr bool EARLY = (SK == 0);
    if (C.blk < T / 16) load_rows(C.blk);
    for (int it = C.blk; it < T / 16; it += C.G) {
        const int row0 = it * 16 + C.wave * 2;
        const int itn = it + C.G; const bool hasn = itn < T / 16;
        f32x4 vv[2][4];
#pragma unroll
        for (int r = 0; r < 2; ++r) {
            if (MODE == 0) {
#pragma unroll
                for (int j = 0; j < 4; ++j) vv[r][j] = rx[r][j];
            } else if (MODE == 1 || MODE == 2) {
#pragma unroll
                for (int j = 0; j < 4; ++j) { const u32x2 yw = ra[r][j]; vv[r][j] = (f32x4){bflo(yw.x), bfhi(yw.x), bflo(yw.y), bfhi(yw.y)}; }
            } else {
                const unsigned* rt = route + (size_t)(row0 + r) * 8; const size_t o0 = (size_t)rt[6] * D, o1 = (size_t)rt[7] * D; const float g0 = __builtin_bit_cast(float, rt[4]), g1 = __builtin_bit_cast(float, rt[5]);
#pragma unroll
                for (int j = 0; j < 4; ++j) {
                    const u32x2 hw = rh[r][j];
                    f32x4 y0, y1;
                    if (o0 < YELIM) { const u32x2 w0 = PREY ? ra[r][j] : *(const u32x2*)(YE + o0 + 4 * lane + 256 * j); y0 = (f32x4){bflo(w0.x), bfhi(w0.x), bflo(w0.y), bfhi(w0.y)}; }
                    else { const float* pp = (const float*)(C.ws + B_PART) + (o0 - YELIM) + 4 * lane + 256 * j; y0 = *(const f32x4*)pp;
#pragma unroll
                        for (int kp = 1; kp < 7; ++kp) y0 += *(const f32x4*)(pp + (size_t)kp * 2048 * D);
                        { const unsigned a_ = pk2(y0[0], y0[1]), b_ = pk2(y0[2], y0[3]); y0 = (f32x4){bflo(a_), bfhi(a_), bflo(b_), bfhi(b_)}; } }
                    if (o1 < YELIM) { const u32x2 w1 = PREY ? rb[r][j] : *(const u32x2*)(YE + o1 + 4 * lane + 256 * j); y1 = (f32x4){bflo(w1.x), bfhi(w1.x), bflo(w1.y), bfhi(w1.y)}; }
                    else { const float* pp = (const float*)(C.ws + B_PART) + (o1 - YELIM) + 4 * lane + 256 * j; y1 = *(const f32x4*)pp;
#pragma unroll
                        for (int kp = 1; kp < 7; ++kp) y1 += *(const f32x4*)(pp + (size_t)kp * 2048 * D);
                        { const unsigned a_ = pk2(y1[0], y1[1]), b_ = pk2(y1[2], y1[3]); y1 = (f32x4){bflo(a_), bfhi(a_), bflo(b_), bfhi(b_)}; } }
                    vv[r][j] = ALPHA * (f32x4){bflo(hw.x), bfhi(hw.x), bflo(hw.y), bfhi(hw.y)} + g0 * y0 + g1 * y1;
                }
            }
        }
        if (EARLY && hasn) load_rows(itn);
#pragma unroll
        for (int r = 0; r < 2; ++r) {
            const int row = row0 + r;
            f32x4 v[4];
#pragma unroll
            for (int j = 0; j < 4; ++j) v[j] = vv[r][j];
            float s = 0.f;
#pragma unroll
            for (int j = 0; j < 4; ++j) s += (v[j].x + v[j].y) + (v[j].z + v[j].w);
            const float mean = wave_sum(s) * (1.f / D); float s2 = 0.f;
#pragma unroll
            for (int j = 0; j < 4; ++j) { v[j] = v[j] - mean; s2 += (v[j].x * v[j].x + v[j].y * v[j].y) + (v[j].z * v[j].z + v[j].w * v[j].w); }
            const float rstd = 1.f / sqrtf(wave_sum(s2) * (1.f / D) + LN_EPS);
#pragma unroll
            for (int j = 0; j < 4; ++j) {
                const f32x4 o = v[j] * rstd * *(const LAS f32x4*)(gl + 4 * lane + 256 * j) + *(const LAS f32x4*)(gl + 1024 + 4 * lane + 256 * j);
                if (dst_f32) *(f32x4*)(dst_f32 + (size_t)row * D + 4 * lane + 256 * j) = o;
                u32x2 w; w.x = pk2(o.x, o.y); w.y = pk2(o.z, o.w);
                *(u32x2*)(HB + (size_t)row * D + 4 * lane + 256 * j) = w;
                if (SK != 0) *(LAS f32x4*)(Aimg + (C.wave * 2 + r) * 1028 + 4 * lane + 256 * j) = o;
            }
        }
        if (!EARLY && hasn) load_rows(itn);
        if (SK != 0) {
            __syncthreads();
            f32x4 acc[NCT];
#pragma unroll
            for (int ct = 0; ct < NCT; ++ct) acc[ct] = (f32x4){0.f, 0.f, 0.f, 0.f};
            if (SK == 1) {
#pragma unroll
                for (int ks = 0; ks < 4; ++ks) {
                    const LAS float* ap = Aimg + rr * 1028 + 128 * C.wave + 32 * ks + 8 * q;
                    const f32x4 a0 = *(const LAS f32x4*)ap, a1 = *(const LAS f32x4*)(ap + 4);
                    u32x4 h; h.x = pk2(a0.x, a0.y); h.y = pk2(a0.z, a0.w); h.z = pk2(a1.x, a1.y); h.w = pk2(a1.z, a1.w);
                    u32x4 lo; lo.x = pk2(a0.x - bflo(h.x), a0.y - bfhi(h.x)); lo.y = pk2(a0.z - bflo(h.y), a0.w - bfhi(h.y)); lo.z = pk2(a1.x - bflo(h.z), a1.y - bfhi(h.z)); lo.w = pk2(a1.z - bflo(h.w), a1.w - bfhi(h.w));
                    const bf16x8 ah = __builtin_bit_cast(bf16x8, h), al = __builtin_bit_cast(bf16x8, lo);
#pragma unroll
                    for (int ct = 0; ct < NCT; ++ct) {
                        acc[ct] = __builtin_amdgcn_mfma_f32_16x16x32_bf16(ah, bwh[ks][ct], acc[ct], 0, 0, 0);
                        acc[ct] = __builtin_amdgcn_mfma_f32_16x16x32_bf16(ah, bwl[ks][ct], acc[ct], 0, 0, 0);
                        acc[ct] = __builtin_amdgcn_mfma_f32_16x16x32_bf16(al, bwh[ks][ct], acc[ct], 0, 0, 0);
                    }
                }
            } else {
                const int kb = 128 * C.wave + q;
#pragma unroll
                for (int ks = 0; ks < 32; ++ks) {
                    const float a = Aimg[rr * 1028 + kb + 4 * ks];
#pragma unroll
                    for (int ct = 0; ct < NCT; ++ct) acc[ct] = __builtin_amdgcn_mfma_f32_16x16x4f32(a, bw[ks][ct], acc[ct], 0, 0, 0);
                }
            }
#pragma unroll
            for (int ct = 0; ct < NCT; ++ct) *(LAS f32x4*)(part + ((C.wave * NCT + ct) * 64 + lane) * 4) = acc[ct];
            __syncthreads();
            for (int te = C.tid; te < 256 * NCT; te += NTHR) {
                const int ct = te >> 8, e = te & 255, ln = e >> 2, i = e & 3; float sum = 0.f;
#pragma unroll
                for (int w2 = 0; w2 < 8; ++w2) sum += part[((w2 * NCT + ct) * 64 + ln) * 4 + i];
                const int row = 4 * (ln >> 4) + i, col = 16 * ct + (ln & 15);
                if (SK == 1) ((float*)(C.ws + WS_GATES))[(size_t)(it * 16 + row) * NGATE + col] = sum;
                else if (col < 8) lgt[row * 8 + col] = sum;
            }
            if (SK == 2) {
                LAS int* esel = (LAS int*)(C.lds + 90368 + 512);
                __syncthreads();
                int e0 = 0, e1 = 1; float g0 = 0.f, g1 = 0.f;
                if (C.tid < 16) {
                    float my[8];
#pragma unroll
                    for (int c = 0; c < 8; ++c) my[c] = lgt[C.tid * 8 + c];
                    float v0 = my[0];
#pragma unroll
                    for (int c = 1; c < 8; ++c) if (my[c] > v0) { v0 = my[c]; e0 = c; }
                    float v1 = -3.0e38f; e1 = -1;
#pragma unroll
                    for (int c = 0; c < 8; ++c) if (c != e0 && my[c] > v1) { v1 = my[c]; e1 = c; }
                    g0 = 1.0f / (1.0f + __expf(v1 - v0)); g1 = 1.0f - g0;
                    esel[2 * C.tid] = e0; esel[2 * C.tid + 1] = e1;
                }
                __syncthreads();
                if (C.tid < 16) {
                    unsigned lr0 = 0, lr1 = 0;
                    for (int r2 = 0; r2 < C.tid; ++r2) { const int a0 = esel[2 * r2], a1 = esel[2 * r2 + 1]; lr0 += (a0 == e0) + (a1 == e0); lr1 += (a0 == e1) + (a1 == e1); }
                    unsigned* rt = (unsigned*)(C.ws + WS_ROUTE) + (size_t)(it * 16 + C.tid) * 8;
                    rt[0] = (unsigned)e0; rt[1] = (unsigned)e1; rt[2] = lr0; rt[3] = lr1; rt[4] = __builtin_bit_cast(unsigned, g0); rt[5] = __builtin_bit_cast(unsigned, g1);
                } else if (C.tid >= 64 && C.tid < 72) {
                    const int e = C.tid - 64; unsigned hcount = 0;
                    for (int i = 0; i < 32; ++i) hcount += (esel[i] == e);
                    ((unsigned*)(C.ws + WS_ROUTE + 524288))[it * 8 + e] = hcount;
                }
            }
            __syncthreads();
        }
    }
}

__device__ __forceinline__ int moe_cum_table(Ctx& C, int lm, bool moe) {
    if (C.tid == 0) {
        const unsigned* gcnt = (const unsigned*)(C.ws + WS_CTL) + CW_CNT + 64 * lm; int acc = 0;
        for (int e = 0; e < 8; ++e) { const int nb = moe ? (int)((__hip_atomic_load(gcnt + e, __ATOMIC_RELAXED, __HIP_MEMORY_SCOPE_AGENT) + 255u) >> 8) : (e == 0 ? T / 256 : 0); acc += nb; C.misc[e] = (unsigned)acc; }
    }
    __syncthreads();
    return (int)C.misc[7];
}
__device__ __forceinline__ void moe_dispatch(Ctx& C, int lm) {
    LAS unsigned* P = (LAS unsigned*)C.lds;
    LAS unsigned* segs = (LAS unsigned*)(C.lds + 32768);
    const unsigned* IH = (const unsigned*)(C.ws + WS_ROUTE + 524288);
    for (int i = C.tid; i < 8192 / 4; i += NTHR) *(LAS u32x4*)(P + 4 * i) = *(const u32x4*)(IH + 4 * i);
    __syncthreads();
    {
        const int e = C.tid & 7, seg = C.tid >> 3; unsigned run = 0;
        for (int i = 0; i < 16; ++i) { const int idx = (seg * 16 + i) * 8 + e; const unsigned v = P[idx]; P[idx] = run; run += v; }
        segs[seg * 8 + e] = run;
    }
    __syncthreads();
    if (C.tid < 8) { unsigned run = 0; for (int sgi = 0; sgi < 64; ++sgi) { const unsigned v = segs[sgi * 8 + C.tid]; segs[sgi * 8 + C.tid] = run; run += v; }
        C.misc[16 + C.tid] = run;
        if (C.blk == 0) __hip_atomic_store((unsigned*)(C.ws + WS_CTL) + CW_CNT + 64 * lm + C.tid, run, __ATOMIC_RELAXED, __HIP_MEMORY_SCOPE_AGENT); }
    __syncthreads();
    { const int e = C.tid & 7, seg = C.tid >> 3; const unsigned off = segs[seg * 8 + e];
      for (int i = 0; i < 16; ++i) P[(seg * 16 + i) * 8 + e] += off; }
    if (C.tid == 0) { int acc = 0; for (int e = 0; e < 8; ++e) { acc += (int)((C.misc[16 + e] + 255u) >> 8); C.misc[e] = (unsigned)acc; } }
    __syncthreads();
    unsigned* route = (unsigned*)(C.ws + WS_ROUTE); const bf16* HB = (const bf16*)(C.ws + WS_HBF); bf16* XS = (bf16*)(C.ws + B_XS);
    const int gw = C.blk * NWAVES + C.wave, NGW = C.G * NWAVES;
    for (int t = gw; t < T; t += NGW) {
        unsigned* rt = route + (size_t)t * 8;
        const unsigned e0 = rt[0], e1 = rt[1]; const int it = t >> 4;
        const unsigned d0 = (e0 ? C.misc[e0 - 1] : 0u) * 256u + P[it * 8 + e0] + rt[2], d1 = (e1 ? C.misc[e1 - 1] : 0u) * 256u + P[it * 8 + e1] + rt[3];
        if (C.lane == 0) { rt[6] = d0; rt[7] = d1; }
        const u32x4* s = (const u32x4*)(HB + (size_t)t * D); u32x4* p0 = (u32x4*)(XS + (size_t)d0 * D); u32x4* p1 = (u32x4*)(XS + (size_t)d1 * D);
        const u32x4 a = s[C.lane], b = s[C.lane + 64];
        p0[C.lane] = a; p0[C.lane + 64] = b; p1[C.lane] = a; p1[C.lane + 64] = b;
    }
}

__device__ __forceinline__ void conv_phase(Ctx& C, int l) {
    const bf16* XR = (const bf16*)(C.ws + B_XBCR); const bf16* QR = (const bf16*)(C.ws + B_MQKR); bf16* XC = (bf16*)(C.ws + B_XBCC); bf16* QC = (bf16*)(C.ws + B_MQKC);
    const float* cw1 = C.in[4] + (size_t)l * 5 * 1536; const float* cb1 = C.in[5] + (size_t)l * 1536;
    const float* cw2 = C.in[12] + (size_t)l * 5 * 1024; const float* cb2 = C.in[13] + (size_t)l * 1024;
    const int NIT = (T / 8) * 320;
    for (int it = C.blk * NTHR + C.tid; it < NIT; it += C.G * NTHR) {
        const int tb = it / 320, gi = it - tb * 320; const int tok0 = tb * 8, t0 = tok0 & (SEQ - 1);
        const bool second = gi >= 192; const int c0 = second ? (gi - 192) * 8 : gi * 8; const int ld = second ? 1024 : 1536;
        const bf16* src = (second ? QR : XR) + c0; const float* cw = (second ? cw2 : cw1) + c0; const float* cb = (second ? cb2 : cb1) + c0;
        float wk[5][8], bias[8];
#pragma unroll
        for (int k = 0; k < 5; ++k) { const f32x4 wa = *(const f32x4*)(cw + (size_t)k * ld), wb = *(const f32x4*)(cw + (size_t)k * ld + 4);
            wk[k][0] = wa.x; wk[k][1] = wa.y; wk[k][2] = wa.z; wk[k][3] = wa.w; wk[k][4] = wb.x; wk[k][5] = wb.y; wk[k][6] = wb.z; wk[k][7] = wb.w; }
        { const f32x4 ba = *(const f32x4*)cb, bb = *(const f32x4*)(cb + 4); bias[0] = ba.x; bias[1] = ba.y; bias[2] = ba.z; bias[3] = ba.w; bias[4] = bb.x; bias[5] = bb.y; bias[6] = bb.z; bias[7] = bb.w; }
        u32x4 xr[12];
#pragma unroll
        for (int i = 0; i < 12; ++i) { const int tt = t0 + i - 2; xr[i] = (tt >= 0 && tt < SEQ) ? *(const u32x4*)(src + (size_t)(tok0 + i - 2) * ld) : (u32x4){0u, 0u, 0u, 0u}; }
#pragma unroll
        for (int o = 0; o < 8; ++o) {
            float acc[8];
#pragma unroll
            for (int j = 0; j < 8; ++j) acc[j] = bias[j];
#pragma unroll
            for (int k = 0; k < 5; ++k) { const u32x4 x = xr[o + k];
                acc[0] += bflo(x.x) * wk[k][0]; acc[1] += bfhi(x.x) * wk[k][1]; acc[2] += bflo(x.y) * wk[k][2]; acc[3] += bfhi(x.y) * wk[k][3];
                acc[4] += bflo(x.z) * wk[k][4]; acc[5] += bfhi(x.z) * wk[k][5]; acc[6] += bflo(x.w) * wk[k][6]; acc[7] += bfhi(x.w) * wk[k][7]; }
            u32x4 ov; ov.x = pk2(siluf_(acc[0]), siluf_(acc[1])); ov.y = pk2(siluf_(acc[2]), siluf_(acc[3])); ov.z = pk2(siluf_(acc[4]), siluf_(acc[5])); ov.w = pk2(siluf_(acc[6]), siluf_(acc[7]));
            *(u32x4*)((second ? QC : XC) + (size_t)(tok0 + o) * ld + c0) = ov;
        }
    }
    u32x4* z = (u32x4*)(C.ws + B_YBUF); const size_t NZ = (FAST_SSD && FAST_HG && FAST_ML) ? 0 : (size_t)160 * MiB / 16;
    for (size_t i = (size_t)C.blk * NTHR + C.tid; i < NZ; i += (size_t)C.G * NTHR) z[i] = (u32x4){0u, 0u, 0u, 0u};
}

__device__ __forceinline__ void naive_mixers(Ctx& C, int l) {
    const float* Gt = (const float*)(C.ws + WS_GATES);
    const bf16* XC = (const bf16*)(C.ws + B_XBCC); const bf16* QC = (const bf16*)(C.ws + B_MQKC);
    const bf16* HQ = (const bf16*)(C.ws + B_HQ); const bf16* HFR = (const bf16*)(C.ws + B_HFR); const bf16* HI = (const bf16*)(C.ws + B_HI); const bf16* MV = (const bf16*)(C.ws + B_MV);
    float* YB = (float*)(C.ws + B_YBUF); float* OB = (float*)(C.ws + B_OBUF); float* HBf = (float*)(C.ws + B_HBUF);
    const int tid = C.tid;
    for (int u = C.blk; u < 96; u += C.G) {
        if ((u < 64 && FAST_SSD) || (u >= 64 && u < 80 && FAST_HG) || (u >= 80 && FAST_ML)) continue;
        if (u < 64) {
            const int b = u >> 5, dir = (u >> 4) & 1, h = u & 15, g = h >> 3;
            const int p = tid >> 3, nq = tid & 7;
            const float dtb = C.in[6][(l * 2 + dir) * 16 + h], Aneg = -__expf(C.in[7][(l * 2 + dir) * 16 + h]);
            float st[16];
#pragma unroll
            for (int i = 0; i < 16; ++i) st[i] = 0.f;
            for (int s = 0; s < SEQ; ++s) {
                const int t = dir ? (SEQ - 1 - s) : s; const size_t tok = (size_t)b * SEQ + t;
                const float dt = softplusf_(Gt[tok * NGATE + dir * 16 + h] + dtb), dec = __expf(dt * Aneg);
                const float xv = dt * bf2f(XC[tok * 1536 + h * 64 + p]);
                const u32x4 b0 = *(const u32x4*)(XC + tok * 1536 + 1024 + g * 128 + nq * 16), b1 = *(const u32x4*)(XC + tok * 1536 + 1024 + g * 128 + nq * 16 + 8);
                const u32x4 c0 = *(const u32x4*)(XC + tok * 1536 + 1280 + g * 128 + nq * 16), c1 = *(const u32x4*)(XC + tok * 1536 + 1280 + g * 128 + nq * 16 + 8);
                const unsigned bw[8] = {b0.x, b0.y, b0.z, b0.w, b1.x, b1.y, b1.z, b1.w}, cwv[8] = {c0.x, c0.y, c0.z, c0.w, c1.x, c1.y, c1.z, c1.w};
                float y = 0.f;
#pragma unroll
                for (int i = 0; i < 8; ++i) {
                    st[2 * i] = st[2 * i] * dec + xv * bflo(bw[i]); st[2 * i + 1] = st[2 * i + 1] * dec + xv * bfhi(bw[i]);
                    y += st[2 * i] * bflo(cwv[i]) + st[2 * i + 1] * bfhi(cwv[i]);
                }
                y += __shfl_xor(y, 1); y += __shfl_xor(y, 2); y += __shfl_xor(y, 4);
                if (nq == 0) atomicAdd(YB + tok * 1024 + h * 64 + p, y);
            }
        } else if (u < 80) {
            const int uu = u - 64, b = uu >> 3, dir = (uu >> 2) & 1, hd = uu & 3;
            const int v = tid >> 2, kq = tid & 3;
            float st[32], oml[32];
#pragma unroll
            for (int i = 0; i < 32; ++i) {
                const int ch = hd * 128 + kq * 32 + i;
                const float x0 = C.in[10][0 * 512 + ch], x1 = C.in[10][1 * 512 + ch], x2 = C.in[10][2 * 512 + ch], x3 = C.in[10][3 * 512 + ch];
                const float mx = fmaxf(fmaxf(x0, x1), fmaxf(x2, x3)); const float e0 = __expf(x0 - mx), e1 = __expf(x1 - mx), e2 = __expf(x2 - mx), e3 = __expf(x3 - mx); const float inv = 1.0f / (e0 + e1 + e2 + e3);
                float lb = 0.f; if (l >= 1) lb += e1 * inv; if (l >= 2) lb += e2 * inv; if (l >= 3) lb += e3 * inv;
                oml[i] = 1.0f - lb; st[i] = 0.f;
            }
            for (int s = 0; s < SEQ; ++s) {
                const int t = dir ? (SEQ - 1 - s) : s; const size_t tok = (size_t)b * SEQ + t;
                const float vv = bf2f(HI[tok * 512 + hd * 128 + v]);
                float o = 0.f;
#pragma unroll
                for (int c4 = 0; c4 < 4; ++c4) {
                    const u32x4 fw = *(const u32x4*)(HFR + tok * 1024 + dir * 512 + hd * 128 + kq * 32 + c4 * 8);
                    const u32x4 qw = *(const u32x4*)(HQ + tok * 512 + hd * 128 + kq * 32 + c4 * 8);
                    const unsigned fa[4] = {fw.x, fw.y, fw.z, fw.w}, qa[4] = {qw.x, qw.y, qw.z, qw.w};
#pragma unroll
                    for (int i = 0; i < 4; ++i) {
                        const int k0 = c4 * 8 + 2 * i;
                        const float key0 = oml[k0] * sigmoidf_(-bflo(fa[i])), key1 = oml[k0 + 1] * sigmoidf_(-bfhi(fa[i]));
                        st[k0] = (1.0f - key0) * st[k0] + key0 * vv; st[k0 + 1] = (1.0f - key1) * st[k0 + 1] + key1 * vv;
                        o += siluf_(bflo(qa[i])) * st[k0] + siluf_(bfhi(qa[i])) * st[k0 + 1];
                    }
                }
                o += __shfl_xor(o, 1); o += __shfl_xor(o, 2);
                if (kq == 0) atomicAdd(OB + tok * 512 + hd * 128 + v, o);
            }
        } else {
            const int uu = u - 80, b = uu >> 3, dir = (uu >> 2) & 1, hd = uu & 3;
            const int v = tid >> 2, kq = tid & 3;
            const float igb = C.in[14][(l * 2 + dir) * 4 + hd], fgb = C.in[15][(l * 2 + dir) * 4 + hd];
            float cs[32], ns[32];
#pragma unroll
            for (int i = 0; i < 32; ++i) { cs[i] = 0.f; ns[i] = 0.f; }
            for (int s = 0; s < SEQ; ++s) {
                const int t = dir ? (SEQ - 1 - s) : s; const size_t tok = (size_t)b * SEQ + t;
                const float ei = __expf(Gt[tok * NGATE + 32 + dir * 4 + hd] + igb);
                const float f = __expf(-softplusf_(-(Gt[tok * NGATE + 40 + dir * 4 + hd] + fgb)));
                const float vv = bf2f(MV[tok * 512 + hd * 128 + v]);
                float num = 0.f, den = 0.f;
#pragma unroll
                for (int c4 = 0; c4 < 4; ++c4) {
                    const u32x4 qw = *(const u32x4*)(QC + tok * 1024 + hd * 128 + kq * 32 + c4 * 8);
                    const u32x4 kw = *(const u32x4*)(QC + tok * 1024 + 512 + hd * 128 + kq * 32 + c4 * 8);
                    const unsigned qa[4] = {qw.x, qw.y, qw.z, qw.w}, ka[4] = {kw.x, kw.y, kw.z, kw.w};
#pragma unroll
                    for (int i = 0; i < 4; ++i) {
                        const int k0 = c4 * 8 + 2 * i;
                        const float ka0 = ei * bflo(ka[i]), ka1 = ei * bfhi(ka[i]);
                        cs[k0] = f * cs[k0] + ka0 * vv; cs[k0 + 1] = f * cs[k0 + 1] + ka1 * vv;
                        ns[k0] = f * ns[k0] + ka0; ns[k0 + 1] = f * ns[k0 + 1] + ka1;
                        const float q0 = bflo(qa[i]) * 0.08838834764831845f, q1 = bfhi(qa[i]) * 0.08838834764831845f;
                        num += q0 * cs[k0] + q1 * cs[k0 + 1]; den += q0 * ns[k0] + q1 * ns[k0 + 1];
                    }
                }
                num += __shfl_xor(num, 1); num += __shfl_xor(num, 2); den += __shfl_xor(den, 1); den += __shfl_xor(den, 2);
                if (kq == 0) atomicAdd(HBf + tok * 512 + hd * 128 + v, num / fmaxf(fabsf(den), 1.0f));
            }
        }
    }
}
__device__ __forceinline__ void naive_combine(Ctx& C, int l) {
    const float* YB = (const float*)(C.ws + B_YBUF); const float* OB = (const float*)(C.ws + B_OBUF); const float* HBf = (const float*)(C.ws + B_HBUF);
    const bf16* XC = (const bf16*)(C.ws + B_XBCC); const bf16* Z = (const bf16*)(C.ws + B_Z); const bf16* HG = (const bf16*)(C.ws + B_HG); const bf16* MO = (const bf16*)(C.ws + B_MO);
    bf16* MIX = (bf16*)(C.ws + B_MIX);
    const float* dsk = C.in[8] + l * 16; const float* nw1 = C.in[9] + l * 1024; const float* nw2 = C.in[11] + l * 512; const float* nw3 = C.in[16] + l * 512;
    const int gw = C.blk * NWAVES + C.wave, NGW = C.G * NWAVES, lane = C.lane;
    for (int tok = gw; tok < T; tok += NGW) {
        if (!FAST_SSD) { float y[16]; float ss = 0.f; const int c0 = 16 * lane; const float dk = dsk[c0 >> 6];
#pragma unroll
          for (int j = 0; j < 16; ++j) { const float x = bf2f(XC[(size_t)tok * 1536 + c0 + j]); const float z = bf2f(Z[(size_t)tok * 1024 + c0 + j]);
              y[j] = (YB[(size_t)tok * 1024 + c0 + j] + x * dk) * siluf_(z); ss += y[j] * y[j]; }
#pragma unroll
          for (int o = 1; o < 32; o <<= 1) ss += __shfl_xor(ss, o);
          const float r = 1.0f / sqrtf(ss * (1.f / 512.f) + RMS_EPS);
#pragma unroll
          for (int j = 0; j < 16; ++j) MIX[(size_t)tok * 2048 + c0 + j] = (bf16)f2bf(y[j] * r * nw1[c0 + j]); }
        if (!FAST_HG) { float o[8]; float ss = 0.f; const int c0 = 8 * lane;
#pragma unroll
          for (int j = 0; j < 8; ++j) { o[j] = OB[(size_t)tok * 512 + c0 + j]; ss += o[j] * o[j]; }
#pragma unroll
          for (int q = 1; q < 16; q <<= 1) ss += __shfl_xor(ss, q);
          const float r = 1.0f / sqrtf(ss * (1.f / 128.f) + RMS_EPS);
#pragma unroll
          for (int j = 0; j < 8; ++j) MIX[(size_t)tok * 2048 + 1024 + c0 + j] = (bf16)f2bf(o[j] * r * nw2[c0 + j] * siluf_(bf2f(HG[(size_t)tok * 512 + c0 + j]))); }
        if (!FAST_ML) { float o[8]; float s = 0.f; const int c0 = 8 * lane;
#pragma unroll
          for (int j = 0; j < 8; ++j) { o[j] = HBf[(size_t)tok * 512 + c0 + j]; s += o[j]; }
#pragma unroll
          for (int q = 1; q < 16; q <<= 1) s += __shfl_xor(s, q);
          const float mean = s * (1.f / 128.f); float ss = 0.f;
#pragma unroll
          for (int j = 0; j < 8; ++j) { o[j] -= mean; ss += o[j] * o[j]; }
#pragma unroll
          for (int q = 1; q < 16; q <<= 1) ss += __shfl_xor(ss, q);
          const float r = 1.0f / sqrtf(ss * (1.f / 128.f) + LN_EPS);
#pragma unroll
          for (int j = 0; j < 8; ++j) MIX[(size_t)tok * 2048 + 1536 + c0 + j] = (bf16)f2bf(o[j] * r * nw3[c0 + j] * sigmoidf_(bf2f(MO[(size_t)tok * 512 + c0 + j]))); }
    }
}


#define MFMA16(a, b, c) __builtin_amdgcn_mfma_f32_16x16x32_bf16((a), (b), (c), 0, 0, 0)
__device__ __forceinline__ unsigned lds_addr(const LAS unsigned char* p) { return (unsigned)(size_t)p; }
__device__ __forceinline__ bf16x8 frag_row(const LAS unsigned char* img, int stride, int row, int kel) { return *(const LAS bf16x8*)(img + row * stride + kel * 2); }
__device__ __forceinline__ bf16x8 tr2(unsigned a0, unsigned a1) {
    s16x4 lo, hi;
    asm volatile("ds_read_b64_tr_b16 %0, %2\n\tds_read_b64_tr_b16 %1, %3\n\ts_waitcnt lgkmcnt(0)" : "=&v"(lo), "=&v"(hi) : "v"(a0), "v"(a1) : "memory");
    return __builtin_shufflevector(lo, hi, 0, 1, 2, 3, 4, 5, 6, 7);
}
template <int DB>
__device__ __forceinline__ void tr_quad(unsigned a, bf16x8& f0, bf16x8& f1, bf16x8& f2, bf16x8& f3) {
    s16x4 l0, h0, l1, h1, l2, h2, l3, h3;
    asm volatile("ds_read_b64_tr_b16 %0, %8\n\tds_read_b64_tr_b16 %1, %8 offset:%9\n\tds_read_b64_tr_b16 %2, %8 offset:32\n\tds_read_b64_tr_b16 %3, %8 offset:%10\n\t"
                 "ds_read_b64_tr_b16 %4, %8 offset:64\n\tds_read_b64_tr_b16 %5, %8 offset:%11\n\tds_read_b64_tr_b16 %6, %8 offset:96\n\tds_read_b64_tr_b16 %7, %8 offset:%12\n\ts_waitcnt lgkmcnt(0)"
                 : "=&v"(l0), "=&v"(h0), "=&v"(l1), "=&v"(h1), "=&v"(l2), "=&v"(h2), "=&v"(l3), "=&v"(h3)
                 : "v"(a), "n"(DB), "n"(DB + 32), "n"(DB + 64), "n"(DB + 96) : "memory");
    f0 = __builtin_shufflevector(l0, h0, 0, 1, 2, 3, 4, 5, 6, 7); f1 = __builtin_shufflevector(l1, h1, 0, 1, 2, 3, 4, 5, 6, 7);
    f2 = __builtin_shufflevector(l2, h2, 0, 1, 2, 3, 4, 5, 6, 7); f3 = __builtin_shufflevector(l3, h3, 0, 1, 2, 3, 4, 5, 6, 7);
}
template <bool ACC, int STRIDE>
__device__ __forceinline__ void frag_tr4(unsigned img, int k0, int n0, int r, int q, bf16x8 (&f)[4]) {
    const unsigned a = img + (k0 + (ACC ? 4 : 8) * q + (r >> 2)) * STRIDE + (n0 + 4 * (r & 3)) * 2;
    tr_quad<(ACC ? 16 : 4) * STRIDE>(a, f[0], f[1], f[2], f[3]);
}
__device__ __forceinline__ bf16x8 frag_tr(unsigned img, int stride, int k0, int n0, int r, int q) { const unsigned a = img + (k0 + 8 * q + (r >> 2)) * stride + (n0 + 4 * (r & 3)) * 2; return tr2(a, a + 4 * stride); }
__device__ __forceinline__ bf16x8 frag_tr_acc(unsigned img, int stride, int k0, int n0, int r, int q) { const unsigned a = img + (k0 + 4 * q + (r >> 2)) * stride + (n0 + 4 * (r & 3)) * 2; return tr2(a, a + 16 * stride); }
__device__ __forceinline__ bf16x8 pack8(const float (&v)[8]) { u32x4 w; w.x = pk2(v[0], v[1]); w.y = pk2(v[2], v[3]); w.z = pk2(v[4], v[5]); w.w = pk2(v[6], v[7]); return __builtin_bit_cast(bf16x8, w); }
__device__ __forceinline__ void unpack8(const bf16x8 f, float (&v)[8]) { const u32x4 w = __builtin_bit_cast(u32x4, f); v[0] = bflo(w.x); v[1] = bfhi(w.x); v[2] = bflo(w.y); v[3] = bfhi(w.y); v[4] = bflo(w.z); v[5] = bfhi(w.z); v[6] = bflo(w.w); v[7] = bfhi(w.w); }
__device__ __forceinline__ u32x2 pack4(const f32x4 v) { u32x2 w; w.x = pk2(v[0], v[1]); w.y = pk2(v[2], v[3]); return w; }
template <int ROWS, int COLS> struct TileRegs { u32x4 v[ROWS * COLS / 8 / NTHR]; };
template <int ROWS, int COLS>
__device__ __forceinline__ void tile_gload(TileRegs<ROWS, COLS>& t, const bf16* src, size_t ld, int tid) {
    constexpr int CPR = COLS / 8, NI = ROWS * COLS / 8 / NTHR;
#pragma unroll
    for (int i = 0; i < NI; ++i) { const int idx = tid + i * NTHR, row = idx / CPR, ch = idx - row * CPR; t.v[i] = *(const u32x4*)(src + (size_t)row * ld + ch * 8); }
}
template <int ROWS, int COLS, int STRIDE>
__device__ __forceinline__ void tile_sstore(const TileRegs<ROWS, COLS>& t, LAS unsigned char* img, int tid) {
    constexpr int CPR = COLS / 8, NI = ROWS * COLS / 8 / NTHR;
#pragma unroll
    for (int i = 0; i < NI; ++i) { const int idx = tid + i * NTHR, row = idx / CPR, ch = idx - row * CPR; *(LAS u32x4*)(img + row * STRIDE + ch * 16) = t.v[i]; }
}
__device__ __forceinline__ void scan128(float a0, float a1, int lane, float& i0, float& i1, float& tot) {
    float s = a0 + a1;
#pragma unroll
    for (int o = 1; o < 64; o <<= 1) { const float t = __shfl_up(s, o); if (lane >= o) s += t; }
    i1 = s; i0 = s - a1; tot = __shfl(s, 63);
}
__device__ __forceinline__ float hg_lb(const float* lbl, int l, int ch) {
    const float x0 = lbl[0 * 512 + ch], x1 = lbl[1 * 512 + ch], x2 = lbl[2 * 512 + ch], x3 = lbl[3 * 512 + ch];
    const float mx = fmaxf(fmaxf(x0, x1), fmaxf(x2, x3)); const float e0 = __expf(x0 - mx), e1 = __expf(x1 - mx), e2 = __expf(x2 - mx), e3 = __expf(x3 - mx); const float inv = 1.0f / (e0 + e1 + e2 + e3);
    float lb = 0.f; if (l >= 1) lb += e1 * inv; if (l >= 2) lb += e2 * inv; if (l >= 3) lb += e3 * inv; return lb;
}

__device__ __forceinline__ void mix_params(Ctx& C, int l) {
    LAS float* P = (LAS float*)(C.lds + PAR_OFF);
    if (C.tid < 512) P[C.tid] = 1.0f - hg_lb(C.in[10], l, C.tid);
    if (C.tid < 32) { P[512 + C.tid] = C.in[6][l * 32 + C.tid]; P[544 + C.tid] = -__expf(C.in[7][l * 32 + C.tid]); }
    if (C.tid < 16) P[576 + C.tid] = C.in[8][l * 16 + C.tid];
    if (C.tid < 8) { P[592 + C.tid] = C.in[14][l * 8 + C.tid]; P[600 + C.tid] = C.in[15][l * 8 + C.tid]; }
    __syncthreads();
}
#define UNIT_PROLOG() Ctx C = C0_; { int ln_; asm volatile("v_mbcnt_lo_u32_b32 %0, -1, 0\n\tv_mbcnt_hi_u32_b32 %0, -1, %0" : "=v"(ln_)); C.lane = ln_; C.tid = C.wave * 64 + ln_; C.ws = (unsigned char*)C0_.in[30]; }
__device__ __forceinline__ void ssdC_seq(Ctx& C0_, int l, int u0, int nu, int ustride) { UNIT_PROLOG();
    const int tid = C.tid, lane = C.lane, w = C.wave, r = lane & 15, q = lane >> 4;
    LAS unsigned char* Bimg = C.lds; LAS unsigned char* Ximg = C.lds + 34816; LAS float* wv = (LAS float*)(C.lds + 102400);
    const bf16* XC = (const bf16*)(C.ws + B_XBCC);
    TileRegs<128, 128> tB; TileRegs<128, 256> tX;
    { const int half = u0 & 1, g = (u0 >> 1) & 1, c = (u0 >> 2) & 63, b = u0 >> 8; const size_t tok0 = (size_t)b * SEQ + c * 128;
      tile_gload(tB, XC + tok0 * 1536 + 1024 + g * 128, 1536, tid); tile_gload(tX, XC + tok0 * 1536 + (g * 8 + half * 4) * 64, 1536, tid); }
#pragma unroll 1
    for (int iu = 0; iu < nu; ++iu) {
        const int u = u0 + iu * ustride;
        const int half = u & 1, g = (u >> 1) & 1, c = (u >> 2) & 63, b = u >> 8;
        const size_t tok0 = (size_t)b * SEQ + c * 128;
        {
            const int hh = w >> 1, dir = w & 1, h = g * 8 + half * 4 + hh;
            const float dtb = ((const LAS float*)(C.lds + PAR_OFF))[512 + dir * 16 + h], Aneg = ((const LAS float*)(C.lds + PAR_OFF))[544 + dir * 16 + h];
            const float* Gt = (const float*)(C.ws + WS_GATES);
            const float d0 = softplusf_(Gt[(tok0 + 2 * lane) * NGATE + dir * 16 + h] + dtb), d1 = softplusf_(Gt[(tok0 + 2 * lane + 1) * NGATE + dir * 16 + h] + dtb);
            const float a0 = d0 * Aneg, a1 = d1 * Aneg; float i0, i1, tot; scan128(a0, a1, lane, i0, i1, tot);
            const float c0 = dir ? tot - i0 + a0 : i0, c1 = dir ? tot - i1 + a1 : i1;
            wv[w * 128 + 2 * lane] = d0 * __expf(tot - c0); wv[w * 128 + 2 * lane + 1] = d1 * __expf(tot - c1);
            if (lane == 0) ((float*)(C.ws + B_DECS))[((b * 64 + c) * 2 + dir) * 16 + h] = __expf(tot);
        }
        tile_sstore<128, 128, 272>(tB, Bimg, tid); tile_sstore<128, 256, 528>(tX, Ximg, tid);
        if (iu + 1 < nu) {
            const int u2 = u + ustride; const int half2 = u2 & 1, g2 = (u2 >> 1) & 1, c2 = (u2 >> 2) & 63, b2 = u2 >> 8; const size_t tk2 = (size_t)b2 * SEQ + c2 * 128;
            tile_gload(tB, XC + tk2 * 1536 + 1024 + g2 * 128, 1536, tid); tile_gload(tX, XC + tk2 * 1536 + (g2 * 8 + half2 * 4) * 64, 1536, tid);
        }
        __syncthreads();
        const unsigned bimg = lds_addr(Bimg), ximg = lds_addr(Ximg);
        bf16x8 bfr[4];
#pragma unroll
        for (int ks = 0; ks < 4; ++ks) bfr[ks] = frag_tr(bimg, 272, 32 * ks, 16 * w, r, q);
        bf16* ST = (bf16*)(C.ws + B_STS);
#pragma unroll 1
        for (int hh = 0; hh < 4; ++hh) {
            const int h = g * 8 + half * 4 + hh;
            f32x4 acc[2][4];
#pragma unroll
            for (int d = 0; d < 2; ++d)
#pragma unroll
                for (int pt = 0; pt < 4; ++pt) acc[d][pt] = (f32x4){0.f, 0.f, 0.f, 0.f};
#pragma unroll
            for (int ks = 0; ks < 4; ++ks) {
                bf16x8 xf[4]; frag_tr4<false, 528>(ximg, 32 * ks, hh * 64, r, q, xf);
                float bv[8]; unpack8(bfr[ks], bv);
#pragma unroll
                for (int d = 0; d < 2; ++d) {
                    const f32x4 w0 = *(const LAS f32x4*)(wv + (hh * 2 + d) * 128 + 32 * ks + 8 * q), w1 = *(const LAS f32x4*)(wv + (hh * 2 + d) * 128 + 32 * ks + 8 * q + 4);
                    float sv[8] = {bv[0] * w0.x, bv[1] * w0.y, bv[2] * w0.z, bv[3] * w0.w, bv[4] * w1.x, bv[5] * w1.y, bv[6] * w1.z, bv[7] * w1.w};
                    const bf16x8 bs = pack8(sv);
#pragma unroll
                    for (int pt = 0; pt < 4; ++pt) acc[d][pt] = MFMA16(bs, xf[pt], acc[d][pt]);
                }
            }
            LAS unsigned char* Oimg = C.lds + 106496;
#pragma unroll
            for (int d = 0; d < 2; ++d) {
#pragma unroll
                for (int pt = 0; pt < 4; ++pt) *(LAS u32x2*)(Oimg + (16 * pt + r) * 272 + (16 * w + 4 * q) * 2) = pack4(acc[d][pt]);
                __syncthreads();
                bf16* dstp = ST + (size_t)(((b * 64 + c) * 2 + d) * 16 + h) * 8192;
#pragma unroll
                for (int i = 0; i < 2; ++i) { const int idx = tid + i * NTHR, row = idx >> 4, ch = idx & 15; *(u32x4*)(dstp + row * 128 + ch * 8) = *(const LAS u32x4*)(Oimg + row * 272 + ch * 16); }
                __syncthreads();
            }
        }
        __syncthreads();
    }
}
__device__ __forceinline__ void mlC_seq(Ctx& C0_, int l, int u0, int nu, int ustride) { UNIT_PROLOG();
    const int tid = C.tid, lane = C.lane, w = C.wave, r = lane & 15, q = lane >> 4;
    LAS unsigned char* Kimg = C.lds; LAS unsigned char* Vimg = C.lds + 34816; LAS float* wv = (LAS float*)(C.lds + 69632);
    TileRegs<128, 128> tK, tV;
    { const int hd = u0 & 3, c = (u0 >> 2) & 63, b = u0 >> 8; const size_t tok0 = (size_t)b * SEQ + c * 128;
      tile_gload(tK, (const bf16*)(C.ws + B_MQKC) + tok0 * 1024 + 512 + hd * 128, 1024, tid); tile_gload(tV, (const bf16*)(C.ws + B_MV) + tok0 * 512 + hd * 128, 512, tid); }
    float gf0 = 0.f, gf1 = 0.f, gi0 = 0.f, gi1 = 0.f;
    if (w < 2) { const int hd = u0 & 3, c = (u0 >> 2) & 63, b = u0 >> 8; const size_t tok0 = (size_t)b * SEQ + c * 128; const float* Gt = (const float*)(C.ws + WS_GATES);
        gf0 = Gt[(tok0 + 2 * lane) * NGATE + 40 + w * 4 + hd]; gf1 = Gt[(tok0 + 2 * lane + 1) * NGATE + 40 + w * 4 + hd]; gi0 = Gt[(tok0 + 2 * lane) * NGATE + 32 + w * 4 + hd]; gi1 = Gt[(tok0 + 2 * lane + 1) * NGATE + 32 + w * 4 + hd]; }
#pragma unroll 1
    for (int iu = 0; iu < nu; ++iu) {
        const int u = u0 + iu * ustride;
        const int hd = u & 3, c = (u >> 2) & 63, b = u >> 8;
        const size_t tok0 = (size_t)b * SEQ + c * 128;
        if (w < 2) {
            const int dir = w; const float igb = ((const LAS float*)(C.lds + PAR_OFF))[592 + dir * 4 + hd], fgb = ((const LAS float*)(C.lds + PAR_OFF))[600 + dir * 4 + hd];
            const float f0 = -softplusf_(-(gf0 + fgb)), f1 = -softplusf_(-(gf1 + fgb));
            const float li0 = gi0 + igb, li1 = gi1 + igb;
            float i0, i1, tot; scan128(f0, f1, lane, i0, i1, tot);
            const float c0 = dir ? tot - i0 + f0 : i0, c1 = dir ? tot - i1 + f1 : i1;
            wv[dir * 128 + 2 * lane] = __expf(tot - c0 + li0); wv[dir * 128 + 2 * lane + 1] = __expf(tot - c1 + li1);
            if (lane == 0) ((float*)(C.ws + B_DECM))[((b * 64 + c) * 2 + dir) * 4 + hd] = __expf(tot);
        }
        tile_sstore<128, 128, 272>(tK, Kimg, tid); tile_sstore<128, 128, 272>(tV, Vimg, tid);
        if (iu + 1 < nu) { const int u2 = u + ustride; const int hd2 = u2 & 3, c2 = (u2 >> 2) & 63, b2 = u2 >> 8; const size_t tk2 = (size_t)b2 * SEQ + c2 * 128;
            tile_gload(tK, (const bf16*)(C.ws + B_MQKC) + tk2 * 1024 + 512 + hd2 * 128, 1024, tid); tile_gload(tV, (const bf16*)(C.ws + B_MV) + tk2 * 512 + hd2 * 128, 512, tid);
            if (w < 2) { const float* Gt = (const float*)(C.ws + WS_GATES);
                gf0 = Gt[(tk2 + 2 * lane) * NGATE + 40 + w * 4 + hd2]; gf1 = Gt[(tk2 + 2 * lane + 1) * NGATE + 40 + w * 4 + hd2]; gi0 = Gt[(tk2 + 2 * lane) * NGATE + 32 + w * 4 + hd2]; gi1 = Gt[(tk2 + 2 * lane + 1) * NGATE + 32 + w * 4 + hd2]; } }
        __syncthreads();
        const unsigned kimg = lds_addr(Kimg), vimg = lds_addr(Vimg);
        bf16* ST = (bf16*)(C.ws + B_STM); float* NM = (float*)(C.ws + B_NM);
#pragma unroll 1
        for (int d = 0; d < 2; ++d) {
            f32x4 acc[8]; f32x4 nac = (f32x4){0.f, 0.f, 0.f, 0.f};
#pragma unroll
            for (int kt = 0; kt < 8; ++kt) acc[kt] = (f32x4){0.f, 0.f, 0.f, 0.f};
#pragma unroll 1
            for (int ks = 0; ks < 4; ++ks) {
                const f32x4 w0 = *(const LAS f32x4*)(wv + d * 128 + 32 * ks + 8 * q), w1 = *(const LAS f32x4*)(wv + d * 128 + 32 * ks + 8 * q + 4);
                const bf16x8 vf = frag_tr(vimg, 272, 32 * ks, 16 * w, r, q);
                const bf16x8 kown = frag_tr(kimg, 272, 32 * ks, 16 * w, r, q);
                bf16x8 kfa[4], kfb[4]; frag_tr4<false, 272>(kimg, 32 * ks, 0, r, q, kfa); frag_tr4<false, 272>(kimg, 32 * ks, 64, r, q, kfb);
                float vv[8]; unpack8(vf, vv);
                float wl[8] = {w0.x, w0.y, w0.z, w0.w, w1.x, w1.y, w1.z, w1.w};
                float sv[8], wlo[8];
#pragma unroll
                for (int j = 0; j < 8; ++j) sv[j] = vv[j] * wl[j];
                const bf16x8 vs = pack8(sv), whi = pack8(wl);
                { float wh[8]; unpack8(whi, wh);
#pragma unroll
                  for (int j = 0; j < 8; ++j) wlo[j] = wl[j] - wh[j]; }
                const bf16x8 wlf = pack8(wlo);
#pragma unroll
                for (int kt = 0; kt < 8; ++kt) acc[kt] = MFMA16(kt < 4 ? kfa[kt & 3] : kfb[kt & 3], vs, acc[kt]);
                nac = MFMA16(kown, whi, nac); nac = MFMA16(kown, wlf, nac);
            }
            const size_t sb = (size_t)(((b * 64 + c) * 2 + d) * 4 + hd);
            LAS unsigned char* Oimg = C.lds + 71680;
#pragma unroll
            for (int kt = 0; kt < 8; ++kt) *(LAS u32x2*)(Oimg + (16 * w + r) * 272 + (16 * kt + 4 * q) * 2) = pack4(acc[kt]);
            if (r == 0) *(f32x4*)(NM + sb * 128 + 16 * w + 4 * q) = nac;
            __syncthreads();
#pragma unroll
            for (int i = 0; i < 4; ++i) { const int idx = tid + i * NTHR, row = idx >> 4, ch = idx & 15; *(u32x4*)(ST + (sb * 128 + row) * 128 + ch * 8) = *(const LAS u32x4*)(Oimg + row * 272 + ch * 16); }
            __syncthreads();
        }
    }
}
template <int MODE>
__device__ __forceinline__ float hg_gates(Ctx& C, int l, int hd, int dir, LAS float*  , LAS unsigned char* Kimg, LAS float* segtot) {
    const int k = C.tid & 127, seg = C.tid >> 7;
    const float oml = ((const LAS float*)(C.lds + PAR_OFF))[hd * 128 + k];
    __syncthreads();
    float key[16], P[16]; float run = 1.f;
#pragma unroll
    for (int i = 0; i < 16; ++i) {
        const int t = dir ? (seg * 16 + 15 - i) : (seg * 16 + i);
        key[i] = oml * sigmoidf_(-bf2f(*(const LAS bf16*)(Kimg + t * 272 + k * 2)));
        run *= 1.0f - key[i]; P[i] = run;
    }
    segtot[seg * 128 + k] = run;
    __syncthreads();
    float rest = 1.f, tot = 1.f;
#pragma unroll
    for (int s2 = 0; s2 < 4; ++s2) { const float v = segtot[s2 * 128 + k]; tot *= v; if (dir ? (s2 < seg) : (s2 > seg)) rest *= v; }
    const float R = run * rest;
#pragma unroll
    for (int i = 0; i < 16; ++i) {
        const int t = dir ? (seg * 16 + 15 - i) : (seg * 16 + i);
        *(LAS bf16*)(Kimg + t * 272 + k * 2) = (bf16)f2bf(key[i] * R * __builtin_amdgcn_rcpf(fmaxf(P[i], 1e-30f)));
    }
    __syncthreads();
    return tot;
}
__device__ __forceinline__ void hgC_seq(Ctx& C0_, int l, int u0, int nu, int ustride) { UNIT_PROLOG();
    const int tid = C.tid, lane = C.lane, w = C.wave, r = lane & 15, q = lane >> 4;
    LAS float* Gimg = (LAS float*)C.lds; LAS unsigned char* Kimg = C.lds + 33792; LAS unsigned char* Vimg = C.lds + 51200; LAS float* segtot = (LAS float*)(C.lds + 68608);
    const unsigned kimg = lds_addr(Kimg), vimg = lds_addr(Vimg);
    bf16* ST = (bf16*)(C.ws + B_STH); float* DH = (float*)(C.ws + B_DECH);
    TileRegs<64, 128> tV, tF0, tF1;
    { const int hd = u0 & 3, c = (u0 >> 2) & 127, b = u0 >> 9; const size_t tok0 = (size_t)b * SEQ + c * 64;
      tile_gload(tV, (const bf16*)(C.ws + B_HI) + tok0 * 512 + hd * 128, 512, tid);
      tile_gload(tF0, (const bf16*)(C.ws + B_HFR) + tok0 * 1024 + hd * 128, 1024, tid); tile_gload(tF1, (const bf16*)(C.ws + B_HFR) + tok0 * 1024 + 512 + hd * 128, 1024, tid); }
#pragma unroll 1
    for (int iu = 0; iu < nu; ++iu) {
        const int u = u0 + iu * ustride;
        const int hd = u & 3, c = (u >> 2) & 127, b = u >> 9;
        tile_sstore<64, 128, 272>(tV, Vimg, tid);
#pragma unroll
        for (int d = 0; d < 2; ++d) {
            tile_sstore<64, 128, 272>(d ? tF1 : tF0, Kimg, tid);
            if (d == 1 && iu + 1 < nu) {
                const int u2 = u + ustride; const int hd2 = u2 & 3, c2 = (u2 >> 2) & 127, b2 = u2 >> 9; const size_t tk2 = (size_t)b2 * SEQ + c2 * 64;
                tile_gload(tV, (const bf16*)(C.ws + B_HI) + tk2 * 512 + hd2 * 128, 512, tid);
                tile_gload(tF0, (const bf16*)(C.ws + B_HFR) + tk2 * 1024 + hd2 * 128, 1024, tid); tile_gload(tF1, (const bf16*)(C.ws + B_HFR) + tk2 * 1024 + 512 + hd2 * 128, 1024, tid);
            }
            const float dec = hg_gates<1>(C, l, hd, d, Gimg, Kimg, segtot);
            const size_t sb = (size_t)(((b * 128 + c) * 2 + d) * 4 + hd);
            if (tid < 128) DH[sb * 128 + tid] = dec;
            f32x4 acc[8];
#pragma unroll
            for (int kt = 0; kt < 8; ++kt) acc[kt] = (f32x4){0.f, 0.f, 0.f, 0.f};
#pragma unroll
            for (int ks = 0; ks < 2; ++ks) {
                const bf16x8 vf = frag_tr(vimg, 272, 32 * ks, 16 * w, r, q);
                bf16x8 kfa[4], kfb[4]; frag_tr4<false, 272>(kimg, 32 * ks, 0, r, q, kfa); frag_tr4<false, 272>(kimg, 32 * ks, 64, r, q, kfb);
#pragma unroll
                for (int kt = 0; kt < 8; ++kt) acc[kt] = MFMA16(kt < 4 ? kfa[kt & 3] : kfb[kt & 3], vf, acc[kt]);
            }
            LAS unsigned char* Oimg = C.lds + 71680;
#pragma unroll
            for (int kt = 0; kt < 8; ++kt) *(LAS u32x2*)(Oimg + (16 * w + r) * 272 + (16 * kt + 4 * q) * 2) = pack4(acc[kt]);
            __syncthreads();
#pragma unroll
            for (int i = 0; i < 4; ++i) { const int idx = tid + i * NTHR, row = idx >> 4, ch = idx & 15; *(u32x4*)(ST + (sb * 128 + row) * 128 + ch * 8) = *(const LAS u32x4*)(Oimg + row * 272 + ch * 16); }
            __syncthreads();
        }
    }
}
__device__ __forceinline__ void deal_range(int blk, int G, int lo, int hi, int& first, int& cnt) {
    int j0 = (lo > blk) ? (lo - blk + G - 1) / G : 0; const int u0 = blk + j0 * G;
    if (u0 >= hi) { first = 0; cnt = 0; return; }
    first = u0 - lo; cnt = (hi - 1 - u0) / G + 1;
}
__device__ __forceinline__ void mixC_phase(Ctx& C, int l) {
    int f, n;
    mix_params(C, l);
    if (FAST_SSD) { deal_range(C.blk, C.G, 0, 512, f, n); if (n) ssdC_seq(C, l, f, n, C.G); }
    if (FAST_ML) { deal_range(C.blk, C.G, 512, 1024, f, n); if (n) mlC_seq(C, l, f, n, C.G); }
    if (FAST_HG) { deal_range(C.blk, C.G, 1024, 2048, f, n); if (n) hgC_seq(C, l, f, n, C.G); }
}

template <int NCH, int DECMODE  >
__device__ __forceinline__ void scan_items(bf16* ST, const float* DEC, size_t base, size_t cstride, size_t dbase, size_t dstride, int dir) {
    constexpr int PF = (DECMODE == 0) ? 16 : 8;
    float run[8];
#pragma unroll
    for (int j = 0; j < 8; ++j) run[j] = 0.f;
    u32x4 Lb[PF]; f32x4 Da[PF], Db[PF]; float Ds[PF];
#pragma unroll
    for (int j = 0; j < PF; ++j) { const int c = dir ? NCH - 1 - j : j; Lb[j] = *(const u32x4*)(ST + base + c * cstride);
        if (DECMODE == 0) Ds[j] = DEC[dbase + c * dstride]; else { Da[j] = *(const f32x4*)(DEC + dbase + c * dstride); Db[j] = *(const f32x4*)(DEC + dbase + c * dstride + 4); } }
#pragma unroll 1
    for (int st = 0; st < NCH; st += PF) {
#pragma unroll
        for (int j = 0; j < PF; ++j) {
            const int c = dir ? NCH - 1 - (st + j) : st + j;
            u32x4 o; o.x = pk2(run[0], run[1]); o.y = pk2(run[2], run[3]); o.z = pk2(run[4], run[5]); o.w = pk2(run[6], run[7]);
            const u32x4 L = Lb[j]; f32x4 da, db; float d = 0.f;
            if (DECMODE == 0) d = Ds[j]; else { da = Da[j]; db = Db[j]; }
            if (st + j + PF < NCH) { const int c2 = dir ? NCH - 1 - (st + j + PF) : st + j + PF; Lb[j] = *(const u32x4*)(ST + base + c2 * cstride);
                if (DECMODE == 0) Ds[j] = DEC[dbase + c2 * dstride]; else { Da[j] = *(const f32x4*)(DEC + dbase + c2 * dstride); Db[j] = *(const f32x4*)(DEC + dbase + c2 * dstride + 4); } }
            *(u32x4*)(ST + base + c * cstride) = o;
            if (DECMODE == 0) {
                run[0] = run[0] * d + bflo(L.x); run[1] = run[1] * d + bfhi(L.x); run[2] = run[2] * d + bflo(L.y); run[3] = run[3] * d + bfhi(L.y);
                run[4] = run[4] * d + bflo(L.z); run[5] = run[5] * d + bfhi(L.z); run[6] = run[6] * d + bflo(L.w); run[7] = run[7] * d + bfhi(L.w);
            } else {
                run[0] = run[0] * da.x + bflo(L.x); run[1] = run[1] * da.y + bfhi(L.x); run[2] = run[2] * da.z + bflo(L.y); run[3] = run[3] * da.w + bfhi(L.y);
                run[4] = run[4] * db.x + bflo(L.z); run[5] = run[5] * db.y + bfhi(L.z); run[6] = run[6] * db.z + bflo(L.w); run[7] = run[7] * db.w + bfhi(L.w);
            }
        }
    }
}
template <int NCH, int PF>
__device__ __forceinline__ void scan_items_lds(bf16* ST, LAS const float* dl, size_t base, size_t cstride, int dir) {
    float run[8];
#pragma unroll
    for (int j = 0; j < 8; ++j) run[j] = 0.f;
    u32x4 Lb[PF];
#pragma unroll
    for (int j = 0; j < PF; ++j) { const int c = dir ? NCH - 1 - j : j; Lb[j] = *(const u32x4*)(ST + base + c * cstride); }
#pragma unroll 1
    for (int st = 0; st < NCH; st += PF) {
#pragma unroll
        for (int j = 0; j < PF; ++j) {
            const int c = dir ? NCH - 1 - (st + j) : st + j;
            u32x4 o; o.x = pk2(run[0], run[1]); o.y = pk2(run[2], run[3]); o.z = pk2(run[4], run[5]); o.w = pk2(run[6], run[7]);
            const u32x4 L = Lb[j];
            const f32x4 da = *(LAS const f32x4*)(dl + c * 128), db = *(LAS const f32x4*)(dl + c * 128 + 4);
            if (st + j + PF < NCH) { const int c2 = dir ? NCH - 1 - (st + j + PF) : st + j + PF; Lb[j] = *(const u32x4*)(ST + base + c2 * cstride); }
            *(u32x4*)(ST + base + c * cstride) = o;
            run[0] = run[0] * da.x + bflo(L.x); run[1] = run[1] * da.y + bfhi(L.x); run[2] = run[2] * da.z + bflo(L.y); run[3] = run[3] * da.w + bfhi(L.y);
            run[4] = run[4] * db.x + bflo(L.z); run[5] = run[5] * db.y + bfhi(L.z); run[6] = run[6] * db.z + bflo(L.w); run[7] = run[7] * db.w + bfhi(L.w);
        }
    }
}
__device__ __forceinline__ void scan_phase(Ctx& C) {
    for (int vb = C.blk; vb < 256; vb += C.G) {
        const int t = C.tid;
        if (FAST_HG) {
            const int seq = vb >> 4, b = seq >> 3, dir = (seq >> 2) & 1, hd = seq & 3; const float* DH = (const float*)(C.ws + B_DECH);
#pragma unroll
            for (int i = 0; i < 8; ++i) { const int idx = t + i * NTHR, c = idx >> 5, k4 = idx & 31; *(LAS f32x4*)((LAS float*)C.lds + c * 128 + k4 * 4) = *(const f32x4*)(DH + ((size_t)((b * 128 + c) * 2 + dir) * 4 + hd) * 128 + k4 * 4); }
            __syncthreads();
        }
        if (t < 256) {
            if (FAST_SSD) { const int it = vb * 256 + t, seq = it >> 10, e8 = it & 1023, b = seq >> 5, dir = (seq >> 4) & 1, h = seq & 15;
                scan_items<64, 0>((bf16*)(C.ws + B_STS), (const float*)(C.ws + B_DECS), ((size_t)(b * 64 * 2 + dir) * 16 + h) * 8192 + e8 * 8, (size_t)2 * 16 * 8192, (size_t)(b * 64 * 2 + dir) * 16 + h, 32, dir); }
        } else if (t < 384) {
            if (FAST_ML) { const int i2 = vb * 128 + (t - 256), seq = i2 >> 11, e8 = i2 & 2047, b = seq >> 3, dir = (seq >> 2) & 1, hd = seq & 3;
                scan_items<64, 0>((bf16*)(C.ws + B_STM), (const float*)(C.ws + B_DECM), ((size_t)(b * 64 * 2 + dir) * 4 + hd) * 16384 + e8 * 8, (size_t)2 * 4 * 16384, (size_t)(b * 64 * 2 + dir) * 4 + hd, 8, dir);
                if (vb < 16) {
                    const int i3 = vb * 128 + (t - 256), seq2 = i3 >> 7, k = i3 & 127, b2 = seq2 >> 3, dir2 = (seq2 >> 2) & 1, hd2 = seq2 & 3;
                    float* NM = (float*)(C.ws + B_NM); const float* DM = (const float*)(C.ws + B_DECM); float run = 0.f;
#pragma unroll 1
                    for (int s0 = 0; s0 < 64; s0 += 32) {
                        float lv[32], dd[32];
#pragma unroll
                        for (int j = 0; j < 32; ++j) { const int c = dir2 ? 63 - (s0 + j) : s0 + j; const size_t sb = (size_t)((b2 * 64 + c) * 2 + dir2) * 4 + hd2; lv[j] = NM[sb * 128 + k]; dd[j] = DM[sb]; }
#pragma unroll
                        for (int j = 0; j < 32; ++j) { const int c = dir2 ? 63 - (s0 + j) : s0 + j; const size_t sb = (size_t)((b2 * 64 + c) * 2 + dir2) * 4 + hd2; NM[sb * 128 + k] = run; run = run * dd[j] + lv[j]; }
                    }
                } }
        } else {
            if (FAST_HG) { const int i2 = vb * 128 + (t - 384), seq = i2 >> 11, e8 = i2 & 2047, b = seq >> 3, dir = (seq >> 2) & 1, hd = seq & 3;
                scan_items_lds<128, 32>((bf16*)(C.ws + B_STH), (LAS const float*)C.lds + ((e8 * 8) & 127), ((size_t)(b * 128 * 2 + dir) * 4 + hd) * 16384 + e8 * 8, (size_t)2 * 4 * 16384, dir); }
        }
        __syncthreads();
    }
}

__device__ __forceinline__ void decay_tables(float c0, float c1, int dir, int lane, LAS float* av, LAS float* VV, LAS float* WW, float& loc0, float& loc1) {
    const int I = lane >> 3;
    const float rsrc = dir ? __shfl(c0, (8 * (I + 1)) & 63) : __shfl(c1, (8 * I - 1) & 63);
    const float refI = dir ? (I < 7 ? rsrc : 0.f) : (I > 0 ? rsrc : 0.f);
    loc0 = c0 - refI; loc1 = c1 - refI;
    av[2 * lane] = __expf(loc0); av[2 * lane + 1] = __expf(loc1);
    {
        const int I2 = lane >> 3, J2 = lane & 7;
        const float ra = dir ? __shfl(c0, (8 * (I2 + 1)) & 63) : __shfl(c1, (8 * I2 - 1) & 63), rb = dir ? __shfl(c0, (8 * (J2 + 1)) & 63) : __shfl(c1, (8 * J2 - 1) & 63);
        const float rI = dir ? (I2 < 7 ? ra : 0.f) : (I2 > 0 ? ra : 0.f), rJ = dir ? (J2 < 7 ? rb : 0.f) : (J2 > 0 ? rb : 0.f);
        VV[lane] = __expf(fminf(rI - rJ, 0.f));
        if (J2 == 0) WW[I2] = __expf(rI);
    }
}
__device__ __forceinline__ void ssdE_unit(Ctx& C0_, int l, int u) { UNIT_PROLOG();
    const int g = u & 1, c = (u >> 1) & 63, b = u >> 7;
    const int tid = C.tid, lane = C.lane, w = C.wave, r = lane & 15, q = lane >> 4;
    const size_t tok0 = (size_t)b * SEQ + c * 128;
    LAS unsigned char* Cimg = C.lds; LAS unsigned char* Bimg = C.lds + 34816; LAS unsigned char* Ximg = C.lds + 34816; LAS unsigned char* S0 = C.lds + 69632;
    LAS float* av = (LAS float*)(C.lds + 104448); LAS float* bv = (LAS float*)(C.lds + 112640);
    LAS float* VV = (LAS float*)(C.lds + 120832); LAS float* WW = (LAS float*)(C.lds + 124928);
    const bf16* XC = (const bf16*)(C.ws + B_XBCC);
    TileRegs<128, 128> tB, tC; tile_gload(tB, XC + tok0 * 1536 + 1024 + g * 128, 1536, tid); tile_gload(tC, XC + tok0 * 1536 + 1280 + g * 128, 1536, tid);
    {
        const int h = g * 8 + w; const float* Gt = (const float*)(C.ws + WS_GATES);
#pragma unroll
        for (int dir = 0; dir < 2; ++dir) {
            const float dtb = ((const LAS float*)(C.lds + PAR_OFF))[512 + dir * 16 + h], Aneg = ((const LAS float*)(C.lds + PAR_OFF))[544 + dir * 16 + h];
            const float d0 = softplusf_(Gt[(tok0 + 2 * lane) * NGATE + dir * 16 + h] + dtb), d1 = softplusf_(Gt[(tok0 + 2 * lane + 1) * NGATE + dir * 16 + h] + dtb);
            const float a0 = d0 * Aneg, a1 = d1 * Aneg; float i0, i1, tot; scan128(a0, a1, lane, i0, i1, tot);
            const float c0 = dir ? tot - i0 + a0 : i0, c1 = dir ? tot - i1 + a1 : i1;
            const int hd = w * 2 + dir; float l0, l1;
            decay_tables(c0, c1, dir, lane, av + hd * 128, VV + hd * 64, WW + hd * 8, l0, l1);
            bv[hd * 128 + 2 * lane] = __expf(fminf(-l0, 80.f)) * d0; bv[hd * 128 + 2 * lane + 1] = __expf(fminf(-l1, 80.f)) * d1;
        }
    }
    tile_sstore<128, 128, 272>(tB, Bimg, tid); tile_sstore<128, 128, 272>(tC, Cimg, tid);
    __syncthreads();
    const bf16* STS = (const bf16*)(C.ws + B_STS);
    TileRegs<128, 64> tX; TileRegs<64, 128> tS0, tS1;
    tile_gload(tX, XC + tok0 * 1536 + (g * 8) * 64, 1536, tid);
    tile_gload(tS0, STS + (size_t)(((b * 64 + c) * 2 + 0) * 16 + g * 8) * 8192, 128, tid); tile_gload(tS1, STS + (size_t)(((b * 64 + c) * 2 + 1) * 16 + g * 8) * 8192, 128, tid);
    f32x4 cbT[8]; bf16x8 cfr[4];
#pragma unroll
    for (int ks = 0; ks < 4; ++ks) cfr[ks] = frag_row(Cimg, 272, 16 * w + r, 32 * ks + 8 * q);
#pragma unroll
    for (int st = 0; st < 8; ++st) { cbT[st] = (f32x4){0.f, 0.f, 0.f, 0.f};
#pragma unroll
        for (int ks = 0; ks < 4; ++ks) cbT[st] = MFMA16(frag_row(Bimg, 272, 16 * st + r, 32 * ks + 8 * q), cfr[ks], cbT[st]); }
    __syncthreads();
    const unsigned ximg = lds_addr(Ximg);
    const int lrow = 16 * w + r; const size_t tok = tok0 + lrow;
    bf16* MIX = (bf16*)(C.ws + B_MIX); const bf16* Z = (const bf16*)(C.ws + B_Z);
    float ssq = 0.f;
#pragma unroll 1
    for (int hh = 0; hh < 8; ++hh) {
        const int h = g * 8 + hh;
        tile_sstore<128, 64, 144>(tX, Ximg, tid); tile_sstore<64, 128, 272>(tS0, S0, tid); tile_sstore<64, 128, 272>(tS1, S0 + 17408, tid);
        if (hh < 7) {
            tile_gload(tX, XC + tok0 * 1536 + (h + 1) * 64, 1536, tid);
            tile_gload(tS0, STS + (size_t)(((b * 64 + c) * 2 + 0) * 16 + h + 1) * 8192, 128, tid); tile_gload(tS1, STS + (size_t)(((b * 64 + c) * 2 + 1) * 16 + h + 1) * 8192, 128, tid);
        }
        u32x2 zw4[4];
#pragma unroll
        for (int pt = 0; pt < 4; ++pt) zw4[pt] = *(const u32x2*)(Z + tok * 1024 + h * 64 + 16 * pt + 4 * q);
        const float dk = ((const LAS float*)(C.lds + PAR_OFF))[576 + h];
        __syncthreads();
        f32x4 y[4];
#pragma unroll
        for (int pt = 0; pt < 4; ++pt) y[pt] = (f32x4){0.f, 0.f, 0.f, 0.f};
        const float al0 = av[(hh * 2 + 0) * 128 + lrow], al1 = av[(hh * 2 + 1) * 128 + lrow];
#pragma unroll
        for (int ks = 0; ks < 4; ++ks) {
            bf16x8 xf[4]; frag_tr4<true, 144>(ximg, 32 * ks, 0, r, q, xf);
#pragma unroll
            for (int dir = 0; dir < 2; ++dir) {
                const bool active = dir ? (32 * ks + 31 >= 16 * w) : (32 * ks <= 16 * w + 15);
                if (active) {
                    const int hd = hh * 2 + dir;
                    const f32x4 ba = *(const LAS f32x4*)(bv + hd * 128 + 32 * ks + 4 * q), bb = *(const LAS f32x4*)(bv + hd * 128 + 32 * ks + 16 + 4 * q);
                    const float al = dir ? al1 : al0; const float va = al * VV[hd * 64 + w * 8 + 2 * ks], vb = al * VV[hd * 64 + w * 8 + 2 * ks + 1];
                    float m[8];
#pragma unroll
                    for (int j = 0; j < 8; ++j) {
                        const int s2 = 32 * ks + 16 * (j >> 2) + 4 * q + (j & 3);
                        const bool keep = dir ? (s2 >= lrow) : (s2 <= lrow);
                        m[j] = keep ? cbT[2 * ks + (j >> 2)][j & 3] * ((j < 4) ? va * ba[j & 3] : vb * bb[j & 3]) : 0.f;
                    }
                    const bf16x8 mf = pack8(m);
#pragma unroll
                    for (int pt = 0; pt < 4; ++pt) y[pt] = MFMA16(xf[pt], mf, y[pt]);
                }
            }
        }
#pragma unroll
        for (int dir = 0; dir < 2; ++dir) {
            f32x4 yo[4];
#pragma unroll
            for (int pt = 0; pt < 4; ++pt) yo[pt] = (f32x4){0.f, 0.f, 0.f, 0.f};
#pragma unroll
            for (int ks = 0; ks < 4; ++ks)
#pragma unroll
                for (int pt = 0; pt < 4; ++pt) yo[pt] = MFMA16(frag_row(S0 + dir * 17408, 272, 16 * pt + r, 32 * ks + 8 * q), cfr[ks], yo[pt]);
            const float e = (dir ? al1 : al0) * WW[(hh * 2 + dir) * 8 + w];
#pragma unroll
            for (int pt = 0; pt < 4; ++pt) y[pt] += yo[pt] * e;
        }
#pragma unroll
        for (int pt = 0; pt < 4; ++pt) {
            const u32x2 xw = *(const LAS u32x2*)(Ximg + lrow * 144 + (16 * pt + 4 * q) * 2);
            const u32x2 zw = zw4[pt];
            f32x4 v;
            v[0] = (y[pt][0] + bflo(xw.x) * dk) * siluf_(bflo(zw.x)); v[1] = (y[pt][1] + bfhi(xw.x) * dk) * siluf_(bfhi(zw.x));
            v[2] = (y[pt][2] + bflo(xw.y) * dk) * siluf_(bflo(zw.y)); v[3] = (y[pt][3] + bfhi(xw.y) * dk) * siluf_(bfhi(zw.y));
            ssq += (v[0] * v[0] + v[1] * v[1]) + (v[2] * v[2] + v[3] * v[3]);
            *(u32x2*)(MIX + tok * 2048 + h * 64 + 16 * pt + 4 * q) = pack4(v);
        }
        __syncthreads();
    }
    ssq += __shfl_xor(ssq, 16); ssq += __shfl_xor(ssq, 32);
    const float rs = 1.0f / sqrtf(ssq * (1.f / 512.f) + RMS_EPS);
    const float* nw = C.in[9] + l * 1024 + g * 512;
#pragma unroll 1
    for (int i0 = 0; i0 < 32; i0 += 16) {
        u32x2 vw[16]; f32x4 nv[16];
#pragma unroll
        for (int i = 0; i < 16; ++i) { vw[i] = *(const u32x2*)(MIX + tok * 2048 + g * 512 + (i0 + i) * 16 + 4 * q); nv[i] = *(const f32x4*)(nw + (i0 + i) * 16 + 4 * q); }
#pragma unroll
        for (int i = 0; i < 16; ++i) {
            f32x4 v; v[0] = bflo(vw[i].x) * rs * nv[i][0]; v[1] = bfhi(vw[i].x) * rs * nv[i][1]; v[2] = bflo(vw[i].y) * rs * nv[i][2]; v[3] = bfhi(vw[i].y) * rs * nv[i][3];
            *(u32x2*)(MIX + tok * 2048 + g * 512 + (i0 + i) * 16 + 4 * q) = pack4(v);
        }
    }
}
__device__ __forceinline__ void mlE_unit(Ctx& C0_, int l, int u) { UNIT_PROLOG();
    const int hd = u & 3, c = (u >> 2) & 63, b = u >> 8;
    const int tid = C.tid, lane = C.lane, w = C.wave, r = lane & 15, q = lane >> 4;
    const size_t tok0 = (size_t)b * SEQ + c * 128;
    LAS unsigned char* Qimg = C.lds; LAS unsigned char* Kimg = C.lds + 34816; LAS unsigned char* Vimg = C.lds + 69632;
    LAS float* cum = (LAS float*)(C.lds + 104448); LAS float* liv = (LAS float*)(C.lds + 105472); LAS float* nent = (LAS float*)(C.lds + 106496);
    const size_t sb0 = (size_t)(((b * 64 + c) * 2 + 0) * 4 + hd), sb1 = (size_t)(((b * 64 + c) * 2 + 1) * 4 + hd);
    TileRegs<128, 128> tS0, tS1;
    { TileRegs<128, 128> tQ, tK, tV;
      tile_gload(tQ, (const bf16*)(C.ws + B_MQKC) + tok0 * 1024 + hd * 128, 1024, tid); tile_gload(tK, (const bf16*)(C.ws + B_MQKC) + tok0 * 1024 + 512 + hd * 128, 1024, tid);
      tile_gload(tV, (const bf16*)(C.ws + B_MV) + tok0 * 512 + hd * 128, 512, tid);
      tile_gload(tS0, (const bf16*)(C.ws + B_STM) + sb0 * 16384, 128, tid); tile_gload(tS1, (const bf16*)(C.ws + B_STM) + sb1 * 16384, 128, tid);
      float gf0 = 0.f, gf1 = 0.f, gi0 = 0.f, gi1 = 0.f;
      if (w < 2) { const float* Gt = (const float*)(C.ws + WS_GATES);
          gf0 = Gt[(tok0 + 2 * lane) * NGATE + 40 + w * 4 + hd]; gf1 = Gt[(tok0 + 2 * lane + 1) * NGATE + 40 + w * 4 + hd]; gi0 = Gt[(tok0 + 2 * lane) * NGATE + 32 + w * 4 + hd]; gi1 = Gt[(tok0 + 2 * lane + 1) * NGATE + 32 + w * 4 + hd]; }
      tile_sstore<128, 128, 272>(tQ, Qimg, tid); tile_sstore<128, 128, 272>(tK, Kimg, tid); tile_sstore<128, 128, 272>(tV, Vimg, tid);
      if (w < 2) {
        const int dir = w; const float igb = ((const LAS float*)(C.lds + PAR_OFF))[592 + dir * 4 + hd], fgb = ((const LAS float*)(C.lds + PAR_OFF))[600 + dir * 4 + hd];
        const float f0 = -softplusf_(-(gf0 + fgb)), f1 = -softplusf_(-(gf1 + fgb));
        float i0, i1, tot; scan128(f0, f1, lane, i0, i1, tot);
        cum[dir * 128 + 2 * lane] = dir ? tot - i0 + f0 : i0; cum[dir * 128 + 2 * lane + 1] = dir ? tot - i1 + f1 : i1;
        liv[dir * 128 + 2 * lane] = gi0 + igb; liv[dir * 128 + 2 * lane + 1] = gi1 + igb;
      } }
    __syncthreads();
    const float SC = 0.08838834764831845f;
    f32x4 sT[8]; bf16x8 qfr[4];
#pragma unroll
    for (int ks = 0; ks < 4; ++ks) qfr[ks] = frag_row(Qimg, 272, 16 * w + r, 32 * ks + 8 * q);
#pragma unroll
    for (int st = 0; st < 8; ++st) { sT[st] = (f32x4){0.f, 0.f, 0.f, 0.f};
#pragma unroll
        for (int ks = 0; ks < 4; ++ks) sT[st] = MFMA16(frag_row(Kimg, 272, 16 * st + r, 32 * ks + 8 * q), qfr[ks], sT[st]);
        sT[st] *= SC; }
    __syncthreads();
    const unsigned vimg = lds_addr(Vimg);
    const int lrow = 16 * w + r; const size_t tok = tok0 + lrow;
    {
        tile_sstore<128, 128, 272>(tS0, Kimg, tid); tile_sstore<128, 128, 272>(tS1, Qimg, tid);
        if (tid < 256) nent[tid] = ((const float*)(C.ws + B_NM))[(tid < 128 ? sb0 : sb1) * 128 + (tid & 127)];
    }
    __syncthreads();
    const float cl0 = cum[lrow], cl1 = cum[128 + lrow];
    u32x2 ow8[8];
    { const bf16* MOp = (const bf16*)(C.ws + B_MO) + tok * 512 + hd * 128;
#pragma unroll
      for (int vt = 0; vt < 8; ++vt) ow8[vt] = *(const u32x2*)(MOp + 16 * vt + 4 * q); }
    f32x4 num[2][8]; float denp0 = 0.f, denp1 = 0.f;
#pragma unroll
    for (int d = 0; d < 2; ++d)
#pragma unroll
        for (int vt = 0; vt < 8; ++vt) num[d][vt] = (f32x4){0.f, 0.f, 0.f, 0.f};
#pragma unroll
    for (int ks = 0; ks < 4; ++ks) {
        const bool act0 = (32 * ks <= 16 * w + 15), act1 = (32 * ks + 31 >= 16 * w);
        bf16x8 mf0, mf1;
#pragma unroll
        for (int dir = 0; dir < 2; ++dir) {
            float m[8]; float ds = 0.f;
            if (dir ? act1 : act0) {
                const LAS float* cm = cum + dir * 128; const LAS float* lv = liv + dir * 128; const float cl = dir ? cl1 : cl0;
                const f32x4 ca = *(const LAS f32x4*)(cm + 32 * ks + 4 * q), cb = *(const LAS f32x4*)(cm + 32 * ks + 16 + 4 * q);
                const f32x4 la = *(const LAS f32x4*)(lv + 32 * ks + 4 * q), lb = *(const LAS f32x4*)(lv + 32 * ks + 16 + 4 * q);
#pragma unroll
                for (int j = 0; j < 8; ++j) {
                    const int s2 = 32 * ks + 16 * (j >> 2) + 4 * q + (j & 3);
                    const float cs = (j < 4) ? ca[j & 3] : cb[j & 3], ls = (j < 4) ? la[j & 3] : lb[j & 3];
                    const bool keep = dir ? (s2 >= lrow) : (s2 <= lrow);
                    m[j] = keep ? sT[2 * ks + (j >> 2)][j & 3] * __expf(cl - cs + ls) : 0.f; ds += m[j];
                }
            } else {
#pragma unroll
                for (int j = 0; j < 8; ++j) m[j] = 0.f;
            }
            if (dir) { denp1 += ds; mf1 = pack8(m); } else { denp0 += ds; mf0 = pack8(m); }
        }
#pragma unroll
        for (int half = 0; half < 2; ++half) {
            bf16x8 vf[4]; frag_tr4<true, 272>(vimg, 32 * ks, 64 * half, r, q, vf);
            if (act0) {
#pragma unroll
                for (int vt = 0; vt < 4; ++vt) num[0][4 * half + vt] = MFMA16(vf[vt], mf0, num[0][4 * half + vt]);
            }
            if (act1) {
#pragma unroll
                for (int vt = 0; vt < 4; ++vt) num[1][4 * half + vt] = MFMA16(vf[vt], mf1, num[1][4 * half + vt]);
            }
        }
        asm volatile("" ::: "memory");
    }
    float inv0 = 0.f, inv1 = 0.f;
#pragma unroll
    for (int dir = 0; dir < 2; ++dir) {
        const LAS unsigned char* Simg = dir ? Qimg : Kimg; const float e = __expf(dir ? cl1 : cl0) * SC;
        float qn = 0.f;
#pragma unroll
        for (int ks = 0; ks < 4; ++ks) {
            asm volatile("" ::: "memory");
            float qv[8]; unpack8(qfr[ks], qv);
            const f32x4 n0 = *(const LAS f32x4*)(nent + dir * 128 + 32 * ks + 8 * q), n1 = *(const LAS f32x4*)(nent + dir * 128 + 32 * ks + 8 * q + 4);
            qn += (qv[0] * n0.x + qv[1] * n0.y + qv[2] * n0.z + qv[3] * n0.w) + (qv[4] * n1.x + qv[5] * n1.y + qv[6] * n1.z + qv[7] * n1.w);
#pragma unroll
            for (int j = 0; j < 8; ++j) qv[j] *= e;
            const bf16x8 qe = pack8(qv);
#pragma unroll
            for (int vt = 0; vt < 8; ++vt) num[dir][vt] = MFMA16(frag_row(Simg, 272, 16 * vt + r, 32 * ks + 8 * q), qe, num[dir][vt]);
        }
        float denp = dir ? denp1 : denp0;
        denp += __shfl_xor(denp, 16); denp += __shfl_xor(denp, 32); qn += __shfl_xor(qn, 16); qn += __shfl_xor(qn, 32);
        const float den = denp + e * qn; const float inv = 1.0f / fmaxf(fabsf(den), 1.0f);
        if (dir) inv1 = inv; else inv0 = inv;
    }
    f32x4 hs[8];
#pragma unroll
    for (int vt = 0; vt < 8; ++vt) hs[vt] = num[0][vt] * inv0 + num[1][vt] * inv1;
    float s1 = 0.f;
#pragma unroll
    for (int vt = 0; vt < 8; ++vt) s1 += (hs[vt][0] + hs[vt][1]) + (hs[vt][2] + hs[vt][3]);
    s1 += __shfl_xor(s1, 16); s1 += __shfl_xor(s1, 32);
    const float mean = s1 * (1.f / 128.f); float s2 = 0.f;
#pragma unroll
    for (int vt = 0; vt < 8; ++vt) { hs[vt] -= mean; s2 += (hs[vt][0] * hs[vt][0] + hs[vt][1] * hs[vt][1]) + (hs[vt][2] * hs[vt][2] + hs[vt][3] * hs[vt][3]); }
    s2 += __shfl_xor(s2, 16); s2 += __shfl_xor(s2, 32);
    const float rs = 1.0f / sqrtf(s2 * (1.f / 128.f) + LN_EPS);
    const float* nw = C.in[16] + l * 512 + hd * 128; bf16* MIX = (bf16*)(C.ws + B_MIX) + tok * 2048 + 1536 + hd * 128;
#pragma unroll
    for (int vt = 0; vt < 8; ++vt) {
        const int v0 = 16 * vt + 4 * q; const f32x4 nv = *(const f32x4*)(nw + v0); const u32x2 ow = ow8[vt];
        f32x4 o; o[0] = hs[vt][0] * rs * nv[0] * sigmoidf_(bflo(ow.x)); o[1] = hs[vt][1] * rs * nv[1] * sigmoidf_(bfhi(ow.x)); o[2] = hs[vt][2] * rs * nv[2] * sigmoidf_(bflo(ow.y)); o[3] = hs[vt][3] * rs * nv[3] * sigmoidf_(bfhi(ow.y));
        *(u32x2*)(MIX + v0) = pack4(o);
    }
    __syncthreads();
}
__device__ __forceinline__ void hg_gates_e(Ctx& C, int l, int hd, int dir, const LAS unsigned char* Qimg, LAS unsigned char* QLimg, LAS unsigned char* Kimg, LAS float* segtot, LAS float* VV) {
    const int k = C.tid & 127, seg = C.tid >> 7;
    const float oml = ((const LAS float*)(C.lds + PAR_OFF))[hd * 128 + k];
    __syncthreads();
    float run = 1.f;
#pragma unroll
    for (int i = 0; i < 16; ++i) {
        const int t = dir ? (seg * 16 + 15 - i) : (seg * 16 + i);
        const float key = oml * sigmoidf_(-bf2f(*(const LAS bf16*)(Kimg + t * 272 + k * 2)));
        run *= 1.0f - key;
        const float qv = bf2f(*(const LAS bf16*)(Qimg + t * 272 + k * 2));
        *(LAS bf16*)(Kimg + t * 272 + k * 2) = (bf16)f2bf(key * __builtin_amdgcn_rcpf(fmaxf(run, 1e-30f)));
        *(LAS bf16*)(QLimg + t * 272 + k * 2) = (bf16)f2bf(qv * run);
    }
    segtot[seg * 128 + k] = run;
    __syncthreads();
    {
        float acc = 1.f;
        if (dir == 0) { for (int J = seg - 1; J >= 0; --J) { acc *= segtot[J * 128 + k]; VV[(seg * 4 + J) * 128 + k] = acc; } }
        else { for (int J = seg + 1; J < 4; ++J) { acc *= segtot[J * 128 + k]; VV[(seg * 4 + J) * 128 + k] = acc; } }
        VV[(seg * 4 + seg) * 128 + k] = acc;
    }
    __syncthreads();
}
__device__ __forceinline__ void hgE_seq(Ctx& C0_, int l, int u0, int nu, int ustride) { UNIT_PROLOG();
    const int tid = C.tid, lane = C.lane, w = C.wave, r = lane & 15, q = lane >> 4, I = w & 3, vh = w >> 2;
    LAS unsigned char* Qimg = C.lds; LAS unsigned char* Vimg = C.lds + 17408; LAS unsigned char* QLimg = C.lds + 34816; LAS unsigned char* Kimg = C.lds + 52224; LAS unsigned char* Simg = C.lds + 69632;
    LAS float* segtot = (LAS float*)(C.lds + 104448); LAS float* VV = (LAS float*)(C.lds + 106496); LAS float* xch = (LAS float*)(C.lds + 114688);
    const unsigned vimg = lds_addr(Vimg);
    const int lrow = 16 * I + r;
    TileRegs<64, 128> tQ, tV, tF0, tF1; TileRegs<128, 128> tS0, tS1;
#define HGE_ISSUE(uu) do { const int hd_ = (uu) & 3, c_ = ((uu) >> 2) & 127, b_ = (uu) >> 9; const size_t tk_ = (size_t)b_ * SEQ + c_ * 64; \
        tile_gload(tQ, (const bf16*)(C.ws + B_HQ) + tk_ * 512 + hd_ * 128, 512, tid); tile_gload(tV, (const bf16*)(C.ws + B_HI) + tk_ * 512 + hd_ * 128, 512, tid); \
        tile_gload(tF0, (const bf16*)(C.ws + B_HFR) + tk_ * 1024 + hd_ * 128, 1024, tid); tile_gload(tF1, (const bf16*)(C.ws + B_HFR) + tk_ * 1024 + 512 + hd_ * 128, 1024, tid); \
        tile_gload(tS0, (const bf16*)(C.ws + B_STH) + (size_t)(((b_ * 128 + c_) * 2 + 0) * 4 + hd_) * 16384, 128, tid); tile_gload(tS1, (const bf16*)(C.ws + B_STH) + (size_t)(((b_ * 128 + c_) * 2 + 1) * 4 + hd_) * 16384, 128, tid); } while (0)
    HGE_ISSUE(u0);
#pragma unroll 1
    for (int iu = 0; iu < nu; ++iu) {
        const int u = u0 + iu * ustride;
        const int hd = u & 3, c = (u >> 2) & 127, b = u >> 9;
        const size_t tok0 = (size_t)b * SEQ + c * 64; const size_t tok = tok0 + lrow;
#pragma unroll
        for (int i = 0; i < 2; ++i) { const u32x4 x = tQ.v[i];
            tQ.v[i].x = pk2(siluf_(bflo(x.x)), siluf_(bfhi(x.x))); tQ.v[i].y = pk2(siluf_(bflo(x.y)), siluf_(bfhi(x.y))); tQ.v[i].z = pk2(siluf_(bflo(x.z)), siluf_(bfhi(x.z))); tQ.v[i].w = pk2(siluf_(bflo(x.w)), siluf_(bfhi(x.w))); }
        tile_sstore<64, 128, 272>(tQ, Qimg, tid); tile_sstore<64, 128, 272>(tV, Vimg, tid);
        f32x4 o[4];
#pragma unroll
        for (int vt = 0; vt < 4; ++vt) o[vt] = (f32x4){0.f, 0.f, 0.f, 0.f};
        u32x2 gw4[4];
        { const bf16* HGp = (const bf16*)(C.ws + B_HG) + tok * 512 + hd * 128;
#pragma unroll
          for (int vt = 0; vt < 4; ++vt) gw4[vt] = *(const u32x2*)(HGp + 64 * vh + 16 * vt + 4 * q); }
#pragma unroll
        for (int dir = 0; dir < 2; ++dir) {
            tile_sstore<64, 128, 272>(dir ? tF1 : tF0, Kimg, tid); tile_sstore<128, 128, 272>(dir ? tS1 : tS0, Simg, tid);
            if (dir == 1 && iu + 1 < nu) HGE_ISSUE(u + ustride);
            hg_gates_e(C, l, hd, dir, Qimg, QLimg, Kimg, segtot, VV);
            bf16x8 qd[4];
#pragma unroll
            for (int ks = 0; ks < 4; ++ks) qd[ks] = frag_row(QLimg, 272, lrow, 32 * ks + 8 * q);
            f32x4 att[4];
#pragma unroll
            for (int J = 0; J < 4; ++J) {
                att[J] = (f32x4){0.f, 0.f, 0.f, 0.f};
                const bool inr = dir ? (J >= I) : (J <= I);
                if (inr) {
#pragma unroll
                    for (int ks = 0; ks < 4; ++ks) {
                        const int k0 = 32 * ks + 8 * q;
                        bf16x8 qf = qd[ks];
                        if (J != I) { float qv[8]; unpack8(qd[ks], qv);
                            const f32x4 v0 = *(const LAS f32x4*)(VV + (I * 4 + J) * 128 + k0), v1 = *(const LAS f32x4*)(VV + (I * 4 + J) * 128 + k0 + 4);
                            qv[0] *= v0.x; qv[1] *= v0.y; qv[2] *= v0.z; qv[3] *= v0.w; qv[4] *= v1.x; qv[5] *= v1.y; qv[6] *= v1.z; qv[7] *= v1.w; qf = pack8(qv); }
                        att[J] = MFMA16(frag_row(Kimg, 272, 16 * J + r, k0), qf, att[J]);
                    }
                    if (J == I) {
#pragma unroll
                        for (int i = 0; i < 4; ++i) { const bool keep = dir ? (4 * q + i >= r) : (4 * q + i <= r); att[J][i] = keep ? att[J][i] : 0.f; }
                    }
                }
            }
#pragma unroll
            for (int k2 = 0; k2 < 2; ++k2) {
                float m[8] = {att[2 * k2][0], att[2 * k2][1], att[2 * k2][2], att[2 * k2][3], att[2 * k2 + 1][0], att[2 * k2 + 1][1], att[2 * k2 + 1][2], att[2 * k2 + 1][3]};
                const bf16x8 mf = pack8(m);
                bf16x8 vf4[4]; frag_tr4<true, 272>(vimg, 32 * k2, 64 * vh, r, q, vf4);
#pragma unroll
                for (int vt = 0; vt < 4; ++vt) o[vt] = MFMA16(vf4[vt], mf, o[vt]);
            }
#pragma unroll
            for (int ks = 0; ks < 4; ++ks) {
                const int k0 = 32 * ks + 8 * q;
                float qv[8]; unpack8(qd[ks], qv);
                const f32x4 v0 = *(const LAS f32x4*)(VV + (I * 4 + I) * 128 + k0), v1 = *(const LAS f32x4*)(VV + (I * 4 + I) * 128 + k0 + 4);
                qv[0] *= v0.x; qv[1] *= v0.y; qv[2] *= v0.z; qv[3] *= v0.w; qv[4] *= v1.x; qv[5] *= v1.y; qv[6] *= v1.z; qv[7] *= v1.w;
                const bf16x8 qh = pack8(qv);
#pragma unroll
                for (int vt = 0; vt < 4; ++vt) o[vt] = MFMA16(frag_row(Simg, 272, 64 * vh + 16 * vt + r, k0), qh, o[vt]);
            }
            __syncthreads();
        }
        float ss = 0.f;
#pragma unroll
        for (int vt = 0; vt < 4; ++vt) ss += (o[vt][0] * o[vt][0] + o[vt][1] * o[vt][1]) + (o[vt][2] * o[vt][2] + o[vt][3] * o[vt][3]);
        ss += __shfl_xor(ss, 16); ss += __shfl_xor(ss, 32);
        if (q == 0) xch[vh * 64 + lrow] = ss;
        __syncthreads();
        const float rs = 1.0f / sqrtf((xch[lrow] + xch[64 + lrow]) * (1.f / 128.f) + RMS_EPS);
        const float* nw = C.in[11] + l * 512 + hd * 128; bf16* MIX = (bf16*)(C.ws + B_MIX) + tok * 2048 + 1024 + hd * 128;
#pragma unroll
        for (int vt = 0; vt < 4; ++vt) {
            const int v0 = 64 * vh + 16 * vt + 4 * q; const f32x4 nv = *(const f32x4*)(nw + v0); const u32x2 gw = gw4[vt];
            f32x4 v; v[0] = o[vt][0] * rs * nv[0] * siluf_(bflo(gw.x)); v[1] = o[vt][1] * rs * nv[1] * siluf_(bfhi(gw.x)); v[2] = o[vt][2] * rs * nv[2] * siluf_(bflo(gw.y)); v[3] = o[vt][3] * rs * nv[3] * siluf_(bfhi(gw.y));
            *(u32x2*)(MIX + v0) = pack4(v);
        }
        __syncthreads();
    }
#undef HGE_ISSUE
}
__device__ __forceinline__ void mixE_phase(Ctx& C, int l) {
    int f, n;
    const int rot = (C.blk >> 3) % 3;
    mix_params(C, l);
#pragma unroll 1
    for (int k3 = 0; k3 < 3; ++k3) {
        int ty = k3 + rot; if (ty >= 3) ty -= 3;
        if (ty == 0) { if (FAST_SSD) { deal_range(C.blk, C.G, 0, 256, f, n); for (int i = 0; i < n; ++i) ssdE_unit(C, l, f + i * C.G); } }
        else if (ty == 1) { if (FAST_ML) { deal_range(C.blk, C.G, 256, 768, f, n); for (int i = 0; i < n; ++i) mlE_unit(C, l, f + i * C.G); } }
        else { if (FAST_HG) { deal_range(C.blk, C.G, 768, 1792, f, n); if (n) hgE_seq(C, l, f, n, C.G); } }
    }
}

constexpr int PH_PER_LAYER = 11, NPHASES = 1 + DEPTH * PH_PER_LAYER;
__global__ void __launch_bounds__(NTHR, 2) fwd_kernel(Args args) {
    extern __shared__ __attribute__((aligned(16))) unsigned char lds_raw[];
    Ctx C;
    C.lds = (LAS unsigned char*)lds_raw; C.misc = (volatile LAS unsigned*)(C.lds + MISC_OFF);
    C.ws = args.ws; C.in.lds = C.lds; C.out = args.out;
    C.tid = threadIdx.x; C.lane = C.tid & 63; C.wave = __builtin_amdgcn_readfirstlane(C.tid >> 6); C.G = gridDim.x; C.blk = blockIdx.x;
    if (C.tid < 64) C.misc[C.tid] = 0u;
    if (C.tid < 31) { const unsigned long long p = C.tid < 29 ? (unsigned long long)args.in[C.tid] : (C.tid == 29 ? (unsigned long long)args.out : (unsigned long long)args.ws);
        *(LAS u32x2*)(C.lds + PTAB_OFF + 8 * C.tid) = (u32x2){(unsigned)p, (unsigned)(p >> 32)}; }
    __syncthreads();
    const int lo = args.ph_lo, hi = args.ph_hi;
#if MK_ONE_LAUNCH
    XcdBarrier bar = xcd_barrier_post((unsigned*)(C.ws + WS_CTL) + CW_BAR, C.misc + 32);
#define GRID_BAR() do { XcdBarrier b2_ = bar; b2_.bar = (unsigned*)C.in[30] + CW_BAR; asm volatile("" : "+s"(b2_.x)); xcd_barrier(b2_); } while (0)
#else
#define GRID_BAR() do { } while (0)
#endif
#define IN(k) (lo <= (k) && (k) < hi)
#if PROFILE_A || PROFILE_B
#define STAMP(i) do { int l2_; asm volatile("v_mbcnt_lo_u32_b32 %0, -1, 0\n\tv_mbcnt_hi_u32_b32 %0, -1, %0" : "=v"(l2_)); if (l2_ == 0 && C.wave == 0) ((volatile LAS unsigned long long*)(C.lds + TS_OFF))[i] = __builtin_amdgcn_s_memrealtime(); } while (0)
#define SEAM(k) do { GRID_BAR(); STAMP((k) + 1); } while (0)
#else
#define STAMP(i) do { } while (0)
#define SEAM(k) do { if (IN((k) + 1)) GRID_BAR(); } while (0)
#endif
#define LAUNDER() do { __syncthreads(); C.out = (float*)C.in[29]; C.ws = (unsigned char*)C.in[30]; int ln_; asm volatile("v_mbcnt_lo_u32_b32 %0, -1, 0\n\tv_mbcnt_hi_u32_b32 %0, -1, %0" : "=v"(ln_)); C.lane = ln_; C.tid = C.wave * 64 + ln_; asm volatile("" : "+s"(C.blk), "+s"(C.G)); } while (0)

    STAMP(0);
    if (IN(0)) { LAUNDER();
        ln_phase<0, 1>(C, C.in[0], C.in[1], C.in[2], nullptr, 0);
        __syncthreads();
        wconv_layer(C, 0);
        SEAM(0);
    }
    for (int l = 0; l < DEPTH; ++l) {
        const int pb = 1 + l * PH_PER_LAYER; const bool moe = (l & 1) != 0; const int lm = l >> 1;
        const int dff = moe ? DFF_E : DFF_D;
        if (IN(pb + 0)) { LAUNDER();
            pg8::GOrder S; S.init(C.ws + WS_HBF, C.ws + WS_WIN, D, T / 256, NMAIN / 256, C.G, C.blk, 0, nullptr);
            pg8::EpiProj E{C.ws};
            pg8::gemm_phase<pg8::EpiProj, pg8::GOrder>(C.lds, D, D, S, E, C.tid);
            SEAM(pb + 0);
        }
        if (IN(pb + 1)) { LAUNDER(); conv_phase(C, l); SEAM(pb + 1); }
        if (IN(pb + 2)) { LAUNDER(); if (!(FAST_SSD && FAST_HG && FAST_ML)) naive_mixers(C, l); __syncthreads(); mixC_phase(C, l); SEAM(pb + 2); }
        if (IN(pb + 3)) { LAUNDER(); scan_phase(C); SEAM(pb + 3); }
        if (IN(pb + 4)) { LAUNDER(); if (!(FAST_SSD && FAST_HG && FAST_ML)) naive_combine(C, l); __syncthreads(); mixE_phase(C, l); SEAM(pb + 4); }
        if (IN(pb + 5)) { LAUNDER();
            pg8::GOrder S; S.init(C.ws + B_MIX, C.ws + WS_WOUT, DMIX, T / 256, D / 256, C.G, C.blk, 0, nullptr);
            pg8::EpiBf16Res E{(bf16*)(C.ws + B_Y), (const bf16*)(C.ws + WS_HBF), D};
            pg8::gemm_phase<pg8::EpiBf16Res, pg8::GOrder>(C.lds, DMIX, DMIX, S, E, C.tid);
            SEAM(pb + 5);
        }
        if (IN(pb + 6)) { LAUNDER();
            if (moe) ln_phase<1, 2>(C, nullptr, C.in[18] + l * D, C.in[19] + l * D, nullptr, l);
            else ln_phase<1, 0>(C, nullptr, C.in[18] + l * D, C.in[19] + l * D, nullptr, l);
            SEAM(pb + 6);
        }
        if (IN(pb + 7) && (moe || PROFILE_A || PROFILE_B)) { LAUNDER(); if (moe) moe_dispatch(C, lm); SEAM(pb + 7); }
        if (IN(pb + 8)) { LAUNDER();
            __syncthreads();
            const int nblk = moe_cum_table(C, lm, moe);
            pg8::GOrder S; S.init(moe ? C.ws + B_XS : C.ws + WS_HBF, C.ws + WS_W13, D, nblk, 2 * dff / 256, C.G, C.blk, (size_t)2 * dff * D * 2, (const LAS int*)(C.lds + MISC_OFF));
            pg8::EpiSwiglu E{(bf16*)(C.ws + B_HID), dff};
            pg8::gemm_phase<pg8::EpiSwiglu, pg8::GOrder>(C.lds, D, D, S, E, C.tid);
            SEAM(pb + 8);
        }
        if (IN(pb + 9)) { LAUNDER();
            __syncthreads();
            const int nblk = moe_cum_table(C, lm, moe);
            const int nfull = nblk < 128 ? nblk : 128;
            pg8::GOrder S; S.init(C.ws + B_HID, C.ws + WS_W2, dff, nfull, D / 256, C.G, C.blk, (size_t)D * dff * 2, (const LAS int*)(C.lds + MISC_OFF));
            pg8::EpiBf16Res E{moe ? (bf16*)(C.ws + B_YE) : (bf16*)(C.ws + B_Y), moe ? nullptr : (const bf16*)(C.ws + WS_HBF), D};
            pg8::gemm_phase<pg8::EpiBf16Res, pg8::GOrder>(C.lds, dff, dff, S, E, C.tid);
            if (nblk > 128) {
                __syncthreads();
                pg8::TailOrder S2; S2.init(C.ws + B_HID, C.ws + WS_W2, dff, nblk - 128, C.G, C.blk, (size_t)D * dff * 2, (const LAS int*)(C.lds + MISC_OFF));
                pg8::EpiF32 E2{(float*)(C.ws + B_PART), D};
                pg8::gemm_phase<pg8::EpiF32, pg8::TailOrder>(C.lds, 512, dff, S2, E2, C.tid);
            }
            SEAM(pb + 9);
        }
        if (IN(pb + 10)) { LAUNDER();
            float* dst = (l == DEPTH - 1) ? C.out : nullptr;
            const float* g = C.in[20] + l * D; const float* b = C.in[21] + l * D;
            if (l == DEPTH - 1) { if (moe) ln_phase<3, 0>(C, nullptr, g, b, dst, l); else ln_phase<2, 0>(C, nullptr, g, b, dst, l); }
            else { if (moe) ln_phase<3, 1>(C, nullptr, g, b, dst, l + 1); else ln_phase<2, 1>(C, nullptr, g, b, dst, l + 1);
                __syncthreads(); wconv_layer(C, l + 1); }
            SEAM(pb + 10);
        }
    }
#if PROFILE_A || PROFILE_B
    {
        int l3_; asm volatile("v_mbcnt_lo_u32_b32 %0, -1, 0\n\tv_mbcnt_hi_u32_b32 %0, -1, %0" : "=v"(l3_));
        if (l3_ == 0 && C.wave == 0 && __builtin_amdgcn_readfirstlane(C.blk) == 0) {
            volatile LAS unsigned long long* ts = (volatile LAS unsigned long long*)(C.lds + TS_OFF);
            unsigned long long dsum = 0;
            for (int p = 0; p < NPHASES; ++p) { const int cls = (p == 0) ? 0 : 1 + (p - 1) % PH_PER_LAYER; if ((PROFILE_A >> cls) & 1) dsum += ts[p + 1] - ts[p]; }
            const unsigned long long t0 = __builtin_amdgcn_s_memrealtime();
            while (__builtin_amdgcn_s_memrealtime() - t0 < dsum) __builtin_amdgcn_s_sleep(8);
        }
    }
#endif
#undef IN
#undef SEAM
}

extern "C" void kernel_launch(void* const* d_in, const int* in_sizes, int n_in, void* d_out, int out_size, void* d_ws, size_t ws_size, hipStream_t stream) {
    static int grid = 0;
    if (grid == 0) {
        if (n_in != 29 || out_size != T * D || ws_size < WS_END) { fprintf(stderr, "kernel_launch: unexpected shapes (n_in %d out %d ws %zu need %zu)\n", n_in, out_size, ws_size, (size_t)WS_END); grid = -1; return; }
        int dev = 0, cus = 0, per_cu = 0;
        if (hipGetDevice(&dev) != hipSuccess || hipDeviceGetAttribute(&cus, hipDeviceAttributeMultiprocessorCount, dev) != hipSuccess) { grid = -1; return; }
        if (hipFuncSetAttribute((const void*)fwd_kernel, hipFuncAttributeMaxDynamicSharedMemorySize, LDS_BYTES) != hipSuccess) { grid = -1; return; }
        if (hipOccupancyMaxActiveBlocksPerMultiprocessor(&per_cu, (const void*)fwd_kernel, NTHR, LDS_BYTES) != hipSuccess || per_cu < 1) fprintf(stderr, "kernel_launch: occupancy query says %d\n", per_cu);
        (void)hipGetLastError();
        grid = cus;
    }
    if (grid < 0) return;
    (void)hipMemsetAsync((char*)d_ws + WS_CTL, 0, CTL_ZERO_BYTES, stream);
    Args a{};
    for (int i = 0; i < 29; ++i) a.in[i] = (const float*)d_in[i];
    a.out = (float*)d_out; a.ws = (unsigned char*)d_ws;
#if MK_ONE_LAUNCH
    a.ph_lo = 0; a.ph_hi = NPHASES;
    hipLaunchKernelGGL(fwd_kernel, dim3(grid), dim3(NTHR), LDS_BYTES, stream, a);
#else
    for (int p = 0; p < NPHASES; ++p) {
        if (p >= 1) { const int k = (p - 1) % PH_PER_LAYER, l = (p - 1) / PH_PER_LAYER; if (k == 7 && !(l & 1)) continue; }
        a.ph_lo = p; a.ph_hi = p + 1;
        hipLaunchKernelGGL(fwd_kernel, dim3(grid), dim3(NTHR), LDS_BYTES, stream, a);
    }
#endif
}
```

```cpp
#include <hip/hip_runtime.h>
#include <cstdio>
#include <cstdint>

#ifndef PROFILE_A
#define PROFILE_A 0
#define PROFILE_B 0
#endif
#ifndef MK_ONE_LAUNCH
#define MK_ONE_LAUNCH 1
#endif

#ifndef FAST_SSD
#define FAST_SSD 1
#endif
#ifndef FAST_HG
#define FAST_HG 1
#endif
#ifndef FAST_ML
#define FAST_ML 1
#endif

#define LAS __attribute__((address_space(3)))
#define GAS __attribute__((address_space(1)))
typedef unsigned short bf16;
typedef short bf16x8 __attribute__((ext_vector_type(8)));
typedef float f32x4 __attribute__((ext_vector_type(4)));
typedef float f32x2 __attribute__((ext_vector_type(2)));
typedef unsigned u32x4 __attribute__((ext_vector_type(4)));
typedef unsigned u32x2 __attribute__((ext_vector_type(2)));
typedef short s16x4 __attribute__((ext_vector_type(4)));

constexpr int T = 16384, SEQ = 8192, D = 1024, DEPTH = 4, DPROJ = 7216, NMAIN = 7168, DMIX = 2048;
constexpr int DFF_D = 2816, DFF_E = 3584, NEXP = 8, NGATE = 48;
constexpr int NWAVES = 8, NTHR = 512;
constexpr float ALPHA = 1.681792830507429f;
constexpr float LN_EPS = 1e-5f, RMS_EPS = 1e-6f;
constexpr int MOE_ROWS = 34816;

constexpr size_t MiB = 1u << 20;
constexpr size_t WS_CTL = 0, CTL_ZERO_BYTES = 1 * MiB;
constexpr size_t WS_HF32 = 1 * MiB, WS_HBF = 65 * MiB, WS_GATES = 97 * MiB, WS_ROUTE = 100 * MiB;
constexpr size_t WS_WIN = 101 * MiB, WS_WOUT = 115 * MiB, WS_W13 = 119 * MiB, WS_W2 = 231 * MiB, WS_BIG = 287 * MiB;
constexpr size_t B_Z = WS_BIG + 0 * MiB, B_XBCR = WS_BIG + 32 * MiB, B_HQ = WS_BIG + 80 * MiB, B_HFR = WS_BIG + 96 * MiB, B_HI = WS_BIG + 128 * MiB, B_HG = WS_BIG + 144 * MiB;
constexpr size_t B_MQKR = WS_BIG + 160 * MiB, B_MV = WS_BIG + 192 * MiB, B_MO = WS_BIG + 208 * MiB;
constexpr size_t B_XBCC = WS_BIG + 224 * MiB, B_MQKC = WS_BIG + 272 * MiB;
constexpr size_t B_YBUF = WS_BIG + 304 * MiB, B_OBUF = WS_BIG + 368 * MiB, B_HBUF = WS_BIG + 432 * MiB;
constexpr size_t B_MIX = WS_BIG + 464 * MiB;
constexpr size_t B_Y = WS_BIG + 0 * MiB;
constexpr size_t B_XS = WS_BIG + 64 * MiB, B_HID = WS_BIG + 136 * MiB, B_YE = WS_BIG + 376 * MiB;
constexpr size_t B_PART = B_XS;
constexpr size_t B_STS = WS_BIG + 304 * MiB, B_STH = WS_BIG + 368 * MiB, B_STM = WS_BIG + 432 * MiB;
constexpr size_t B_DECS = WS_BIG + 528 * MiB, B_DECM = B_DECS + 65536, B_NM = B_DECS + 131072, B_DECH = B_DECS + 1 * MiB;
constexpr size_t WS_END = WS_BIG + 532 * MiB;
constexpr int CW_TMO = 0, CW_BAR = 4096, CW_CNT = 8192;

#define LDS_WAIT() asm volatile("s_waitcnt lgkmcnt(0)" ::: "memory")
#define VM_WAIT() asm volatile("s_waitcnt vmcnt(0)" ::: "memory")
__device__ __forceinline__ unsigned f2bf(float f) { unsigned u = __builtin_bit_cast(unsigned, f); return (u + 0x7fffu + ((u >> 16) & 1u)) >> 16; }
typedef __bf16 nbf16x2 __attribute__((ext_vector_type(2)));
__device__ __forceinline__ unsigned pk2(float lo, float hi) { const f32x2 v = {lo, hi}; return __builtin_bit_cast(unsigned, __builtin_convertvector(v, nbf16x2)); }
__device__ __forceinline__ float bf2f(unsigned short b) { return __builtin_bit_cast(float, ((unsigned)b) << 16); }
__device__ __forceinline__ float bflo(unsigned w) { return __builtin_bit_cast(float, w << 16); }
__device__ __forceinline__ float bfhi(unsigned w) { return __builtin_bit_cast(float, w & 0xffff0000u); }
__device__ __forceinline__ float sigmoidf_(float x) { return __builtin_amdgcn_rcpf(1.0f + __expf(-x)); }
__device__ __forceinline__ float siluf_(float x) { return x * __builtin_amdgcn_rcpf(1.0f + __expf(-x)); }
__device__ __forceinline__ float softplusf_(float x) { return fmaxf(x, 0.f) + log1pf(__expf(-fabsf(x))); }
__device__ __forceinline__ float wave_sum(float v) {
#pragma unroll
    for (int o = 1; o < 64; o <<= 1) v += __shfl_xor(v, o);
    return v;
}

namespace pg8 {
#define PG8_LAS __attribute__((address_space(3)))
typedef unsigned short bf16_t;
constexpr int BM = 256, BK = 64, HALF = 128, HTB = HALF * BK * 2, STAGE_BYTES = 8 * HTB, NXCD = 8, WGM = 8;
__host__ __device__ __forceinline__ int lds_byte(int r, int c) { const int st = (r >> 4) * 2 + (c >> 5), rr = r & 15, cc = c & 31, ob = rr * 64 + cc * 2; return st * 1024 + (ob ^ (((ob >> 9) & 1) << 5)); }
__host__ __device__ __forceinline__ void stage_rc(int b, int& R, int& C) { const int st = b / 1024, sb = b % 1024, swz = sb ^ (((sb >> 9) & 1) << 5); R = (st >> 1) * 16 + swz / 64; C = (st & 1) * 32 + (swz % 64) / 2; }
__host__ __device__ __forceinline__ int perm32(int rho) { const int n = rho >> 4, i = rho & 15; return 8 * (i >> 2) + 4 * n + (i & 3); }

struct Unit { const char* A; const char* B; int pm, pn; };

struct GOrder {
    const char* A; const char* Bt; int K; int nM, nN, nwg, G, c; size_t bexp; const PG8_LAS int* cum;
    __device__ void init(const void* A_, const void* Bt_, int K_, int nM_, int nN_, int G_, int c_, size_t bexp_, const PG8_LAS int* cum_) { A = (const char*)A_; Bt = (const char*)Bt_; K = K_; nM = nM_; nN = nN_; nwg = nM * nN; G = G_; c = c_; bexp = bexp_; cum = cum_; }
    __device__ bool next(int i, Unit& u) const {
        const long L = (long)i * G + c; if (L >= nwg) return false;
        int wgid = (int)L; { const int q = nwg / NXCD, r = nwg % NXCD, xcd = wgid % NXCD, off = wgid / NXCD; wgid = (xcd < r ? xcd * (q + 1) : r * (q + 1) + (xcd - r) * q) + off; }
        const int nig = WGM * nN, gid = wgid / nig, fm = gid * WGM, gsz = (nM - fm) < WGM ? (nM - fm) : WGM;
        u.pm = fm + ((wgid % nig) % gsz); u.pn = (wgid % nig) / gsz;
        int e = 0; if (cum) { for (int j = 0; j < 8; ++j) e += (cum[j] <= u.pm) ? 1 : 0; if (e > 7) e = 7; }
        u.A = A + (size_t)u.pm * 256 * K * 2; u.B = Bt + (size_t)e * bexp + (size_t)u.pn * 256 * K * 2; return true;
    }
};
struct TailOrder {
    const char* A; const char* Bt; int KS, npieces, G, c; size_t bexp; const PG8_LAS int* cum;
    __device__ void init(const void* A_, const void* Bt_, int KS_, int ntail, int G_, int c_, size_t bexp_, const PG8_LAS int* cum_) { A = (const char*)A_; Bt = (const char*)Bt_; KS = KS_; npieces = ntail * 28; G = G_; c = c_; bexp = bexp_; cum = cum_; }
    __device__ bool next(int i, Unit& u) const {
        const long L = (long)i * G + c; if (L >= npieces) return false;
        const int p = (int)L, kp = p % 7, pn = (p / 7) & 3, rbi = p / 28, rb = 128 + rbi;
        int e = 0; for (int j = 0; j < 8; ++j) e += (cum[j] <= rb) ? 1 : 0; if (e > 7) e = 7;
        u.pm = kp * 8 + rbi; u.pn = pn;
        u.A = A + ((size_t)rb * 256 * KS + (size_t)kp * 512) * 2; u.B = Bt + (size_t)e * bexp + ((size_t)pn * 256 * KS + (size_t)kp * 512) * 2; return true;
    }
};
__device__ __forceinline__ unsigned cvt_pk_bf16(float lo, float hi) { unsigned r; asm volatile("v_cvt_pk_bf16_f32 %0, %1, %2" : "=v"(r) : "v"(lo), "v"(hi)); return r; }

struct EpiF32 {
    static constexpr bool PERM = false;
    float* C; int ldc;
    __device__ __forceinline__ void operator()(const f32x4 (&acc)[2][2][4][2], const Unit& u, int wr, int wc, int fr, int fq) const {
        const int row0 = u.pm * BM + wr * 64 + fr, col0 = u.pn * BM + wc * 32 + 4 * fq;
#pragma unroll
        for (int ai = 0; ai < 2; ++ai)
#pragma unroll
            for (int m = 0; m < 4; ++m) { float* rowp = C + (size_t)(row0 + ai * HALF + m * 16) * ldc + col0;
#pragma unroll
                for (int bj = 0; bj < 2; ++bj)
#pragma unroll
                    for (int n = 0; n < 2; ++n) *(f32x4*)(rowp + bj * HALF + n * 16) = acc[ai][bj][m][n]; }
    }
};
struct EpiBf16Res {
    static constexpr bool PERM = true;
    bf16_t* O; const bf16_t* res; int ldc;
    __device__ __forceinline__ void operator()(const f32x4 (&acc)[2][2][4][2], const Unit& u, int wr, int wc, int fr, int fq) const {
        const int row0 = u.pm * BM + wr * 64 + fr, col0 = u.pn * BM + wc * 32 + 8 * fq;
#pragma unroll
        for (int ai = 0; ai < 2; ++ai)
#pragma unroll
            for (int m = 0; m < 4; ++m) { const size_t off = (size_t)(row0 + ai * HALF + m * 16) * ldc + col0;
#pragma unroll
                for (int bj = 0; bj < 2; ++bj) { f32x4 v0 = acc[ai][bj][m][0], v1 = acc[ai][bj][m][1];
                    if (res) { const u32x4 rw = *(const u32x4*)(res + off + bj * HALF);
                        v0[0] += ALPHA * bflo(rw.x); v0[1] += ALPHA * bfhi(rw.x); v0[2] += ALPHA * bflo(rw.y); v0[3] += ALPHA * bfhi(rw.y);
                        v1[0] += ALPHA * bflo(rw.z); v1[1] += ALPHA * bfhi(rw.z); v1[2] += ALPHA * bflo(rw.w); v1[3] += ALPHA * bfhi(rw.w); }
                    u32x4 w; w.x = cvt_pk_bf16(v0[0], v0[1]); w.y = cvt_pk_bf16(v0[2], v0[3]); w.z = cvt_pk_bf16(v1[0], v1[1]); w.w = cvt_pk_bf16(v1[2], v1[3]);
                    *(u32x4*)(O + off + bj * HALF) = w; } }
    }
};
struct EpiProj {
    static constexpr bool PERM = true;
    unsigned char* ws;
    __device__ __forceinline__ void operator()(const f32x4 (&acc)[2][2][4][2], const Unit& u, int wr, int wc, int fr, int fq) const {
        const int pn = u.pn; size_t off; int ldc, c0;
        if (pn < 4) { off = B_Z; ldc = 1024; c0 = pn; } else if (pn < 10) { off = B_XBCR; ldc = 1536; c0 = pn - 4; } else if (pn < 12) { off = B_HQ; ldc = 512; c0 = pn - 10; }
        else if (pn < 16) { off = B_HFR; ldc = 1024; c0 = pn - 12; } else if (pn < 18) { off = B_HI; ldc = 512; c0 = pn - 16; } else if (pn < 20) { off = B_HG; ldc = 512; c0 = pn - 18; }
        else if (pn < 24) { off = B_MQKR; ldc = 1024; c0 = pn - 20; } else if (pn < 26) { off = B_MV; ldc = 512; c0 = pn - 24; } else { off = B_MO; ldc = 512; c0 = pn - 26; }
        bf16_t* base = (bf16_t*)(ws + off);
        const int row0 = u.pm * BM + wr * 64 + fr, col0 = c0 * BM + wc * 32 + 8 * fq;
#pragma unroll
        for (int ai = 0; ai < 2; ++ai)
#pragma unroll
            for (int m = 0; m < 4; ++m) { bf16_t* rowp = base + (size_t)(row0 + ai * HALF + m * 16) * ldc + col0;
#pragma unroll
                for (int bj = 0; bj < 2; ++bj) { const f32x4 v0 = acc[ai][bj][m][0], v1 = acc[ai][bj][m][1];
                    u32x4 w; w.x = cvt_pk_bf16(v0[0], v0[1]); w.y = cvt_pk_bf16(v0[2], v0[3]); w.z = cvt_pk_bf16(v1[0], v1[1]); w.w = cvt_pk_bf16(v1[2], v1[3]);
                    *(u32x4*)(rowp + bj * HALF) = w; } }
    }
};
struct EpiSwiglu {
    static constexpr bool PERM = true;
    bf16_t* O; int ldc;
    __device__ __forceinline__ void operator()(const f32x4 (&acc)[2][2][4][2], const Unit& u, int wr, int wc, int fr, int fq) const {
        const int row0 = u.pm * BM + wr * 64 + fr, col0 = u.pn * HALF + wc * 32 + 8 * fq;
#pragma unroll
        for (int ai = 0; ai < 2; ++ai)
#pragma unroll
            for (int m = 0; m < 4; ++m) { bf16_t* rowp = O + (size_t)(row0 + ai * HALF + m * 16) * ldc + col0;
                float o[8];
#pragma unroll
                for (int n = 0; n < 2; ++n)
#pragma unroll
                    for (int j = 0; j < 4; ++j) { const float a = acc[ai][0][m][n][j], b = acc[ai][1][m][n][j]; o[n * 4 + j] = a * __builtin_amdgcn_rcpf(1.0f + __expf(-a)) * b; }
                u32x4 w; w.x = cvt_pk_bf16(o[0], o[1]); w.y = cvt_pk_bf16(o[2], o[3]); w.z = cvt_pk_bf16(o[4], o[5]); w.w = cvt_pk_bf16(o[6], o[7]);
                *(u32x4*)rowp = w; }
    }
};

template <class Epi, class Sched, bool ALIGN_EPI = true>
__device__ __forceinline__ void gemm_phase(PG8_LAS unsigned char* lds, const int K, const int KS, const Sched& S, const Epi& E, const int tid) {
    const int wid = __builtin_amdgcn_readfirstlane(tid >> 6), lane = tid & 63, wr = wid >> 2, wc = wid & 3, fr = lane & 15, fq = lane >> 4;
    const int nt = K / BK;
    unsigned voffA[2], voffB[2];
#pragma unroll
    for (int i = 0; i < 2; ++i) { int R, C; stage_rc(tid * 16 + i * 8192, R, C); const int Rb = Epi::PERM ? ((R & ~31) + perm32(R & 31)) : R;
        voffA[i] = (unsigned)(R * KS + C) * 2u; voffB[i] = (unsigned)(Rb * KS + C) * 2u; }
    const size_t kstep = (size_t)(BK * 2);
    const size_t hstep = (size_t)HALF * KS * 2;
    const unsigned ldsw = (unsigned)wid * 1024u;
    const int aoff = lds_byte(wr * 64 + fr, fq * 8), boff = lds_byte(wc * 32 + fr, fq * 8);
#define PG8_SA(b, h) (((b) * 2 + (h)) * HTB)
#define PG8_SB(b, h) ((4 + (b) * 2 + (h)) * HTB)
#define PG8_STAGE(bufoff, gbase, voff) do { _Pragma("unroll") for (int _i = 0; _i < 2; ++_i) \
        __builtin_amdgcn_global_load_lds((const unsigned*)((const char*)(gbase) + (voff)[_i]), (PG8_LAS unsigned*)(lds + (bufoff) + ldsw + _i * 8192), 16, 0, 0); } while (0)
#define PG8_LDA(dst, b, h) do { _Pragma("unroll") for (int m = 0; m < 4; ++m) _Pragma("unroll") for (int k = 0; k < 2; ++k) dst[m][k] = *(const PG8_LAS bf16x8*)(lds + PG8_SA(b, h) + aoff + m * 2048 + k * 1024); } while (0)
#define PG8_LDB(dst, b, h) do { _Pragma("unroll") for (int n = 0; n < 2; ++n) _Pragma("unroll") for (int k = 0; k < 2; ++k) dst[n][k] = *(const PG8_LAS bf16x8*)(lds + PG8_SB(b, h) + boff + n * 2048 + k * 1024); } while (0)
#define PG8_MMA(ai, bj, At, Bt) do { __builtin_amdgcn_s_setprio(1); _Pragma("unroll") for (int m = 0; m < 4; ++m) _Pragma("unroll") for (int n = 0; n < 2; ++n) _Pragma("unroll") for (int k = 0; k < 2; ++k) \
        acc[ai][bj][m][n] = __builtin_amdgcn_mfma_f32_16x16x32_bf16(Bt[n][k], At[m][k], acc[ai][bj][m][n], 0, 0, 0); __builtin_amdgcn_s_setprio(0); } while (0)
#define PG8_WAIT_V(n) asm volatile("s_waitcnt vmcnt(" #n ")" ::: "memory")
#define PG8_WAIT_L(n) asm volatile("s_waitcnt lgkmcnt(" #n ")" ::: "memory")
#define PG8_BAR __builtin_amdgcn_s_barrier()
#define PG8_SCHED __builtin_amdgcn_sched_barrier(0)
    Unit cur, nxt; int ui = 0;
    if (!S.next(0, cur)) return;
    f32x4 acc[2][2][4][2];
#pragma unroll
    for (int a = 0; a < 2; ++a)
#pragma unroll
        for (int b = 0; b < 2; ++b)
#pragma unroll
            for (int m = 0; m < 4; ++m)
#pragma unroll
                for (int n = 0; n < 2; ++n) acc[a][b][m][n] = (f32x4){0.f, 0.f, 0.f, 0.f};
    bf16x8 At[4][2], B0[2][2], B1[2][2];
    const char* cA = cur.A; const char* cB = cur.B;
    PG8_STAGE(PG8_SB(0, 0), cB, voffB); PG8_STAGE(PG8_SB(0, 1), cB + hstep, voffB); PG8_STAGE(PG8_SA(0, 0), cA, voffA); PG8_STAGE(PG8_SA(0, 1), cA + hstep, voffA);
    if (wr == 1) PG8_BAR;
    PG8_WAIT_V(2); PG8_BAR;
    PG8_STAGE(PG8_SB(1, 0), cB + kstep, voffB); PG8_STAGE(PG8_SA(1, 0), cA + kstep, voffA); PG8_STAGE(PG8_SB(1, 1), cB + hstep + kstep, voffB);
    PG8_WAIT_V(6); PG8_BAR;
    for (;;) {
        const bool has_next = S.next(ui + 1, nxt);
        const char* nA = has_next ? nxt.A : cA; const char* nB = has_next ? nxt.B : cB;
        for (int t = 0; t < nt; t += 2) {
            const bool last = (t == nt - 2);
            const char* a1 = cA + (size_t)(t + 1) * kstep;
            const char* a2 = last ? nA : cA + (size_t)(t + 2) * kstep; const char* b2 = last ? nB : cB + (size_t)(t + 2) * kstep;
            const char* a3 = a2 + kstep; const char* b3 = b2 + kstep;
            PG8_LDB(B0, 0, 0); PG8_LDB(B1, 0, 1); PG8_SCHED; PG8_LDA(At, 0, 0); PG8_STAGE(PG8_SA(1, 1), a1 + hstep, voffA);
            PG8_WAIT_V(8); PG8_WAIT_L(0); PG8_BAR; PG8_MMA(0, 0, At, B0); PG8_MMA(0, 1, At, B1); PG8_BAR; PG8_SCHED;
            PG8_LDA(At, 0, 1); PG8_STAGE(PG8_SB(0, 0), b2, voffB); PG8_STAGE(PG8_SB(0, 1), b2 + hstep, voffB); PG8_STAGE(PG8_SA(0, 0), a2, voffA);
            PG8_WAIT_V(8); PG8_WAIT_L(0); PG8_BAR; PG8_MMA(1, 0, At, B0); PG8_MMA(1, 1, At, B1); PG8_BAR; PG8_SCHED;
            PG8_LDB(B0, 1, 0); PG8_LDB(B1, 1, 1); PG8_SCHED; PG8_LDA(At, 1, 0); PG8_STAGE(PG8_SA(0, 1), a2 + hstep, voffA);
            PG8_WAIT_V(8); PG8_WAIT_L(0); PG8_BAR; PG8_MMA(0, 0, At, B0); PG8_MMA(0, 1, At, B1); PG8_BAR; PG8_SCHED;
            PG8_LDA(At, 1, 1); PG8_STAGE(PG8_SB(1, 0), b3, voffB); PG8_STAGE(PG8_SB(1, 1), b3 + hstep, voffB); PG8_STAGE(PG8_SA(1, 0), a3, voffA);
            PG8_WAIT_V(8); PG8_WAIT_L(0); PG8_BAR; PG8_MMA(1, 0, At, B0); PG8_MMA(1, 1, At, B1); PG8_BAR; PG8_SCHED;
        }
        if constexpr (ALIGN_EPI) { if (wr == 0) PG8_BAR; }
        E(acc, cur, wr, wc, fr, fq);
        if (!has_next) break;
#pragma unroll
        for (int a = 0; a < 2; ++a)
#pragma unroll
            for (int b = 0; b < 2; ++b)
#pragma unroll
                for (int m = 0; m < 4; ++m)
#pragma unroll
                    for (int n = 0; n < 2; ++n) acc[a][b][m][n] = (f32x4){0.f, 0.f, 0.f, 0.f};
        cur = nxt; cA = nA; cB = nB; ++ui;
        if constexpr (ALIGN_EPI) { if (wr == 1) PG8_BAR; }
    }
    PG8_WAIT_V(0);
    if constexpr (!ALIGN_EPI) { if (wr == 0) PG8_BAR; }
    PG8_BAR;
#undef PG8_SA
#undef PG8_SB
#undef PG8_STAGE
#undef PG8_LDA
#undef PG8_LDB
#undef PG8_MMA
#undef PG8_WAIT_V
#undef PG8_WAIT_L
#undef PG8_BAR
#undef PG8_SCHED
}
}

#define XB_TMO      128
#define XB_XCNT(j)  (256  + 64 * (j))
#define XB_XSUB(j)  (1280 + 64 * (j))
#define XB_XGEN(j)  (2304 + 64 * (j))
#define XB_TOP      3328
#define XB_TOPGEN   3392
#define XCD_BAR_WORDS 3456
#define XB_SPIN_CAP (1u << 22)
__device__ __forceinline__ unsigned xb_ld(unsigned* p)              { return __hip_atomic_load(p, __ATOMIC_RELAXED, __HIP_MEMORY_SCOPE_AGENT); }
__device__ __forceinline__ unsigned xb_add(unsigned* p, unsigned v) { return __hip_atomic_fetch_add(p, v, __ATOMIC_RELAXED, __HIP_MEMORY_SCOPE_AGENT); }
__device__ __forceinline__ unsigned xb_xcc_id() { return (unsigned)__builtin_amdgcn_s_getreg((3 << 11) | 20) & 0xFu; }
#define XB_SPIN(cond, bar) do { unsigned _sp = 0; while (cond) { __builtin_amdgcn_s_sleep(1); \
    if ((++_sp & 255u) == 0u) { if (xb_ld(&(bar)[XB_TMO])) break; if (_sp > XB_SPIN_CAP) { atomicAdd(&(bar)[XB_TMO], 1u); break; } } } } while (0)
struct XcdBarrier { unsigned* bar; unsigned x; volatile LAS unsigned* st; };
__device__ __forceinline__ XcdBarrier xcd_barrier_post(unsigned* bar, volatile LAS unsigned* st) {
    XcdBarrier b; b.bar = bar; b.x = xb_xcc_id(); b.st = st;
    if (threadIdx.x == 0) (void)xb_add(&bar[XB_XCNT(b.x)], 1u);
    return b;
}
__device__ __forceinline__ void xcd_barrier_complete(unsigned* bar, unsigned x, unsigned& nloc, unsigned& nx) {
    const unsigned G = gridDim.x * gridDim.y * gridDim.z;
    unsigned sum, cnt, mine, sp = 0u;
    for (;;) {
        sum = 0u; cnt = 0u; mine = 0u;
#pragma unroll
        for (unsigned j = 0; j < 16; ++j) { const unsigned c = xb_ld(&bar[XB_XCNT(j)]); sum += c; cnt += (c > 0u) ? 1u : 0u; mine = (j == x) ? c : mine; }
        if (sum == G) break;
        __builtin_amdgcn_s_sleep(1);
        if ((++sp & 255u) == 0u) { if (xb_ld(&bar[XB_TMO])) break; if (sp > XB_SPIN_CAP) { atomicAdd(&bar[XB_TMO], 1u); break; } }
    }
    nloc = mine > 0u ? mine : 1u; nx = cnt > 0u ? cnt : 1u;
}
__device__ __forceinline__ void xcd_barrier(const XcdBarrier& b) {
    asm volatile("s_waitcnt vmcnt(0)" ::: "memory");
    __syncthreads();
    if (threadIdx.x == 0) {
        unsigned* bar = b.bar;
        __builtin_amdgcn_s_waitcnt(0);
        unsigned nloc = b.st[0], nx = b.st[1];
        if (nloc == 0u) { xcd_barrier_complete(bar, b.x, nloc, nx); b.st[0] = nloc; b.st[1] = nx; }
        const unsigned old = xb_add(&bar[XB_XSUB(b.x)], 1u);
        const unsigned gen = old / nloc;
        if (old + 1u == (gen + 1u) * nloc) {
            __builtin_amdgcn_fence(__ATOMIC_RELEASE, "agent");
            asm volatile("s_waitcnt vmcnt(0)" ::: "memory");
            const unsigned og = xb_add(&bar[XB_TOP], 1u);
            const unsigned tg = og / nx;
            if (og + 1u == (tg + 1u) * nx) xb_add(&bar[XB_TOPGEN], 1u);
            else XB_SPIN(xb_ld(&bar[XB_TOPGEN]) == tg, bar);
            __builtin_amdgcn_fence(__ATOMIC_ACQUIRE, "agent");
            xb_add(&bar[XB_XGEN(b.x)], 1u);
            asm volatile("s_waitcnt vmcnt(0)" ::: "memory");
        } else {
            XB_SPIN(xb_ld(&bar[XB_XGEN(b.x)]) == gen, bar);
            __builtin_amdgcn_fence(__ATOMIC_ACQUIRE, "agent");
            asm volatile("s_waitcnt vmcnt(0)" ::: "memory");
        }
    }
    __syncthreads();
}

constexpr int RING_BYTES = 131072;
constexpr int MISC_OFF = RING_BYTES;
constexpr int LDS_BYTES = 147456;

struct Args { const float* in[29]; float* out; unsigned char* ws; int ph_lo, ph_hi; };

constexpr int PAR_OFF = MISC_OFF + 1024;
constexpr int TS_OFF = MISC_OFF + 512;
constexpr int PTAB_OFF = MISC_OFF + 256;
struct InTab {
    LAS unsigned char* lds;
    __device__ __forceinline__ const float* operator[](int i) const {
        const u32x2 w = *(const LAS u32x2*)(lds + PTAB_OFF + 8 * i);
        const unsigned long long p = ((unsigned long long)(unsigned)__builtin_amdgcn_readfirstlane((int)w.y) << 32) | (unsigned)__builtin_amdgcn_readfirstlane((int)w.x);
        return (const float*)p;
    }
};
struct Ctx {
    LAS unsigned char* lds; volatile LAS unsigned* misc; unsigned char* ws; InTab in; float* out;
    int tid, lane, wave, G, blk;
};

__device__ __forceinline__ void tr_quad0(unsigned a, bf16x8& f0, bf16x8& f1, bf16x8& f2, bf16x8& f3) {
    s16x4 l0, h0, l1, h1, l2, h2, l3, h3;
    asm volatile("ds_read_b64_tr_b16 %0, %8\n\tds_read_b64_tr_b16 %1, %8 offset:544\n\tds_read_b64_tr_b16 %2, %8 offset:32\n\tds_read_b64_tr_b16 %3, %8 offset:576\n\t"
                 "ds_read_b64_tr_b16 %4, %8 offset:64\n\tds_read_b64_tr_b16 %5, %8 offset:608\n\tds_read_b64_tr_b16 %6, %8 offset:96\n\tds_read_b64_tr_b16 %7, %8 offset:640\n\ts_waitcnt lgkmcnt(0)"
                 : "=&v"(l0), "=&v"(h0), "=&v"(l1), "=&v"(h1), "=&v"(l2), "=&v"(h2), "=&v"(l3), "=&v"(h3) : "v"(a) : "memory");
    f0 = __builtin_shufflevector(l0, h0, 0, 1, 2, 3, 4, 5, 6, 7); f1 = __builtin_shufflevector(l1, h1, 0, 1, 2, 3, 4, 5, 6, 7);
    f2 = __builtin_shufflevector(l2, h2, 0, 1, 2, 3, 4, 5, 6, 7); f3 = __builtin_shufflevector(l3, h3, 0, 1, 2, 3, 4, 5, 6, 7);
}
struct TItem { const float* src; bf16* dst; size_t ldw; int K; };
__device__ __forceinline__ void titem_load(f32x4 (&v)[16], const TItem& d, int lane) {
    const int kr = lane >> 4, n4 = (lane & 15) * 4;
#pragma unroll
    for (int i = 0; i < 16; ++i) v[i] = __builtin_nontemporal_load((const f32x4*)(d.src + (size_t)(4 * i + kr) * d.ldw + n4));
}
__device__ __forceinline__ void titem_store(const f32x4 (&v)[16], const TItem& d, LAS unsigned char* scr, int lane) {
    const int kr = lane >> 4, n4 = (lane & 15) * 4;
#pragma unroll
    for (int i = 0; i < 16; ++i) { u32x2 w; w.x = pk2(v[i].x, v[i].y); w.y = pk2(v[i].z, v[i].w); *(LAS u32x2*)(scr + (4 * i + kr) * 136 + n4 * 2) = w; }
    LDS_WAIT(); asm volatile("" ::: "memory");
    const unsigned img = (unsigned)(size_t)scr; const int r = lane & 15, q = lane >> 4;
    bf16x8 f[2][4];
#pragma unroll
    for (int kh = 0; kh < 2; ++kh) {
        const unsigned a0 = img + (32 * kh + 8 * q + (r >> 2)) * 136 + (4 * (r & 3)) * 2;
        tr_quad0(a0, f[kh][0], f[kh][1], f[kh][2], f[kh][3]);
    }
#pragma unroll
    for (int kh = 0; kh < 2; ++kh)
#pragma unroll
        for (int nt = 0; nt < 4; ++nt) *(LAS bf16x8*)(scr + (16 * nt + r) * 144 + (32 * kh + 8 * q) * 2) = f[kh][nt];
    LDS_WAIT(); asm volatile("" ::: "memory");
    const int orow = lane >> 3, och = lane & 7;
#pragma unroll
    for (int j = 0; j < 8; ++j) { const bf16x8 o = *(const LAS bf16x8*)(scr + (8 * j + orow) * 144 + och * 16); *(bf16x8*)(d.dst + (size_t)(8 * j + orow) * d.K + och * 8) = o; }
    LDS_WAIT(); asm volatile("" ::: "memory");
}
__device__ __forceinline__ void wconv_layer(Ctx& C, int l) {
    LAS unsigned char* scr = C.lds + C.wave * 16384;
    const int gw = C.blk * NWAVES + C.wave, NGW = C.G * NWAVES;
    const bool moe = (l & 1) != 0; const int li = l >> 1;
    const int dff = moe ? DFF_E : DFF_D, nexp = moe ? NEXP : 1;
    const int I_A = 16 * (NMAIN / 64), I_B = 32 * 16, I_C1 = 16 * (2 * dff / 64), I_D1 = (dff / 64) * 16;
    const int NIT = I_A + I_B + nexp * (I_C1 + I_D1);
    const float* w_in = C.in[3] + (size_t)l * D * DPROJ; const float* w_out = C.in[17] + (size_t)l * DMIX * D;
    const float* w1 = moe ? C.in[26] + (size_t)li * NEXP * D * DFF_E : C.in[22] + (size_t)li * D * DFF_D;
    const float* w3 = moe ? C.in[27] + (size_t)li * NEXP * D * DFF_E : C.in[23] + (size_t)li * D * DFF_D;
    const float* w2 = moe ? C.in[28] + (size_t)li * NEXP * DFF_E * D : C.in[24] + (size_t)li * DFF_D * D;
    bf16* WinT = (bf16*)(C.ws + WS_WIN); bf16* WoutT = (bf16*)(C.ws + WS_WOUT); bf16* W13T = (bf16*)(C.ws + WS_W13); bf16* W2T = (bf16*)(C.ws + WS_W2);
    auto decode = [&](int it) -> TItem {
        TItem d; int r = it;
        if (r < I_A) { const int nb = r % (NMAIN / 64), kb = r / (NMAIN / 64); const int n0 = 64 * nb; d.src = w_in + (size_t)(64 * kb) * DPROJ + (n0 < 2560 ? n0 : n0 + 32); d.ldw = DPROJ; d.K = D; d.dst = WinT + (size_t)n0 * D + 64 * kb; return d; } r -= I_A;
        if (r < I_B) { const int nb = r % 16, kb = r / 16; d.src = w_out + (size_t)(64 * kb) * D + 64 * nb; d.ldw = D; d.K = DMIX; d.dst = WoutT + (size_t)(64 * nb) * DMIX + 64 * kb; return d; } r -= I_B;
        const int per = I_C1 + I_D1, e = r / per; r -= e * per;
        if (r < I_C1) { const int nbn = 2 * dff / 64, nb = r % nbn, kb = r / nbn; const int n0 = 64 * nb, pn = n0 >> 8, within = n0 & 255, bj = within >> 7, uu = within & 127;
            d.src = (bj ? w3 : w1) + (size_t)e * D * dff + (size_t)(64 * kb) * dff + 128 * pn + uu; d.ldw = dff; d.K = D; d.dst = W13T + (size_t)e * 2 * dff * D + (size_t)n0 * D + 64 * kb; return d; } r -= I_C1;
        { const int nb = r % 16, kb = r / 16; d.src = w2 + (size_t)e * dff * D + (size_t)(64 * kb) * D + 64 * nb; d.ldw = D; d.K = dff; d.dst = W2T + (size_t)e * D * dff + (size_t)(64 * nb) * dff + 64 * kb; return d; }
    };
    f32x4 va[16], vb[16]; TItem da, db;
    int it = gw;
    if (it < NIT) { da = decode(it); titem_load(va, da, C.lane); }
    while (it < NIT) {
        const int i1 = it + NGW, i2 = it + 2 * NGW;
        if (i1 < NIT) { db = decode(i1); titem_load(vb, db, C.lane); }
        titem_store(va, da, scr, C.lane);
        if (i1 >= NIT) break;
        if (i2 < NIT) { da = decode(i2); titem_load(va, da, C.lane); }
        titem_store(vb, db, scr, C.lane);
        it = i2;
    }
}

template <int MODE, int SK>
__device__ __forceinline__ void ln_phase(Ctx& C, const float* src, const float* gam, const float* bet, float* dst_f32, int lsk) {
    LAS float* Aimg = (LAS float*)C.lds;
    LAS float* part = (LAS float*)(C.lds + 65792);
    LAS float* lgt = (LAS float*)(C.lds + 90368);
    constexpr int NCT = (SK == 1) ? 3 : 1;
    bf16* HB = (bf16*)(C.ws + WS_HBF);
    const bf16* Y = (const bf16*)(C.ws + B_Y); const bf16* YE = (const bf16*)(C.ws + B_YE);
    const unsigned* route = (const unsigned*)(C.ws + WS_ROUTE);
    unsigned* gcnt = (unsigned*)(C.ws + WS_CTL) + CW_CNT + 64 * (lsk >> 1);
    const int lane = C.lane, rr = lane & 15, q = lane >> 4;
    LAS float* gl = (LAS float*)(C.lds + 92160);
    if (C.tid < 256) { *(LAS f32x4*)(gl + 4 * C.tid) = *(const f32x4*)(gam + 4 * C.tid); *(LAS f32x4*)(gl + 1024 + 4 * C.tid) = *(const f32x4*)(bet + 4 * C.tid); }
    __syncthreads();
    const float* Wc[NCT]; size_t ldw = 0; bool wvalid = true;
    if (SK == 1) { const float* w_in = C.in[3] + (size_t)lsk * D * DPROJ; ldw = DPROJ;
#pragma unroll
        for (int ct = 0; ct < NCT; ++ct) Wc[ct] = w_in + (ct < 2 ? 2560 + 16 * ct + rr : 7200 + rr); }
    else if (SK == 2) { Wc[0] = C.in[25] + (size_t)(lsk >> 1) * D * NEXP + (rr & 7); ldw = NEXP; wvalid = rr < 8; }
    else { Wc[0] = nullptr; }
    float bw[32][NCT];
    if (SK == 2) {
#pragma unroll
        for (int ks = 0; ks < 32; ++ks)
#pragma unroll
            for (int ct = 0; ct < NCT; ++ct) bw[ks][ct] = wvalid ? Wc[ct][(size_t)(128 * C.wave + q + 4 * ks) * ldw] : 0.f;
    }
    bf16x8 bwh[4][NCT], bwl[4][NCT];
    if (SK == 1) {
#pragma unroll
        for (int ks = 0; ks < 4; ++ks)
#pragma unroll
            for (int ct = 0; ct < NCT; ++ct) {
                float wv[8];
#pragma unroll
                for (int j = 0; j < 8; ++j) wv[j] = Wc[ct][(size_t)(128 * C.wave + 32 * ks + 8 * q + j) * ldw];
                u32x4 h; h.x = pk2(wv[0], wv[1]); h.y = pk2(wv[2], wv[3]); h.z = pk2(wv[4], wv[5]); h.w = pk2(wv[6], wv[7]);
                u32x4 lo; lo.x = pk2(wv[0] - bflo(h.x), wv[1] - bfhi(h.x)); lo.y = pk2(wv[2] - bflo(h.y), wv[3] - bfhi(h.y)); lo.z = pk2(wv[4] - bflo(h.z), wv[5] - bfhi(h.z)); lo.w = pk2(wv[6] - bflo(h.w), wv[7] - bfhi(h.w));
                bwh[ks][ct] = __builtin_bit_cast(bf16x8, h); bwl[ks][ct] = __builtin_bit_cast(bf16x8, lo);
            }
    }
    constexpr size_t YELIM = (size_t)32768 * D;
    constexpr bool PREY = true;
    f32x4 rx[2][4]; u32x2 ra[2][4], rb[2][4], rh[2][4];
    auto load_rows = [&](int it2) {
#pragma unroll
        for (int r = 0; r < 2; ++r) {
            const size_t ro = (size_t)(it2 * 16 + C.wave * 2 + r) * D + 4 * lane;
#pragma unroll
            for (int j = 0; j < 4; ++j) {
                if (MODE == 0) rx[r][j] = *(const f32x4*)(src + ro + 256 * j);
                else if (MODE == 1 || MODE == 2) ra[r][j] = *(const u32x2*)(Y + ro + 256 * j);
                else { const unsigned* rt = route + (size_t)(it2 * 16 + C.wave * 2 + r) * 8; const size_t o0 = (size_t)rt[6] * D, o1 = (size_t)rt[7] * D;
                    rh[r][j] = *(const u32x2*)(HB + ro + 256 * j);
                    if (PREY && o0 < YELIM) ra[r][j] = *(const u32x2*)(YE + o0 + 4 * lane + 256 * j);
                    if (PREY && o1 < YELIM) rb[r][j] = *(const u32x2*)(YE + o1 + 4 * lane + 256 * j); }
            }
        }
    };
    constexpr bool EARLY = (SK == 0);
    if (C.blk < T / 16) load_rows(C.blk);
    for (int it = C.blk; it < T / 16; it += C.G) {
        const int row0 = it * 16 + C.wave * 2;
        const int itn = it + C.G; const bool hasn = itn < T / 16;
        f32x4 vv[2][4];
#pragma unroll
        for (int r = 0; r < 2; ++r) {
            if (MODE == 0) {
#pragma unroll
                for (int j = 0; j < 4; ++j) vv[r][j] = rx[r][j];
            } else if (MODE == 1 || MODE == 2) {
#pragma unroll
                for (int j = 0; j < 4; ++j) { const u32x2 yw = ra[r][j]; vv[r][j] = (f32x4){bflo(yw.x), bfhi(yw.x), bflo(yw.y), bfhi(yw.y)}; }
            } else {
                const unsigned* rt = route + (size_t)(row0 + r) * 8; const size_t o0 = (size_t)rt[6] * D, o1 = (size_t)rt[7] * D; const float g0 = __builtin_bit_cast(float, rt[4]), g1 = __builtin_bit_cast(float, rt[5]);
#pragma unroll
                for (int j = 0; j < 4; ++j) {
                    const u32x2 hw = rh[r][j];
                    f32x4 y0, y1;
                    if (o0 < YELIM) { const u32x2 w0 = PREY ? ra[r][j] : *(const u32x2*)(YE + o0 + 4 * lane + 256 * j); y0 = (f32x4){bflo(w0.x), bfhi(w0.x), bflo(w0.y), bfhi(w0.y)}; }
                    else { const float* pp = (const float*)(C.ws + B_PART) + (o0 - YELIM) + 4 * lane + 256 * j; y0 = *(const f32x4*)pp;
#pragma unroll
                        for (int kp = 1; kp < 7; ++kp) y0 += *(const f32x4*)(pp + (size_t)kp * 2048 * D);
                        { const unsigned a_ = pk2(y0[0], y0[1]), b_ = pk2(y0[2], y0[3]); y0 = (f32x4){bflo(a_), bfhi(a_), bflo(b_), bfhi(b_)}; } }
                    if (o1 < YELIM) { const u32x2 w1 = PREY ? rb[r][j] : *(const u32x2*)(YE + o1 + 4 * lane + 256 * j); y1 = (f32x4){bflo(w1.x), bfhi(w1.x), bflo(w1.y), bfhi(w1.y)}; }
                    else { const float* pp = (const float*)(C.ws + B_PART) + (o1 - YELIM) + 4 * lane + 256 * j; y1 = *(const f32x4*)pp;
#pragma unroll
                        for (int kp = 1; kp < 7; ++kp) y1 += *(const f32x4*)(pp + (size_t)kp * 2048 * D);
                        { const unsigned a_ = pk2(y1[0], y1[1]), b_ = pk2(y1[2], y1[3]); y1 = (f32x4){bflo(a_), bfhi(a_), bflo(b_), bfhi(b_)}; } }
                    vv[r][j] = ALPHA * (f32x4){bflo(hw.x), bfhi(hw.x), bflo(hw.y), bfhi(hw.y)} + g0 * y0 + g1 * y1;
                }
            }
        }
        if (EARLY && hasn) load_rows(itn);
#pragma unroll
        for (int r = 0; r < 2; ++r) {
            const int row = row0 + r;
            f32x4 v[4];
#pragma unroll
            for (int j = 0; j < 4; ++j) v[j] = vv[r][j];
            float s = 0.f;
#pragma unroll
            for (int j = 0; j < 4; ++j) s += (v[j].x + v[j].y) + (v[j].z + v[j].w);
            const float mean = wave_sum(s) * (1.f / D); float s2 = 0.f;
#pragma unroll
            for (int j = 0; j < 4; ++j) { v[j] = v[j] - mean; s2 += (v[j].x * v[j].x + v[j].y * v[j].y) + (v[j].z * v[j].z + v[j].w * v[j].w); }
            const float rstd = 1.f / sqrtf(wave_sum(s2) * (1.f / D) + LN_EPS);
#pragma unroll
            for (int j = 0; j < 4; ++j) {
                const f32x4 o = v[j] * rstd * *(const LAS f32x4*)(gl + 4 * lane + 256 * j) + *(const LAS f32x4*)(gl + 1024 + 4 * lane + 256 * j);
                if (dst_f32) *(f32x4*)(dst_f32 + (size_t)row * D + 4 * lane + 256 * j) = o;
                u32x2 w; w.x = pk2(o.x, o.y); w.y = pk2(o.z, o.w);
                *(u32x2*)(HB + (size_t)row * D + 4 * lane + 256 * j) = w;
                if (SK != 0) *(LAS f32x4*)(Aimg + (C.wave * 2 + r) * 1028 + 4 * lane + 256 * j) = o;
            }
        }
        if (!EARLY && hasn) load_rows(itn);
        if (SK != 0) {
            __syncthreads();
            f32x4 acc[NCT];
#pragma unroll
            for (int ct = 0; ct < NCT; ++ct) acc[ct] = (f32x4){0.f, 0.f, 0.f, 0.f};
            if (SK == 1) {
#pragma unroll
                for (int ks = 0; ks < 4; ++ks) {
                    const LAS float* ap = Aimg + rr * 1028 + 128 * C.wave + 32 * ks + 8 * q;
                    const f32x4 a0 = *(const LAS f32x4*)ap, a1 = *(const LAS f32x4*)(ap + 4);
                    u32x4 h; h.x = pk2(a0.x, a0.y); h.y = pk2(a0.z, a0.w); h.z = pk2(a1.x, a1.y); h.w = pk2(a1.z, a1.w);
                    u32x4 lo; lo.x = pk2(a0.x - bflo(h.x), a0.y - bfhi(h.x)); lo.y = pk2(a0.z - bflo(h.y), a0.w - bfhi(h.y)); lo.z = pk2(a1.x - bflo(h.z), a1.y - bfhi(h.z)); lo.w = pk2(a1.z - bflo(h.w), a1.w - bfhi(h.w));
                    const bf16x8 ah = __builtin_bit_cast(bf16x8, h), al = __builtin_bit_cast(bf16x8, lo);
#pragma unroll
                    for (int ct = 0; ct < NCT; ++ct) {
                        acc[ct] = __builtin_amdgcn_mfma_f32_16x16x32_bf16(ah, bwh[ks][ct], acc[ct], 0, 0, 0);
                        acc[ct] = __builtin_amdgcn_mfma_f32_16x16x32_bf16(ah, bwl[ks][ct], acc[ct], 0, 0, 0);
                        acc[ct] = __builtin_amdgcn_mfma_f32_16x16x32_bf16(al, bwh[ks][ct], acc[ct], 0, 0, 0);
                    }
                }
            } else {
                const int kb = 128 * C.wave + q;
#pragma unroll
                for (int ks = 0; ks < 32; ++ks) {
                    const float a = Aimg[rr * 1028 + kb + 4 * ks];
#pragma unroll
                    for (int ct = 0; ct < NCT; ++ct) acc[ct] = __builtin_amdgcn_mfma_f32_16x16x4f32(a, bw[ks][ct], acc[ct], 0, 0, 0);
                }
            }
#pragma unroll
            for (int ct = 0; ct < NCT; ++ct) *(LAS f32x4*)(part + ((C.wave * NCT + ct) * 64 + lane) * 4) = acc[ct];
            __syncthreads();
            for (int te = C.tid; te < 256 * NCT; te += NTHR) {
                const int ct = te >> 8, e = te & 255, ln = e >> 2, i = e & 3; float sum = 0.f;
#pragma unroll
                for (int w2 = 0; w2 < 8; ++w2) sum += part[((w2 * NCT + ct) * 64 + ln) * 4 + i];
                const int row = 4 * (ln >> 4) + i, col = 16 * ct + (ln & 15);
                if (SK == 1) ((float*)(C.ws + WS_GATES))[(size_t)(it * 16 + row) * NGATE + col] = sum;
                else if (col < 8) lgt[row * 8 + col] = sum;
            }
            if (SK == 2) {
                __syncthreads();
                if (C.wave == 0) {
                    int e0 = 0, e1 = 1; float g0 = 0.f, g1 = 0.f;
                    if (lane < 16) {
                        float my[8];
#pragma unroll
                        for (int c = 0; c < 8; ++c) my[c] = lgt[lane * 8 + c];
                        float v0 = my[0];
#pragma unroll
                        for (int c = 1; c < 8; ++c) if (my[c] > v0) { v0 = my[c]; e0 = c; }
                        float v1 = -3.0e38f; e1 = -1;
#pragma unroll
                        for (int c = 0; c < 8; ++c) if (c != e0 && my[c] > v1) { v1 = my[c]; e1 = c; }
                        g0 = 1.0f / (1.0f + __expf(v1 - v0)); g1 = 1.0f - g0;
                    }
                    const int er0 = __shfl(e0, (lane >> 1) & 15), er1 = __shfl(e1, (lane >> 1) & 15);
                    const int ent = lane < 32 ? ((lane & 1) ? er1 : er0) : -1;
                    unsigned m[8];
#pragma unroll
                    for (int e = 0; e < 8; ++e) m[e] = (unsigned)__ballot(ent == e);
                    if (lane < 16) {
                        const unsigned low = (1u << (2 * lane)) - 1u; unsigned me0 = 0u, me1 = 0u;
#pragma unroll
                        for (int e = 0; e < 8; ++e) { me0 = (e0 == e) ? m[e] : me0; me1 = (e1 == e) ? m[e] : me1; }
                        unsigned* rt = (unsigned*)(C.ws + WS_ROUTE) + (size_t)(it * 16 + lane) * 8;
                        rt[0] = (unsigned)e0; rt[1] = (unsigned)e1; rt[2] = (unsigned)__popc(me0 & low); rt[3] = (unsigned)__popc(me1 & low); rt[4] = __builtin_bit_cast(unsigned, g0); rt[5] = __builtin_bit_cast(unsigned, g1);
                    } else if (lane >= 32 && lane < 40) {
                        unsigned hv = 0u;
#pragma unroll
                        for (int e = 0; e < 8; ++e) hv = (lane - 32 == e) ? (unsigned)__popc(m[e]) : hv;
                        ((unsigned*)(C.ws + WS_ROUTE + 524288))[it * 8 + (lane - 32)] = hv;
                    }
                }
            }
        }
    }
}

__device__ __forceinline__ int moe_cum_table(Ctx& C, int lm, bool moe) {
    if (C.tid == 0) {
        const unsigned* gcnt = (const unsigned*)(C.ws + WS_CTL) + CW_CNT + 64 * lm; int acc = 0;
        for (int e = 0; e < 8; ++e) { const int nb = moe ? (int)((__hip_atomic_load(gcnt + e, __ATOMIC_RELAXED, __HIP_MEMORY_SCOPE_AGENT) + 255u) >> 8) : (e == 0 ? T / 256 : 0); acc += nb; C.misc[e] = (unsigned)acc; }
    }
    __syncthreads();
    return (int)C.misc[7];
}
__device__ __forceinline__ void moe_dispatch(Ctx& C, int lm) {
    LAS unsigned* P = (LAS unsigned*)C.lds;
    LAS unsigned* segs = (LAS unsigned*)(C.lds + 32768);
    const unsigned* IH = (const unsigned*)(C.ws + WS_ROUTE + 524288);
    for (int i = C.tid; i < 8192 / 4; i += NTHR) *(LAS u32x4*)(P + 4 * i) = *(const u32x4*)(IH + 4 * i);
    __syncthreads();
    {
        const int e = C.tid & 7, seg = C.tid >> 3; unsigned run = 0;
        for (int i = 0; i < 16; ++i) { const int idx = (seg * 16 + i) * 8 + e; const unsigned v = P[idx]; P[idx] = run; run += v; }
        segs[seg * 8 + e] = run;
    }
    __syncthreads();
    if (C.tid < 8) { unsigned run = 0; for (int sgi = 0; sgi < 64; ++sgi) { const unsigned v = segs[sgi * 8 + C.tid]; segs[sgi * 8 + C.tid] = run; run += v; }
        C.misc[16 + C.tid] = run;
        if (C.blk == 0) __hip_atomic_store((unsigned*)(C.ws + WS_CTL) + CW_CNT + 64 * lm + C.tid, run, __ATOMIC_RELAXED, __HIP_MEMORY_SCOPE_AGENT); }
    __syncthreads();
    { const int e = C.tid & 7, seg = C.tid >> 3; const unsigned off = segs[seg * 8 + e];
      for (int i = 0; i < 16; ++i) P[(seg * 16 + i) * 8 + e] += off; }
    if (C.tid == 0) { int acc = 0; for (int e = 0; e < 8; ++e) { acc += (int)((C.misc[16 + e] + 255u) >> 8); C.misc[e] = (unsigned)acc; } }
    __syncthreads();
    unsigned* route = (unsigned*)(C.ws + WS_ROUTE); const bf16* HB = (const bf16*)(C.ws + WS_HBF); bf16* XS = (bf16*)(C.ws + B_XS);
    const int gw = C.blk * NWAVES + C.wave, NGW = C.G * NWAVES;
    for (int t = gw; t < T; t += NGW) {
        unsigned* rt = route + (size_t)t * 8;
        const unsigned e0 = rt[0], e1 = rt[1]; const int it = t >> 4;
        const unsigned d0 = (e0 ? C.misc[e0 - 1] : 0u) * 256u + P[it * 8 + e0] + rt[2], d1 = (e1 ? C.misc[e1 - 1] : 0u) * 256u + P[it * 8 + e1] + rt[3];
        if (C.lane == 0) { rt[6] = d0; rt[7] = d1; }
        const u32x4* s = (const u32x4*)(HB + (size_t)t * D); u32x4* p0 = (u32x4*)(XS + (size_t)d0 * D); u32x4* p1 = (u32x4*)(XS + (size_t)d1 * D);
        const u32x4 a = s[C.lane], b = s[C.lane + 64];
        p0[C.lane] = a; p0[C.lane + 64] = b; p1[C.lane] = a; p1[C.lane + 64] = b;
    }
}

__device__ __forceinline__ void conv_phase(Ctx& C, int l) {
    const bf16* XR = (const bf16*)(C.ws + B_XBCR); const bf16* QR = (const bf16*)(C.ws + B_MQKR); bf16* XC = (bf16*)(C.ws + B_XBCC); bf16* QC = (bf16*)(C.ws + B_MQKC);
    const float* cw1 = C.in[4] + (size_t)l * 5 * 1536; const float* cb1 = C.in[5] + (size_t)l * 1536;
    const float* cw2 = C.in[12] + (size_t)l * 5 * 1024; const float* cb2 = C.in[13] + (size_t)l * 1024;
    const int NIT = (T / 8) * 320;
    for (int it = C.blk * NTHR + C.tid; it < NIT; it += C.G * NTHR) {
        const int tb = it / 320, gi = it - tb * 320; const int tok0 = tb * 8, t0 = tok0 & (SEQ - 1);
        const bool second = gi >= 192; const int c0 = second ? (gi - 192) * 8 : gi * 8; const int ld = second ? 1024 : 1536;
        const bf16* src = (second ? QR : XR) + c0; const float* cw = (second ? cw2 : cw1) + c0; const float* cb = (second ? cb2 : cb1) + c0;
        float wk[5][8], bias[8];
#pragma unroll
        for (int k = 0; k < 5; ++k) { const f32x4 wa = *(const f32x4*)(cw + (size_t)k * ld), wb = *(const f32x4*)(cw + (size_t)k * ld + 4);
            wk[k][0] = wa.x; wk[k][1] = wa.y; wk[k][2] = wa.z; wk[k][3] = wa.w; wk[k][4] = wb.x; wk[k][5] = wb.y; wk[k][6] = wb.z; wk[k][7] = wb.w; }
        { const f32x4 ba = *(const f32x4*)cb, bb = *(const f32x4*)(cb + 4); bias[0] = ba.x; bias[1] = ba.y; bias[2] = ba.z; bias[3] = ba.w; bias[4] = bb.x; bias[5] = bb.y; bias[6] = bb.z; bias[7] = bb.w; }
        u32x4 xr[12];
#pragma unroll
        for (int i = 0; i < 12; ++i) { const int tt = t0 + i - 2; xr[i] = (tt >= 0 && tt < SEQ) ? *(const u32x4*)(src + (size_t)(tok0 + i - 2) * ld) : (u32x4){0u, 0u, 0u, 0u}; }
#pragma unroll
        for (int o = 0; o < 8; ++o) {
            float acc[8];
#pragma unroll
            for (int j = 0; j < 8; ++j) acc[j] = bias[j];
#pragma unroll
            for (int k = 0; k < 5; ++k) { const u32x4 x = xr[o + k];
                acc[0] += bflo(x.x) * wk[k][0]; acc[1] += bfhi(x.x) * wk[k][1]; acc[2] += bflo(x.y) * wk[k][2]; acc[3] += bfhi(x.y) * wk[k][3];
                acc[4] += bflo(x.z) * wk[k][4]; acc[5] += bfhi(x.z) * wk[k][5]; acc[6] += bflo(x.w) * wk[k][6]; acc[7] += bfhi(x.w) * wk[k][7]; }
            u32x4 ov; ov.x = pk2(siluf_(acc[0]), siluf_(acc[1])); ov.y = pk2(siluf_(acc[2]), siluf_(acc[3])); ov.z = pk2(siluf_(acc[4]), siluf_(acc[5])); ov.w = pk2(siluf_(acc[6]), siluf_(acc[7]));
            *(u32x4*)((second ? QC : XC) + (size_t)(tok0 + o) * ld + c0) = ov;
        }
    }
    u32x4* z = (u32x4*)(C.ws + B_YBUF); const size_t NZ = (FAST_SSD && FAST_HG && FAST_ML) ? 0 : (size_t)160 * MiB / 16;
    for (size_t i = (size_t)C.blk * NTHR + C.tid; i < NZ; i += (size_t)C.G * NTHR) z[i] = (u32x4){0u, 0u, 0u, 0u};
}

__device__ __forceinline__ void naive_mixers(Ctx& C, int l) {
    const float* Gt = (const float*)(C.ws + WS_GATES);
    const bf16* XC = (const bf16*)(C.ws + B_XBCC); const bf16* QC = (const bf16*)(C.ws + B_MQKC);
    const bf16* HQ = (const bf16*)(C.ws + B_HQ); const bf16* HFR = (const bf16*)(C.ws + B_HFR); const bf16* HI = (const bf16*)(C.ws + B_HI); const bf16* MV = (const bf16*)(C.ws + B_MV);
    float* YB = (float*)(C.ws + B_YBUF); float* OB = (float*)(C.ws + B_OBUF); float* HBf = (float*)(C.ws + B_HBUF);
    const int tid = C.tid;
    for (int u = C.blk; u < 96; u += C.G) {
        if ((u < 64 && FAST_SSD) || (u >= 64 && u < 80 && FAST_HG) || (u >= 80 && FAST_ML)) continue;
        if (u < 64) {
            const int b = u >> 5, dir = (u >> 4) & 1, h = u & 15, g = h >> 3;
            const int p = tid >> 3, nq = tid & 7;
            const float dtb = C.in[6][(l * 2 + dir) * 16 + h], Aneg = -__expf(C.in[7][(l * 2 + dir) * 16 + h]);
            float st[16];
#pragma unroll
            for (int i = 0; i < 16; ++i) st[i] = 0.f;
            for (int s = 0; s < SEQ; ++s) {
                const int t = dir ? (SEQ - 1 - s) : s; const size_t tok = (size_t)b * SEQ + t;
                const float dt = softplusf_(Gt[tok * NGATE + dir * 16 + h] + dtb), dec = __expf(dt * Aneg);
                const float xv = dt * bf2f(XC[tok * 1536 + h * 64 + p]);
                const u32x4 b0 = *(const u32x4*)(XC + tok * 1536 + 1024 + g * 128 + nq * 16), b1 = *(const u32x4*)(XC + tok * 1536 + 1024 + g * 128 + nq * 16 + 8);
                const u32x4 c0 = *(const u32x4*)(XC + tok * 1536 + 1280 + g * 128 + nq * 16), c1 = *(const u32x4*)(XC + tok * 1536 + 1280 + g * 128 + nq * 16 + 8);
                const unsigned bw[8] = {b0.x, b0.y, b0.z, b0.w, b1.x, b1.y, b1.z, b1.w}, cwv[8] = {c0.x, c0.y, c0.z, c0.w, c1.x, c1.y, c1.z, c1.w};
                float y = 0.f;
#pragma unroll
                for (int i = 0; i < 8; ++i) {
                    st[2 * i] = st[2 * i] * dec + xv * bflo(bw[i]); st[2 * i + 1] = st[2 * i + 1] * dec + xv * bfhi(bw[i]);
                    y += st[2 * i] * bflo(cwv[i]) + st[2 * i + 1] * bfhi(cwv[i]);
                }
                y += __shfl_xor(y, 1); y += __shfl_xor(y, 2); y += __shfl_xor(y, 4);
                if (nq == 0) atomicAdd(YB + tok * 1024 + h * 64 + p, y);
            }
        } else if (u < 80) {
            const int uu = u - 64, b = uu >> 3, dir = (uu >> 2) & 1, hd = uu & 3;
            const int v = tid >> 2, kq = tid & 3;
            float st[32], oml[32];
#pragma unroll
            for (int i = 0; i < 32; ++i) {
                const int ch = hd * 128 + kq * 32 + i;
                const float x0 = C.in[10][0 * 512 + ch], x1 = C.in[10][1 * 512 + ch], x2 = C.in[10][2 * 512 + ch], x3 = C.in[10][3 * 512 + ch];
                const float mx = fmaxf(fmaxf(x0, x1), fmaxf(x2, x3)); const float e0 = __expf(x0 - mx), e1 = __expf(x1 - mx), e2 = __expf(x2 - mx), e3 = __expf(x3 - mx); const float inv = 1.0f / (e0 + e1 + e2 + e3);
                float lb = 0.f; if (l >= 1) lb += e1 * inv; if (l >= 2) lb += e2 * inv; if (l >= 3) lb += e3 * inv;
                oml[i] = 1.0f - lb; st[i] = 0.f;
            }
            for (int s = 0; s < SEQ; ++s) {
                const int t = dir ? (SEQ - 1 - s) : s; const size_t tok = (size_t)b * SEQ + t;
                const float vv = bf2f(HI[tok * 512 + hd * 128 + v]);
                float o = 0.f;
#pragma unroll
                for (int c4 = 0; c4 < 4; ++c4) {
                    const u32x4 fw = *(const u32x4*)(HFR + tok * 1024 + dir * 512 + hd * 128 + kq * 32 + c4 * 8);
                    const u32x4 qw = *(const u32x4*)(HQ + tok * 512 + hd * 128 + kq * 32 + c4 * 8);
                    const unsigned fa[4] = {fw.x, fw.y, fw.z, fw.w}, qa[4] = {qw.x, qw.y, qw.z, qw.w};
#pragma unroll
                    for (int i = 0; i < 4; ++i) {
                        const int k0 = c4 * 8 + 2 * i;
                        const float key0 = oml[k0] * sigmoidf_(-bflo(fa[i])), key1 = oml[k0 + 1] * sigmoidf_(-bfhi(fa[i]));
                        st[k0] = (1.0f - key0) * st[k0] + key0 * vv; st[k0 + 1] = (1.0f - key1) * st[k0 + 1] + key1 * vv;
                        o += siluf_(bflo(qa[i])) * st[k0] + siluf_(bfhi(qa[i])) * st[k0 + 1];
                    }
                }
                o += __shfl_xor(o, 1); o += __shfl_xor(o, 2);
                if (kq == 0) atomicAdd(OB + tok * 512 + hd * 128 + v, o);
            }
        } else {
            const int uu = u - 80, b = uu >> 3, dir = (uu >> 2) & 1, hd = uu & 3;
            const int v = tid >> 2, kq = tid & 3;
            const float igb = C.in[14][(l * 2 + dir) * 4 + hd], fgb = C.in[15][(l * 2 + dir) * 4 + hd];
            float cs[32], ns[32];
#pragma unroll
            for (int i = 0; i < 32; ++i) { cs[i] = 0.f; ns[i] = 0.f; }
            for (int s = 0; s < SEQ; ++s) {
                const int t = dir ? (SEQ - 1 - s) : s; const size_t tok = (size_t)b * SEQ + t;
                const float ei = __expf(Gt[tok * NGATE + 32 + dir * 4 + hd] + igb);
                const float f = __expf(-softplusf_(-(Gt[tok * NGATE + 40 + dir * 4 + hd] + fgb)));
                const float vv = bf2f(MV[tok * 512 + hd * 128 + v]);
                float num = 0.f, den = 0.f;
#pragma unroll
                for (int c4 = 0; c4 < 4; ++c4) {
                    const u32x4 qw = *(const u32x4*)(QC + tok * 1024 + hd * 128 + kq * 32 + c4 * 8);
                    const u32x4 kw = *(const u32x4*)(QC + tok * 1024 + 512 + hd * 128 + kq * 32 + c4 * 8);
                    const unsigned qa[4] = {qw.x, qw.y, qw.z, qw.w}, ka[4] = {kw.x, kw.y, kw.z, kw.w};
#pragma unroll
                    for (int i = 0; i < 4; ++i) {
                        const int k0 = c4 * 8 + 2 * i;
                        const float ka0 = ei * bflo(ka[i]), ka1 = ei * bfhi(ka[i]);
                        cs[k0] = f * cs[k0] + ka0 * vv; cs[k0 + 1] = f * cs[k0 + 1] + ka1 * vv;
                        ns[k0] = f * ns[k0] + ka0; ns[k0 + 1] = f * ns[k0 + 1] + ka1;
                        const float q0 = bflo(qa[i]) * 0.08838834764831845f, q1 = bfhi(qa[i]) * 0.08838834764831845f;
                        num += q0 * cs[k0] + q1 * cs[k0 + 1]; den += q0 * ns[k0] + q1 * ns[k0 + 1];
                    }
                }
                num += __shfl_xor(num, 1); num += __shfl_xor(num, 2); den += __shfl_xor(den, 1); den += __shfl_xor(den, 2);
                if (kq == 0) atomicAdd(HBf + tok * 512 + hd * 128 + v, num / fmaxf(fabsf(den), 1.0f));
            }
        }
    }
}
__device__ __forceinline__ void naive_combine(Ctx& C, int l) {
    const float* YB = (const float*)(C.ws + B_YBUF); const float* OB = (const float*)(C.ws + B_OBUF); const float* HBf = (const float*)(C.ws + B_HBUF);
    const bf16* XC = (const bf16*)(C.ws + B_XBCC); const bf16* Z = (const bf16*)(C.ws + B_Z); const bf16* HG = (const bf16*)(C.ws + B_HG); const bf16* MO = (const bf16*)(C.ws + B_MO);
    bf16* MIX = (bf16*)(C.ws + B_MIX);
    const float* dsk = C.in[8] + l * 16; const float* nw1 = C.in[9] + l * 1024; const float* nw2 = C.in[11] + l * 512; const float* nw3 = C.in[16] + l * 512;
    const int gw = C.blk * NWAVES + C.wave, NGW = C.G * NWAVES, lane = C.lane;
    for (int tok = gw; tok < T; tok += NGW) {
        if (!FAST_SSD) { float y[16]; float ss = 0.f; const int c0 = 16 * lane; const float dk = dsk[c0 >> 6];
#pragma unroll
          for (int j = 0; j < 16; ++j) { const float x = bf2f(XC[(size_t)tok * 1536 + c0 + j]); const float z = bf2f(Z[(size_t)tok * 1024 + c0 + j]);
              y[j] = (YB[(size_t)tok * 1024 + c0 + j] + x * dk) * siluf_(z); ss += y[j] * y[j]; }
#pragma unroll
          for (int o = 1; o < 32; o <<= 1) ss += __shfl_xor(ss, o);
          const float r = 1.0f / sqrtf(ss * (1.f / 512.f) + RMS_EPS);
#pragma unroll
          for (int j = 0; j < 16; ++j) MIX[(size_t)tok * 2048 + c0 + j] = (bf16)f2bf(y[j] * r * nw1[c0 + j]); }
        if (!FAST_HG) { float o[8]; float ss = 0.f; const int c0 = 8 * lane;
#pragma unroll
          for (int j = 0; j < 8; ++j) { o[j] = OB[(size_t)tok * 512 + c0 + j]; ss += o[j] * o[j]; }
#pragma unroll
          for (int q = 1; q < 16; q <<= 1) ss += __shfl_xor(ss, q);
          const float r = 1.0f / sqrtf(ss * (1.f / 128.f) + RMS_EPS);
#pragma unroll
          for (int j = 0; j < 8; ++j) MIX[(size_t)tok * 2048 + 1024 + c0 + j] = (bf16)f2bf(o[j] * r * nw2[c0 + j] * siluf_(bf2f(HG[(size_t)tok * 512 + c0 + j]))); }
        if (!FAST_ML) { float o[8]; float s = 0.f; const int c0 = 8 * lane;
#pragma unroll
          for (int j = 0; j < 8; ++j) { o[j] = HBf[(size_t)tok * 512 + c0 + j]; s += o[j]; }
#pragma unroll
          for (int q = 1; q < 16; q <<= 1) s += __shfl_xor(s, q);
          const float mean = s * (1.f / 128.f); float ss = 0.f;
#pragma unroll
          for (int j = 0; j < 8; ++j) { o[j] -= mean; ss += o[j] * o[j]; }
#pragma unroll
          for (int q = 1; q < 16; q <<= 1) ss += __shfl_xor(ss, q);
          const float r = 1.0f / sqrtf(ss * (1.f / 128.f) + LN_EPS);
#pragma unroll
          for (int j = 0; j < 8; ++j) MIX[(size_t)tok * 2048 + 1536 + c0 + j] = (bf16)f2bf(o[j] * r * nw3[c0 + j] * sigmoidf_(bf2f(MO[(size_t)tok * 512 + c0 + j]))); }
    }
}


#define MFMA16(a, b, c) __builtin_amdgcn_mfma_f32_16x16x32_bf16((a), (b), (c), 0, 0, 0)
__device__ __forceinline__ unsigned lds_addr(const LAS unsigned char* p) { return (unsigned)(size_t)p; }
__device__ __forceinline__ bf16x8 frag_row(const LAS unsigned char* img, int stride, int row, int kel) { return *(const LAS bf16x8*)(img + row * stride + kel * 2); }
__device__ __forceinline__ bf16x8 tr2(unsigned a0, unsigned a1) {
    s16x4 lo, hi;
    asm volatile("ds_read_b64_tr_b16 %0, %2\n\tds_read_b64_tr_b16 %1, %3\n\ts_waitcnt lgkmcnt(0)" : "=&v"(lo), "=&v"(hi) : "v"(a0), "v"(a1) : "memory");
    return __builtin_shufflevector(lo, hi, 0, 1, 2, 3, 4, 5, 6, 7);
}
template <int DB>
__device__ __forceinline__ void tr_quad(unsigned a, bf16x8& f0, bf16x8& f1, bf16x8& f2, bf16x8& f3) {
    s16x4 l0, h0, l1, h1, l2, h2, l3, h3;
    asm volatile("ds_read_b64_tr_b16 %0, %8\n\tds_read_b64_tr_b16 %1, %8 offset:%9\n\tds_read_b64_tr_b16 %2, %8 offset:32\n\tds_read_b64_tr_b16 %3, %8 offset:%10\n\t"
                 "ds_read_b64_tr_b16 %4, %8 offset:64\n\tds_read_b64_tr_b16 %5, %8 offset:%11\n\tds_read_b64_tr_b16 %6, %8 offset:96\n\tds_read_b64_tr_b16 %7, %8 offset:%12\n\ts_waitcnt lgkmcnt(0)"
                 : "=&v"(l0), "=&v"(h0), "=&v"(l1), "=&v"(h1), "=&v"(l2), "=&v"(h2), "=&v"(l3), "=&v"(h3)
                 : "v"(a), "n"(DB), "n"(DB + 32), "n"(DB + 64), "n"(DB + 96) : "memory");
    f0 = __builtin_shufflevector(l0, h0, 0, 1, 2, 3, 4, 5, 6, 7); f1 = __builtin_shufflevector(l1, h1, 0, 1, 2, 3, 4, 5, 6, 7);
    f2 = __builtin_shufflevector(l2, h2, 0, 1, 2, 3, 4, 5, 6, 7); f3 = __builtin_shufflevector(l3, h3, 0, 1, 2, 3, 4, 5, 6, 7);
}
template <bool ACC, int STRIDE>
__device__ __forceinline__ void frag_tr4(unsigned img, int k0, int n0, int r, int q, bf16x8 (&f)[4]) {
    const unsigned a = img + (k0 + (ACC ? 4 : 8) * q + (r >> 2)) * STRIDE + (n0 + 4 * (r & 3)) * 2;
    tr_quad<(ACC ? 16 : 4) * STRIDE>(a, f[0], f[1], f[2], f[3]);
}
__device__ __forceinline__ bf16x8 frag_tr(unsigned img, int stride, int k0, int n0, int r, int q) { const unsigned a = img + (k0 + 8 * q + (r >> 2)) * stride + (n0 + 4 * (r & 3)) * 2; return tr2(a, a + 4 * stride); }
__device__ __forceinline__ bf16x8 frag_tr_acc(unsigned img, int stride, int k0, int n0, int r, int q) { const unsigned a = img + (k0 + 4 * q + (r >> 2)) * stride + (n0 + 4 * (r & 3)) * 2; return tr2(a, a + 16 * stride); }
__device__ __forceinline__ bf16x8 pack8(const float (&v)[8]) { u32x4 w; w.x = pk2(v[0], v[1]); w.y = pk2(v[2], v[3]); w.z = pk2(v[4], v[5]); w.w = pk2(v[6], v[7]); return __builtin_bit_cast(bf16x8, w); }
__device__ __forceinline__ void unpack8(const bf16x8 f, float (&v)[8]) { const u32x4 w = __builtin_bit_cast(u32x4, f); v[0] = bflo(w.x); v[1] = bfhi(w.x); v[2] = bflo(w.y); v[3] = bfhi(w.y); v[4] = bflo(w.z); v[5] = bfhi(w.z); v[6] = bflo(w.w); v[7] = bfhi(w.w); }
__device__ __forceinline__ u32x2 pack4(const f32x4 v) { u32x2 w; w.x = pk2(v[0], v[1]); w.y = pk2(v[2], v[3]); return w; }
template <int ROWS, int COLS> struct TileRegs { u32x4 v[ROWS * COLS / 8 / NTHR]; };
template <int ROWS, int COLS>
__device__ __forceinline__ void tile_gload(TileRegs<ROWS, COLS>& t, const bf16* src, size_t ld, int tid) {
    constexpr int CPR = COLS / 8, NI = ROWS * COLS / 8 / NTHR;
#pragma unroll
    for (int i = 0; i < NI; ++i) { const int idx = tid + i * NTHR, row = idx / CPR, ch = idx - row * CPR; t.v[i] = *(const u32x4*)(src + (size_t)row * ld + ch * 8); }
}
template <int ROWS, int COLS, int STRIDE>
__device__ __forceinline__ void tile_sstore(const TileRegs<ROWS, COLS>& t, LAS unsigned char* img, int tid) {
    constexpr int CPR = COLS / 8, NI = ROWS * COLS / 8 / NTHR;
#pragma unroll
    for (int i = 0; i < NI; ++i) { const int idx = tid + i * NTHR, row = idx / CPR, ch = idx - row * CPR; *(LAS u32x4*)(img + row * STRIDE + ch * 16) = t.v[i]; }
}
__device__ __forceinline__ void scan128(float a0, float a1, int lane, float& i0, float& i1, float& tot) {
    float s = a0 + a1;
#pragma unroll
    for (int o = 1; o < 64; o <<= 1) { const float t = __shfl_up(s, o); if (lane >= o) s += t; }
    i1 = s; i0 = s - a1; tot = __shfl(s, 63);
}
__device__ __forceinline__ float hg_lb(const float* lbl, int l, int ch) {
    const float x0 = lbl[0 * 512 + ch], x1 = lbl[1 * 512 + ch], x2 = lbl[2 * 512 + ch], x3 = lbl[3 * 512 + ch];
    const float mx = fmaxf(fmaxf(x0, x1), fmaxf(x2, x3)); const float e0 = __expf(x0 - mx), e1 = __expf(x1 - mx), e2 = __expf(x2 - mx), e3 = __expf(x3 - mx); const float inv = 1.0f / (e0 + e1 + e2 + e3);
    float lb = 0.f; if (l >= 1) lb += e1 * inv; if (l >= 2) lb += e2 * inv; if (l >= 3) lb += e3 * inv; return lb;
}

__device__ __forceinline__ void mix_params(Ctx& C, int l, bool ephase) {
    LAS float* P = (LAS float*)(C.lds + PAR_OFF);
    if (C.tid < 512) P[C.tid] = 1.0f - hg_lb(C.in[10], l, C.tid);
    if (C.tid < 32) { P[512 + C.tid] = C.in[6][l * 32 + C.tid]; P[544 + C.tid] = -__expf(C.in[7][l * 32 + C.tid]); }
    if (C.tid < 16) P[576 + C.tid] = C.in[8][l * 16 + C.tid];
    if (C.tid < 8) { P[592 + C.tid] = C.in[14][l * 8 + C.tid]; P[600 + C.tid] = C.in[15][l * 8 + C.tid]; }
    if (ephase) {
        if (C.tid < 256) *(LAS f32x4*)(P + 640 + 4 * C.tid) = *(const f32x4*)(C.in[9] + l * 1024 + 4 * C.tid);
        else if (C.tid < 384) *(LAS f32x4*)(P + 1664 + 4 * (C.tid - 256)) = *(const f32x4*)(C.in[11] + l * 512 + 4 * (C.tid - 256));
        else *(LAS f32x4*)(P + 2176 + 4 * (C.tid - 384)) = *(const f32x4*)(C.in[16] + l * 512 + 4 * (C.tid - 384));
    }
    __syncthreads();
}
#define UNIT_PROLOG() Ctx C = C0_; { int ln_; asm volatile("v_mbcnt_lo_u32_b32 %0, -1, 0\n\tv_mbcnt_hi_u32_b32 %0, -1, %0" : "=v"(ln_)); C.lane = ln_; C.tid = C.wave * 64 + ln_; C.ws = (unsigned char*)C0_.in[30]; }
__device__ __forceinline__ void ssdC_seq(Ctx& C0_, int l, int u0, int nu, int ustride) { UNIT_PROLOG();
    const int tid = C.tid, lane = C.lane, w = C.wave, r = lane & 15, q = lane >> 4;
    LAS unsigned char* Bimg = C.lds; LAS unsigned char* Ximg = C.lds + 34816; LAS float* wv = (LAS float*)(C.lds + 102400);
    const bf16* XC = (const bf16*)(C.ws + B_XBCC);
    TileRegs<128, 128> tB; TileRegs<128, 256> tX;
    { const int half = u0 & 1, g = (u0 >> 1) & 1, c = (u0 >> 2) & 63, b = u0 >> 8; const size_t tok0 = (size_t)b * SEQ + c * 128;
      tile_gload(tB, XC + tok0 * 1536 + 1024 + g * 128, 1536, tid); tile_gload(tX, XC + tok0 * 1536 + (g * 8 + half * 4) * 64, 1536, tid); }
#pragma unroll 1
    for (int iu = 0; iu < nu; ++iu) {
        const int u = u0 + iu * ustride;
        const int half = u & 1, g = (u >> 1) & 1, c = (u >> 2) & 63, b = u >> 8;
        const size_t tok0 = (size_t)b * SEQ + c * 128;
        {
            const int hh = w >> 1, dir = w & 1, h = g * 8 + half * 4 + hh;
            const float dtb = ((const LAS float*)(C.lds + PAR_OFF))[512 + dir * 16 + h], Aneg = ((const LAS float*)(C.lds + PAR_OFF))[544 + dir * 16 + h];
            const float* Gt = (const float*)(C.ws + WS_GATES);
            const float d0 = softplusf_(Gt[(tok0 + 2 * lane) * NGATE + dir * 16 + h] + dtb), d1 = softplusf_(Gt[(tok0 + 2 * lane + 1) * NGATE + dir * 16 + h] + dtb);
            const float a0 = d0 * Aneg, a1 = d1 * Aneg; float i0, i1, tot; scan128(a0, a1, lane, i0, i1, tot);
            const float c0 = dir ? tot - i0 + a0 : i0, c1 = dir ? tot - i1 + a1 : i1;
            wv[w * 128 + 2 * lane] = d0 * __expf(tot - c0); wv[w * 128 + 2 * lane + 1] = d1 * __expf(tot - c1);
            if (lane == 0) ((float*)(C.ws + B_DECS))[((b * 64 + c) * 2 + dir) * 16 + h] = __expf(tot);
        }
        tile_sstore<128, 128, 272>(tB, Bimg, tid); tile_sstore<128, 256, 528>(tX, Ximg, tid);
        if (iu + 1 < nu) {
            const int u2 = u + ustride; const int half2 = u2 & 1, g2 = (u2 >> 1) & 1, c2 = (u2 >> 2) & 63, b2 = u2 >> 8; const size_t tk2 = (size_t)b2 * SEQ + c2 * 128;
            tile_gload(tB, XC + tk2 * 1536 + 1024 + g2 * 128, 1536, tid); tile_gload(tX, XC + tk2 * 1536 + (g2 * 8 + half2 * 4) * 64, 1536, tid);
        }
        __syncthreads();
        const unsigned bimg = lds_addr(Bimg), ximg = lds_addr(Ximg);
        bf16x8 bfr[4];
#pragma unroll
        for (int ks = 0; ks < 4; ++ks) bfr[ks] = frag_tr(bimg, 272, 32 * ks, 16 * w, r, q);
        bf16* ST = (bf16*)(C.ws + B_STS);
#pragma unroll 1
        for (int hh = 0; hh < 4; ++hh) {
            const int h = g * 8 + half * 4 + hh;
            f32x4 acc[2][4];
#pragma unroll
            for (int d = 0; d < 2; ++d)
#pragma unroll
                for (int pt = 0; pt < 4; ++pt) acc[d][pt] = (f32x4){0.f, 0.f, 0.f, 0.f};
#pragma unroll
            for (int ks = 0; ks < 4; ++ks) {
                bf16x8 xf[4]; frag_tr4<false, 528>(ximg, 32 * ks, hh * 64, r, q, xf);
                float bv[8]; unpack8(bfr[ks], bv);
#pragma unroll
                for (int d = 0; d < 2; ++d) {
                    const f32x4 w0 = *(const LAS f32x4*)(wv + (hh * 2 + d) * 128 + 32 * ks + 8 * q), w1 = *(const LAS f32x4*)(wv + (hh * 2 + d) * 128 + 32 * ks + 8 * q + 4);
                    float sv[8] = {bv[0] * w0.x, bv[1] * w0.y, bv[2] * w0.z, bv[3] * w0.w, bv[4] * w1.x, bv[5] * w1.y, bv[6] * w1.z, bv[7] * w1.w};
                    const bf16x8 bs = pack8(sv);
#pragma unroll
                    for (int pt = 0; pt < 4; ++pt) acc[d][pt] = MFMA16(bs, xf[pt], acc[d][pt]);
                }
            }
            LAS unsigned char* Oimg = C.lds + 106496;
#pragma unroll
            for (int d = 0; d < 2; ++d) {
#pragma unroll
                for (int pt = 0; pt < 4; ++pt) *(LAS u32x2*)(Oimg + (16 * pt + r) * 272 + (16 * w + 4 * q) * 2) = pack4(acc[d][pt]);
                __syncthreads();
                bf16* dstp = ST + (size_t)(((b * 64 + c) * 2 + d) * 16 + h) * 8192;
#pragma unroll
                for (int i = 0; i < 2; ++i) { const int idx = tid + i * NTHR, row = idx >> 4, ch = idx & 15; *(u32x4*)(dstp + row * 128 + ch * 8) = *(const LAS u32x4*)(Oimg + row * 272 + ch * 16); }
                __syncthreads();
            }
        }
        __syncthreads();
    }
}
__device__ __forceinline__ void mlC_seq(Ctx& C0_, int l, int u0, int nu, int ustride) { UNIT_PROLOG();
    const int tid = C.tid, lane = C.lane, w = C.wave, r = lane & 15, q = lane >> 4;
    LAS unsigned char* Kimg = C.lds; LAS unsigned char* Vimg = C.lds + 34816; LAS float* wv = (LAS float*)(C.lds + 69632);
    TileRegs<128, 128> tK, tV;
    { const int hd = u0 & 3, c = (u0 >> 2) & 63, b = u0 >> 8; const size_t tok0 = (size_t)b * SEQ + c * 128;
      tile_gload(tK, (const bf16*)(C.ws + B_MQKC) + tok0 * 1024 + 512 + hd * 128, 1024, tid); tile_gload(tV, (const bf16*)(C.ws + B_MV) + tok0 * 512 + hd * 128, 512, tid); }
    float gf0 = 0.f, gf1 = 0.f, gi0 = 0.f, gi1 = 0.f;
    if (w < 2) { const int hd = u0 & 3, c = (u0 >> 2) & 63, b = u0 >> 8; const size_t tok0 = (size_t)b * SEQ + c * 128; const float* Gt = (const float*)(C.ws + WS_GATES);
        gf0 = Gt[(tok0 + 2 * lane) * NGATE + 40 + w * 4 + hd]; gf1 = Gt[(tok0 + 2 * lane + 1) * NGATE + 40 + w * 4 + hd]; gi0 = Gt[(tok0 + 2 * lane) * NGATE + 32 + w * 4 + hd]; gi1 = Gt[(tok0 + 2 * lane + 1) * NGATE + 32 + w * 4 + hd]; }
#pragma unroll 1
    for (int iu = 0; iu < nu; ++iu) {
        const int u = u0 + iu * ustride;
        const int hd = u & 3, c = (u >> 2) & 63, b = u >> 8;
        const size_t tok0 = (size_t)b * SEQ + c * 128;
        if (w < 2) {
            const int dir = w; const float igb = ((const LAS float*)(C.lds + PAR_OFF))[592 + dir * 4 + hd], fgb = ((const LAS float*)(C.lds + PAR_OFF))[600 + dir * 4 + hd];
            const float f0 = -softplusf_(-(gf0 + fgb)), f1 = -softplusf_(-(gf1 + fgb));
            const float li0 = gi0 + igb, li1 = gi1 + igb;
            float i0, i1, tot; scan128(f0, f1, lane, i0, i1, tot);
            const float c0 = dir ? tot - i0 + f0 : i0, c1 = dir ? tot - i1 + f1 : i1;
            wv[dir * 128 + 2 * lane] = __expf(tot - c0 + li0); wv[dir * 128 + 2 * lane + 1] = __expf(tot - c1 + li1);
            if (lane == 0) ((float*)(C.ws + B_DECM))[((b * 64 + c) * 2 + dir) * 4 + hd] = __expf(tot);
        }
        tile_sstore<128, 128, 272>(tK, Kimg, tid); tile_sstore<128, 128, 272>(tV, Vimg, tid);
        if (iu + 1 < nu) { const int u2 = u + ustride; const int hd2 = u2 & 3, c2 = (u2 >> 2) & 63, b2 = u2 >> 8; const size_t tk2 = (size_t)b2 * SEQ + c2 * 128;
            tile_gload(tK, (const bf16*)(C.ws + B_MQKC) + tk2 * 1024 + 512 + hd2 * 128, 1024, tid); tile_gload(tV, (const bf16*)(C.ws + B_MV) + tk2 * 512 + hd2 * 128, 512, tid);
            if (w < 2) { const float* Gt = (const float*)(C.ws + WS_GATES);
                gf0 = Gt[(tk2 + 2 * lane) * NGATE + 40 + w * 4 + hd2]; gf1 = Gt[(tk2 + 2 * lane + 1) * NGATE + 40 + w * 4 + hd2]; gi0 = Gt[(tk2 + 2 * lane) * NGATE + 32 + w * 4 + hd2]; gi1 = Gt[(tk2 + 2 * lane + 1) * NGATE + 32 + w * 4 + hd2]; } }
        __syncthreads();
        const unsigned kimg = lds_addr(Kimg), vimg = lds_addr(Vimg);
        bf16* ST = (bf16*)(C.ws + B_STM); float* NM = (float*)(C.ws + B_NM);
#pragma unroll 1
        for (int d = 0; d < 2; ++d) {
            f32x4 acc[8]; f32x4 nac = (f32x4){0.f, 0.f, 0.f, 0.f};
#pragma unroll
            for (int kt = 0; kt < 8; ++kt) acc[kt] = (f32x4){0.f, 0.f, 0.f, 0.f};
#pragma unroll 1
            for (int ks = 0; ks < 4; ++ks) {
                const f32x4 w0 = *(const LAS f32x4*)(wv + d * 128 + 32 * ks + 8 * q), w1 = *(const LAS f32x4*)(wv + d * 128 + 32 * ks + 8 * q + 4);
                const bf16x8 vf = frag_tr(vimg, 272, 32 * ks, 16 * w, r, q);
                const bf16x8 kown = frag_tr(kimg, 272, 32 * ks, 16 * w, r, q);
                bf16x8 kfa[4], kfb[4]; frag_tr4<false, 272>(kimg, 32 * ks, 0, r, q, kfa); frag_tr4<false, 272>(kimg, 32 * ks, 64, r, q, kfb);
                float vv[8]; unpack8(vf, vv);
                float wl[8] = {w0.x, w0.y, w0.z, w0.w, w1.x, w1.y, w1.z, w1.w};
                float sv[8], wlo[8];
#pragma unroll
                for (int j = 0; j < 8; ++j) sv[j] = vv[j] * wl[j];
                const bf16x8 vs = pack8(sv), whi = pack8(wl);
                { float wh[8]; unpack8(whi, wh);
#pragma unroll
                  for (int j = 0; j < 8; ++j) wlo[j] = wl[j] - wh[j]; }
                const bf16x8 wlf = pack8(wlo);
#pragma unroll
                for (int kt = 0; kt < 8; ++kt) acc[kt] = MFMA16(kt < 4 ? kfa[kt & 3] : kfb[kt & 3], vs, acc[kt]);
                nac = MFMA16(kown, whi, nac); nac = MFMA16(kown, wlf, nac);
            }
            const size_t sb = (size_t)(((b * 64 + c) * 2 + d) * 4 + hd);
            LAS unsigned char* Oimg = C.lds + 71680;
#pragma unroll
            for (int kt = 0; kt < 8; ++kt) *(LAS u32x2*)(Oimg + (16 * w + r) * 272 + (16 * kt + 4 * q) * 2) = pack4(acc[kt]);
            if (r == 0) *(f32x4*)(NM + sb * 128 + 16 * w + 4 * q) = nac;
            __syncthreads();
#pragma unroll
            for (int i = 0; i < 4; ++i) { const int idx = tid + i * NTHR, row = idx >> 4, ch = idx & 15; *(u32x4*)(ST + (sb * 128 + row) * 128 + ch * 8) = *(const LAS u32x4*)(Oimg + row * 272 + ch * 16); }
            __syncthreads();
        }
    }
}
template <int MODE>
__device__ __forceinline__ float hg_gates(Ctx& C, int l, int hd, int dir, LAS float*  , LAS unsigned char* Kimg, LAS float* segtot) {
    const int k = C.tid & 127, seg = C.tid >> 7;
    const float oml = ((const LAS float*)(C.lds + PAR_OFF))[hd * 128 + k];
    __syncthreads();
    float key[16], P[16]; float run = 1.f;
#pragma unroll
    for (int i = 0; i < 16; ++i) {
        const int t = dir ? (seg * 16 + 15 - i) : (seg * 16 + i);
        key[i] = oml * sigmoidf_(-bf2f(*(const LAS bf16*)(Kimg + t * 272 + k * 2)));
        run *= 1.0f - key[i]; P[i] = run;
    }
    segtot[seg * 128 + k] = run;
    __syncthreads();
    float rest = 1.f, tot = 1.f;
#pragma unroll
    for (int s2 = 0; s2 < 4; ++s2) { const float v = segtot[s2 * 128 + k]; tot *= v; if (dir ? (s2 < seg) : (s2 > seg)) rest *= v; }
    const float R = run * rest;
#pragma unroll
    for (int i = 0; i < 16; ++i) {
        const int t = dir ? (seg * 16 + 15 - i) : (seg * 16 + i);
        *(LAS bf16*)(Kimg + t * 272 + k * 2) = (bf16)f2bf(key[i] * R * __builtin_amdgcn_rcpf(fmaxf(P[i], 1e-30f)));
    }
    __syncthreads();
    return tot;
}
__device__ __forceinline__ void hgC_seq(Ctx& C0_, int l, int u0, int nu, int ustride) { UNIT_PROLOG();
    const int tid = C.tid, lane = C.lane, w = C.wave, r = lane & 15, q = lane >> 4;
    LAS float* Gimg = (LAS float*)C.lds; LAS unsigned char* Kimg = C.lds + 33792; LAS unsigned char* Vimg = C.lds + 51200; LAS float* segtot = (LAS float*)(C.lds + 68608);
    const unsigned kimg = lds_addr(Kimg), vimg = lds_addr(Vimg);
    bf16* ST = (bf16*)(C.ws + B_STH); float* DH = (float*)(C.ws + B_DECH);
    TileRegs<64, 128> tV, tF0, tF1;
    { const int hd = u0 & 3, c = (u0 >> 2) & 127, b = u0 >> 9; const size_t tok0 = (size_t)b * SEQ + c * 64;
      tile_gload(tV, (const bf16*)(C.ws + B_HI) + tok0 * 512 + hd * 128, 512, tid);
      tile_gload(tF0, (const bf16*)(C.ws + B_HFR) + tok0 * 1024 + hd * 128, 1024, tid); tile_gload(tF1, (const bf16*)(C.ws + B_HFR) + tok0 * 1024 + 512 + hd * 128, 1024, tid); }
#pragma unroll 1
    for (int iu = 0; iu < nu; ++iu) {
        const int u = u0 + iu * ustride;
        const int hd = u & 3, c = (u >> 2) & 127, b = u >> 9;
        tile_sstore<64, 128, 272>(tV, Vimg, tid);
#pragma unroll
        for (int d = 0; d < 2; ++d) {
            tile_sstore<64, 128, 272>(d ? tF1 : tF0, Kimg, tid);
            if (d == 1 && iu + 1 < nu) {
                const int u2 = u + ustride; const int hd2 = u2 & 3, c2 = (u2 >> 2) & 127, b2 = u2 >> 9; const size_t tk2 = (size_t)b2 * SEQ + c2 * 64;
                tile_gload(tV, (const bf16*)(C.ws + B_HI) + tk2 * 512 + hd2 * 128, 512, tid);
                tile_gload(tF0, (const bf16*)(C.ws + B_HFR) + tk2 * 1024 + hd2 * 128, 1024, tid); tile_gload(tF1, (const bf16*)(C.ws + B_HFR) + tk2 * 1024 + 512 + hd2 * 128, 1024, tid);
            }
            const float dec = hg_gates<1>(C, l, hd, d, Gimg, Kimg, segtot);
            const size_t sb = (size_t)(((b * 128 + c) * 2 + d) * 4 + hd);
            if (tid < 128) DH[sb * 128 + tid] = dec;
            f32x4 acc[8];
#pragma unroll
            for (int kt = 0; kt < 8; ++kt) acc[kt] = (f32x4){0.f, 0.f, 0.f, 0.f};
#pragma unroll
            for (int ks = 0; ks < 2; ++ks) {
                const bf16x8 vf = frag_tr(vimg, 272, 32 * ks, 16 * w, r, q);
                bf16x8 kfa[4], kfb[4]; frag_tr4<false, 272>(kimg, 32 * ks, 0, r, q, kfa); frag_tr4<false, 272>(kimg, 32 * ks, 64, r, q, kfb);
#pragma unroll
                for (int kt = 0; kt < 8; ++kt) acc[kt] = MFMA16(kt < 4 ? kfa[kt & 3] : kfb[kt & 3], vf, acc[kt]);
            }
            LAS unsigned char* Oimg = C.lds + 71680;
#pragma unroll
            for (int kt = 0; kt < 8; ++kt) *(LAS u32x2*)(Oimg + (16 * w + r) * 272 + (16 * kt + 4 * q) * 2) = pack4(acc[kt]);
            __syncthreads();
#pragma unroll
            for (int i = 0; i < 4; ++i) { const int idx = tid + i * NTHR, row = idx >> 4, ch = idx & 15; *(u32x4*)(ST + (sb * 128 + row) * 128 + ch * 8) = *(const LAS u32x4*)(Oimg + row * 272 + ch * 16); }
            __syncthreads();
        }
    }
}
__device__ __forceinline__ void deal_range(int blk, int G, int lo, int hi, int& first, int& cnt) {
    int j0 = (lo > blk) ? (lo - blk + G - 1) / G : 0; const int u0 = blk + j0 * G;
    if (u0 >= hi) { first = 0; cnt = 0; return; }
    first = u0 - lo; cnt = (hi - 1 - u0) / G + 1;
}
__device__ __forceinline__ void mixC_phase(Ctx& C, int l) {
    int f, n;
    mix_params(C, l, false);
    if (FAST_SSD) { deal_range(C.blk, C.G, 0, 512, f, n); if (n) ssdC_seq(C, l, f, n, C.G); }
    if (FAST_ML) { deal_range(C.blk, C.G, 512, 1024, f, n); if (n) mlC_seq(C, l, f, n, C.G); }
    if (FAST_HG) { deal_range(C.blk, C.G, 1024, 2048, f, n); if (n) hgC_seq(C, l, f, n, C.G); }
}

template <int NCH, int DECMODE  >
__device__ __forceinline__ void scan_items(bf16* ST, const float* DEC, size_t base, size_t cstride, size_t dbase, size_t dstride, int dir) {
    constexpr int PF = (DECMODE == 0) ? 16 : 8;
    float run[8];
#pragma unroll
    for (int j = 0; j < 8; ++j) run[j] = 0.f;
    u32x4 Lb[PF]; f32x4 Da[PF], Db[PF]; float Ds[PF];
#pragma unroll
    for (int j = 0; j < PF; ++j) { const int c = dir ? NCH - 1 - j : j; Lb[j] = *(const u32x4*)(ST + base + c * cstride);
        if (DECMODE == 0) Ds[j] = DEC[dbase + c * dstride]; else { Da[j] = *(const f32x4*)(DEC + dbase + c * dstride); Db[j] = *(const f32x4*)(DEC + dbase + c * dstride + 4); } }
#pragma unroll 1
    for (int st = 0; st < NCH; st += PF) {
#pragma unroll
        for (int j = 0; j < PF; ++j) {
            const int c = dir ? NCH - 1 - (st + j) : st + j;
            u32x4 o; o.x = pk2(run[0], run[1]); o.y = pk2(run[2], run[3]); o.z = pk2(run[4], run[5]); o.w = pk2(run[6], run[7]);
            const u32x4 L = Lb[j]; f32x4 da, db; float d = 0.f;
            if (DECMODE == 0) d = Ds[j]; else { da = Da[j]; db = Db[j]; }
            if (st + j + PF < NCH) { const int c2 = dir ? NCH - 1 - (st + j + PF) : st + j + PF; Lb[j] = *(const u32x4*)(ST + base + c2 * cstride);
                if (DECMODE == 0) Ds[j] = DEC[dbase + c2 * dstride]; else { Da[j] = *(const f32x4*)(DEC + dbase + c2 * dstride); Db[j] = *(const f32x4*)(DEC + dbase + c2 * dstride + 4); } }
            *(u32x4*)(ST + base + c * cstride) = o;
            if (DECMODE == 0) {
                run[0] = run[0] * d + bflo(L.x); run[1] = run[1] * d + bfhi(L.x); run[2] = run[2] * d + bflo(L.y); run[3] = run[3] * d + bfhi(L.y);
                run[4] = run[4] * d + bflo(L.z); run[5] = run[5] * d + bfhi(L.z); run[6] = run[6] * d + bflo(L.w); run[7] = run[7] * d + bfhi(L.w);
            } else {
                run[0] = run[0] * da.x + bflo(L.x); run[1] = run[1] * da.y + bfhi(L.x); run[2] = run[2] * da.z + bflo(L.y); run[3] = run[3] * da.w + bfhi(L.y);
                run[4] = run[4] * db.x + bflo(L.z); run[5] = run[5] * db.y + bfhi(L.z); run[6] = run[6] * db.z + bflo(L.w); run[7] = run[7] * db.w + bfhi(L.w);
            }
        }
    }
}
template <int NCH, int PF>
__device__ __forceinline__ void scan_items_lds(bf16* ST, LAS const float* dl, size_t base, size_t cstride, int dir) {
    float run[8];
#pragma unroll
    for (int j = 0; j < 8; ++j) run[j] = 0.f;
    u32x4 Lb[PF];
#pragma unroll
    for (int j = 0; j < PF; ++j) { const int c = dir ? NCH - 1 - j : j; Lb[j] = *(const u32x4*)(ST + base + c * cstride); }
#pragma unroll 1
    for (int st = 0; st < NCH; st += PF) {
#pragma unroll
        for (int j = 0; j < PF; ++j) {
            const int c = dir ? NCH - 1 - (st + j) : st + j;
            u32x4 o; o.x = pk2(run[0], run[1]); o.y = pk2(run[2], run[3]); o.z = pk2(run[4], run[5]); o.w = pk2(run[6], run[7]);
            const u32x4 L = Lb[j];
            const f32x4 da = *(LAS const f32x4*)(dl + c * 128), db = *(LAS const f32x4*)(dl + c * 128 + 4);
            if (st + j + PF < NCH) { const int c2 = dir ? NCH - 1 - (st + j + PF) : st + j + PF; Lb[j] = *(const u32x4*)(ST + base + c2 * cstride); }
            *(u32x4*)(ST + base + c * cstride) = o;
            run[0] = run[0] * da.x + bflo(L.x); run[1] = run[1] * da.y + bfhi(L.x); run[2] = run[2] * da.z + bflo(L.y); run[3] = run[3] * da.w + bfhi(L.y);
            run[4] = run[4] * db.x + bflo(L.z); run[5] = run[5] * db.y + bfhi(L.z); run[6] = run[6] * db.z + bflo(L.w); run[7] = run[7] * db.w + bfhi(L.w);
        }
    }
}
__device__ __forceinline__ void scan_phase(Ctx& C) {
    for (int vb = C.blk; vb < 256; vb += C.G) {
        const int t = C.tid;
        if (FAST_HG) {
            const int seq = vb >> 4, b = seq >> 3, dir = (seq >> 2) & 1, hd = seq & 3; const float* DH = (const float*)(C.ws + B_DECH);
#pragma unroll
            for (int i = 0; i < 8; ++i) { const int idx = t + i * NTHR, c = idx >> 5, k4 = idx & 31; *(LAS f32x4*)((LAS float*)C.lds + c * 128 + k4 * 4) = *(const f32x4*)(DH + ((size_t)((b * 128 + c) * 2 + dir) * 4 + hd) * 128 + k4 * 4); }
            __syncthreads();
        }
        if (t < 256) {
            if (FAST_SSD) { const int it = vb * 256 + t, seq = it >> 10, e8 = it & 1023, b = seq >> 5, dir = (seq >> 4) & 1, h = seq & 15;
                scan_items<64, 0>((bf16*)(C.ws + B_STS), (const float*)(C.ws + B_DECS), ((size_t)(b * 64 * 2 + dir) * 16 + h) * 8192 + e8 * 8, (size_t)2 * 16 * 8192, (size_t)(b * 64 * 2 + dir) * 16 + h, 32, dir); }
        } else if (t < 384) {
            if (FAST_ML) { const int i2 = vb * 128 + (t - 256), seq = i2 >> 11, e8 = i2 & 2047, b = seq >> 3, dir = (seq >> 2) & 1, hd = seq & 3;
                scan_items<64, 0>((bf16*)(C.ws + B_STM), (const float*)(C.ws + B_DECM), ((size_t)(b * 64 * 2 + dir) * 4 + hd) * 16384 + e8 * 8, (size_t)2 * 4 * 16384, (size_t)(b * 64 * 2 + dir) * 4 + hd, 8, dir);
                if (vb < 16) {
                    const int i3 = vb * 128 + (t - 256), seq2 = i3 >> 7, k = i3 & 127, b2 = seq2 >> 3, dir2 = (seq2 >> 2) & 1, hd2 = seq2 & 3;
                    float* NM = (float*)(C.ws + B_NM); const float* DM = (const float*)(C.ws + B_DECM); float run = 0.f;
#pragma unroll 1
                    for (int s0 = 0; s0 < 64; s0 += 32) {
                        float lv[32], dd[32];
#pragma unroll
                        for (int j = 0; j < 32; ++j) { const int c = dir2 ? 63 - (s0 + j) : s0 + j; const size_t sb = (size_t)((b2 * 64 + c) * 2 + dir2) * 4 + hd2; lv[j] = NM[sb * 128 + k]; dd[j] = DM[sb]; }
#pragma unroll
                        for (int j = 0; j < 32; ++j) { const int c = dir2 ? 63 - (s0 + j) : s0 + j; const size_t sb = (size_t)((b2 * 64 + c) * 2 + dir2) * 4 + hd2; NM[sb * 128 + k] = run; run = run * dd[j] + lv[j]; }
                    }
                } }
        } else {
            if (FAST_HG) { const int i2 = vb * 128 + (t - 384), seq = i2 >> 11, e8 = i2 & 2047, b = seq >> 3, dir = (seq >> 2) & 1, hd = seq & 3;
                scan_items_lds<128, 32>((bf16*)(C.ws + B_STH), (LAS const float*)C.lds + ((e8 * 8) & 127), ((size_t)(b * 128 * 2 + dir) * 4 + hd) * 16384 + e8 * 8, (size_t)2 * 4 * 16384, dir); }
        }
        __syncthreads();
    }
}

__device__ __forceinline__ void decay_tables(float c0, float c1, int dir, int lane, LAS float* av, LAS float* VV, LAS float* WW, float& loc0, float& loc1) {
    const int I = lane >> 3;
    const float rsrc = dir ? __shfl(c0, (8 * (I + 1)) & 63) : __shfl(c1, (8 * I - 1) & 63);
    const float refI = dir ? (I < 7 ? rsrc : 0.f) : (I > 0 ? rsrc : 0.f);
    loc0 = c0 - refI; loc1 = c1 - refI;
    av[2 * lane] = __expf(loc0); av[2 * lane + 1] = __expf(loc1);
    {
        const int I2 = lane >> 3, J2 = lane & 7;
        const float ra = dir ? __shfl(c0, (8 * (I2 + 1)) & 63) : __shfl(c1, (8 * I2 - 1) & 63), rb = dir ? __shfl(c0, (8 * (J2 + 1)) & 63) : __shfl(c1, (8 * J2 - 1) & 63);
        const float rI = dir ? (I2 < 7 ? ra : 0.f) : (I2 > 0 ? ra : 0.f), rJ = dir ? (J2 < 7 ? rb : 0.f) : (J2 > 0 ? rb : 0.f);
        VV[lane] = __expf(fminf(rI - rJ, 0.f));
        if (J2 == 0) WW[I2] = __expf(rI);
    }
}
__device__ __forceinline__ void ssdE_unit(Ctx& C0_, int l, int u) { UNIT_PROLOG();
    const int g = u & 1, c = (u >> 1) & 63, b = u >> 7;
    const int tid = C.tid, lane = C.lane, w = C.wave, r = lane & 15, q = lane >> 4;
    const size_t tok0 = (size_t)b * SEQ + c * 128;
    LAS unsigned char* Cimg = C.lds; LAS unsigned char* Bimg = C.lds + 34816; LAS unsigned char* Ximg = C.lds + 34816; LAS unsigned char* S0 = C.lds + 69632;
    LAS float* av = (LAS float*)(C.lds + 104448); LAS float* bv = (LAS float*)(C.lds + 112640);
    LAS float* VV = (LAS float*)(C.lds + 120832); LAS float* WW = (LAS float*)(C.lds + 124928);
    const bf16* XC = (const bf16*)(C.ws + B_XBCC);
    TileRegs<128, 128> tB, tC; tile_gload(tB, XC + tok0 * 1536 + 1024 + g * 128, 1536, tid); tile_gload(tC, XC + tok0 * 1536 + 1280 + g * 128, 1536, tid);
    {
        const int h = g * 8 + w; const float* Gt = (const float*)(C.ws + WS_GATES);
#pragma unroll
        for (int dir = 0; dir < 2; ++dir) {
            const float dtb = ((const LAS float*)(C.lds + PAR_OFF))[512 + dir * 16 + h], Aneg = ((const LAS float*)(C.lds + PAR_OFF))[544 + dir * 16 + h];
            const float d0 = softplusf_(Gt[(tok0 + 2 * lane) * NGATE + dir * 16 + h] + dtb), d1 = softplusf_(Gt[(tok0 + 2 * lane + 1) * NGATE + dir * 16 + h] + dtb);
            const float a0 = d0 * Aneg, a1 = d1 * Aneg; float i0, i1, tot; scan128(a0, a1, lane, i0, i1, tot);
            const float c0 = dir ? tot - i0 + a0 : i0, c1 = dir ? tot - i1 + a1 : i1;
            const int hd = w * 2 + dir; float l0, l1;
            decay_tables(c0, c1, dir, lane, av + hd * 128, VV + hd * 64, WW + hd * 8, l0, l1);
            bv[hd * 128 + 2 * lane] = __expf(fminf(-l0, 80.f)) * d0; bv[hd * 128 + 2 * lane + 1] = __expf(fminf(-l1, 80.f)) * d1;
        }
    }
    tile_sstore<128, 128, 272>(tB, Bimg, tid); tile_sstore<128, 128, 272>(tC, Cimg, tid);
    __syncthreads();
    const bf16* STS = (const bf16*)(C.ws + B_STS);
    TileRegs<128, 64> tX; TileRegs<64, 128> tS0, tS1;
    tile_gload(tX, XC + tok0 * 1536 + (g * 8) * 64, 1536, tid);
    tile_gload(tS0, STS + (size_t)(((b * 64 + c) * 2 + 0) * 16 + g * 8) * 8192, 128, tid); tile_gload(tS1, STS + (size_t)(((b * 64 + c) * 2 + 1) * 16 + g * 8) * 8192, 128, tid);
    f32x4 cbT[8]; bf16x8 cfr[4];
#pragma unroll
    for (int ks = 0; ks < 4; ++ks) cfr[ks] = frag_row(Cimg, 272, 16 * w + r, 32 * ks + 8 * q);
#pragma unroll
    for (int st = 0; st < 8; ++st) { cbT[st] = (f32x4){0.f, 0.f, 0.f, 0.f};
#pragma unroll
        for (int ks = 0; ks < 4; ++ks) cbT[st] = MFMA16(frag_row(Bimg, 272, 16 * st + r, 32 * ks + 8 * q), cfr[ks], cbT[st]); }
    __syncthreads();
    const unsigned ximg = lds_addr(Ximg);
    const int lrow = 16 * w + r; const size_t tok = tok0 + lrow;
    bf16* MIX = (bf16*)(C.ws + B_MIX); const bf16* Z = (const bf16*)(C.ws + B_Z);
    float ssq = 0.f;
#pragma unroll 1
    for (int hh = 0; hh < 8; ++hh) {
        const int h = g * 8 + hh;
        tile_sstore<128, 64, 144>(tX, Ximg, tid); tile_sstore<64, 128, 272>(tS0, S0, tid); tile_sstore<64, 128, 272>(tS1, S0 + 17408, tid);
        if (hh < 7) {
            tile_gload(tX, XC + tok0 * 1536 + (h + 1) * 64, 1536, tid);
            tile_gload(tS0, STS + (size_t)(((b * 64 + c) * 2 + 0) * 16 + h + 1) * 8192, 128, tid); tile_gload(tS1, STS + (size_t)(((b * 64 + c) * 2 + 1) * 16 + h + 1) * 8192, 128, tid);
        }
        u32x2 zw4[4];
#pragma unroll
        for (int pt = 0; pt < 4; ++pt) zw4[pt] = *(const u32x2*)(Z + tok * 1024 + h * 64 + 16 * pt + 4 * q);
        const float dk = ((const LAS float*)(C.lds + PAR_OFF))[576 + h];
        __syncthreads();
        f32x4 y[4];
#pragma unroll
        for (int pt = 0; pt < 4; ++pt) y[pt] = (f32x4){0.f, 0.f, 0.f, 0.f};
        const float al0 = av[(hh * 2 + 0) * 128 + lrow], al1 = av[(hh * 2 + 1) * 128 + lrow];
#pragma unroll
        for (int ks = 0; ks < 4; ++ks) {
            bf16x8 xf[4]; frag_tr4<true, 144>(ximg, 32 * ks, 0, r, q, xf);
#pragma unroll
            for (int dir = 0; dir < 2; ++dir) {
                const bool active = dir ? (32 * ks + 31 >= 16 * w) : (32 * ks <= 16 * w + 15);
                if (active) {
                    const int hd = hh * 2 + dir;
                    const f32x4 ba = *(const LAS f32x4*)(bv + hd * 128 + 32 * ks + 4 * q), bb = *(const LAS f32x4*)(bv + hd * 128 + 32 * ks + 16 + 4 * q);
                    const float al = dir ? al1 : al0; const float va = al * VV[hd * 64 + w * 8 + 2 * ks], vb = al * VV[hd * 64 + w * 8 + 2 * ks + 1];
                    float m[8];
#pragma unroll
                    for (int j = 0; j < 8; ++j) {
                        const int s2 = 32 * ks + 16 * (j >> 2) + 4 * q + (j & 3);
                        const bool keep = dir ? (s2 >= lrow) : (s2 <= lrow);
                        m[j] = keep ? cbT[2 * ks + (j >> 2)][j & 3] * ((j < 4) ? va * ba[j & 3] : vb * bb[j & 3]) : 0.f;
                    }
                    const bf16x8 mf = pack8(m);
#pragma unroll
                    for (int pt = 0; pt < 4; ++pt) y[pt] = MFMA16(xf[pt], mf, y[pt]);
                }
            }
        }
#pragma unroll
        for (int dir = 0; dir < 2; ++dir) {
            f32x4 yo[4];
#pragma unroll
            for (int pt = 0; pt < 4; ++pt) yo[pt] = (f32x4){0.f, 0.f, 0.f, 0.f};
#pragma unroll
            for (int ks = 0; ks < 4; ++ks)
#pragma unroll
                for (int pt = 0; pt < 4; ++pt) yo[pt] = MFMA16(frag_row(S0 + dir * 17408, 272, 16 * pt + r, 32 * ks + 8 * q), cfr[ks], yo[pt]);
            const float e = (dir ? al1 : al0) * WW[(hh * 2 + dir) * 8 + w];
#pragma unroll
            for (int pt = 0; pt < 4; ++pt) y[pt] += yo[pt] * e;
        }
#pragma unroll
        for (int pt = 0; pt < 4; ++pt) {
            const u32x2 xw = *(const LAS u32x2*)(Ximg + lrow * 144 + (16 * pt + 4 * q) * 2);
            const u32x2 zw = zw4[pt];
            f32x4 v;
            v[0] = (y[pt][0] + bflo(xw.x) * dk) * siluf_(bflo(zw.x)); v[1] = (y[pt][1] + bfhi(xw.x) * dk) * siluf_(bfhi(zw.x));
            v[2] = (y[pt][2] + bflo(xw.y) * dk) * siluf_(bflo(zw.y)); v[3] = (y[pt][3] + bfhi(xw.y) * dk) * siluf_(bfhi(zw.y));
            ssq += (v[0] * v[0] + v[1] * v[1]) + (v[2] * v[2] + v[3] * v[3]);
            *(u32x2*)(MIX + tok * 2048 + h * 64 + 16 * pt + 4 * q) = pack4(v);
        }
        __syncthreads();
    }
    ssq += __shfl_xor(ssq, 16); ssq += __shfl_xor(ssq, 32);
    const float rs = 1.0f / sqrtf(ssq * (1.f / 512.f) + RMS_EPS);
    const LAS float* nw = (const LAS float*)(C.lds + PAR_OFF) + 640 + g * 512;
#pragma unroll 1
    for (int i0 = 0; i0 < 32; i0 += 16) {
        u32x2 vw[16]; f32x4 nv[16];
#pragma unroll
        for (int i = 0; i < 16; ++i) { vw[i] = *(const u32x2*)(MIX + tok * 2048 + g * 512 + (i0 + i) * 16 + 4 * q); nv[i] = *(const LAS f32x4*)(nw + (i0 + i) * 16 + 4 * q); }
#pragma unroll
        for (int i = 0; i < 16; ++i) {
            f32x4 v; v[0] = bflo(vw[i].x) * rs * nv[i][0]; v[1] = bfhi(vw[i].x) * rs * nv[i][1]; v[2] = bflo(vw[i].y) * rs * nv[i][2]; v[3] = bfhi(vw[i].y) * rs * nv[i][3];
            *(u32x2*)(MIX + tok * 2048 + g * 512 + (i0 + i) * 16 + 4 * q) = pack4(v);
        }
    }
}
__device__ __forceinline__ void mlE_unit(Ctx& C0_, int l, int u) { UNIT_PROLOG();
    const int hd = u & 3, c = (u >> 2) & 63, b = u >> 8;
    const int tid = C.tid, lane = C.lane, w = C.wave, r = lane & 15, q = lane >> 4;
    const size_t tok0 = (size_t)b * SEQ + c * 128;
    LAS unsigned char* Qimg = C.lds; LAS unsigned char* Kimg = C.lds + 34816; LAS unsigned char* Vimg = C.lds + 69632;
    LAS float* cum = (LAS float*)(C.lds + 104448); LAS float* liv = (LAS float*)(C.lds + 105472); LAS float* nent = (LAS float*)(C.lds + 106496);
    const size_t sb0 = (size_t)(((b * 64 + c) * 2 + 0) * 4 + hd), sb1 = (size_t)(((b * 64 + c) * 2 + 1) * 4 + hd);
    TileRegs<128, 128> tS0, tS1;
    { TileRegs<128, 128> tQ, tK, tV;
      tile_gload(tQ, (const bf16*)(C.ws + B_MQKC) + tok0 * 1024 + hd * 128, 1024, tid); tile_gload(tK, (const bf16*)(C.ws + B_MQKC) + tok0 * 1024 + 512 + hd * 128, 1024, tid);
      tile_gload(tV, (const bf16*)(C.ws + B_MV) + tok0 * 512 + hd * 128, 512, tid);
      tile_gload(tS0, (const bf16*)(C.ws + B_STM) + sb0 * 16384, 128, tid); tile_gload(tS1, (const bf16*)(C.ws + B_STM) + sb1 * 16384, 128, tid);
      float gf0 = 0.f, gf1 = 0.f, gi0 = 0.f, gi1 = 0.f;
      if (w < 2) { const float* Gt = (const float*)(C.ws + WS_GATES);
          gf0 = Gt[(tok0 + 2 * lane) * NGATE + 40 + w * 4 + hd]; gf1 = Gt[(tok0 + 2 * lane + 1) * NGATE + 40 + w * 4 + hd]; gi0 = Gt[(tok0 + 2 * lane) * NGATE + 32 + w * 4 + hd]; gi1 = Gt[(tok0 + 2 * lane + 1) * NGATE + 32 + w * 4 + hd]; }
      tile_sstore<128, 128, 272>(tQ, Qimg, tid); tile_sstore<128, 128, 272>(tK, Kimg, tid); tile_sstore<128, 128, 272>(tV, Vimg, tid);
      if (w < 2) {
        const int dir = w; const float igb = ((const LAS float*)(C.lds + PAR_OFF))[592 + dir * 4 + hd], fgb = ((const LAS float*)(C.lds + PAR_OFF))[600 + dir * 4 + hd];
        const float f0 = -softplusf_(-(gf0 + fgb)), f1 = -softplusf_(-(gf1 + fgb));
        float i0, i1, tot; scan128(f0, f1, lane, i0, i1, tot);
        cum[dir * 128 + 2 * lane] = dir ? tot - i0 + f0 : i0; cum[dir * 128 + 2 * lane + 1] = dir ? tot - i1 + f1 : i1;
        liv[dir * 128 + 2 * lane] = gi0 + igb; liv[dir * 128 + 2 * lane + 1] = gi1 + igb;
      } }
    __syncthreads();
    const float SC = 0.08838834764831845f;
    f32x4 sT[8]; bf16x8 qfr[4];
#pragma unroll
    for (int ks = 0; ks < 4; ++ks) qfr[ks] = frag_row(Qimg, 272, 16 * w + r, 32 * ks + 8 * q);
#pragma unroll
    for (int st = 0; st < 8; ++st) { sT[st] = (f32x4){0.f, 0.f, 0.f, 0.f};
#pragma unroll
        for (int ks = 0; ks < 4; ++ks) sT[st] = MFMA16(frag_row(Kimg, 272, 16 * st + r, 32 * ks + 8 * q), qfr[ks], sT[st]);
        sT[st] *= SC; }
    __syncthreads();
    const unsigned vimg = lds_addr(Vimg);
    const int lrow = 16 * w + r; const size_t tok = tok0 + lrow;
    {
        tile_sstore<128, 128, 272>(tS0, Kimg, tid); tile_sstore<128, 128, 272>(tS1, Qimg, tid);
        if (tid < 256) nent[tid] = ((const float*)(C.ws + B_NM))[(tid < 128 ? sb0 : sb1) * 128 + (tid & 127)];
    }
    __syncthreads();
    const float cl0 = cum[lrow], cl1 = cum[128 + lrow];
    u32x2 ow8[8];
    { const bf16* MOp = (const bf16*)(C.ws + B_MO) + tok * 512 + hd * 128;
#pragma unroll
      for (int vt = 0; vt < 8; ++vt) ow8[vt] = *(const u32x2*)(MOp + 16 * vt + 4 * q); }
    f32x4 num[2][8]; float denp0 = 0.f, denp1 = 0.f;
#pragma unroll
    for (int d = 0; d < 2; ++d)
#pragma unroll
        for (int vt = 0; vt < 8; ++vt) num[d][vt] = (f32x4){0.f, 0.f, 0.f, 0.f};
#pragma unroll
    for (int ks = 0; ks < 4; ++ks) {
        const bool act0 = (32 * ks <= 16 * w + 15), act1 = (32 * ks + 31 >= 16 * w);
        bf16x8 mf0, mf1;
#pragma unroll
        for (int dir = 0; dir < 2; ++dir) {
            float m[8]; float ds = 0.f;
            if (dir ? act1 : act0) {
                const LAS float* cm = cum + dir * 128; const LAS float* lv = liv + dir * 128; const float cl = dir ? cl1 : cl0;
                const f32x4 ca = *(const LAS f32x4*)(cm + 32 * ks + 4 * q), cb = *(const LAS f32x4*)(cm + 32 * ks + 16 + 4 * q);
                const f32x4 la = *(const LAS f32x4*)(lv + 32 * ks + 4 * q), lb = *(const LAS f32x4*)(lv + 32 * ks + 16 + 4 * q);
#pragma unroll
                for (int j = 0; j < 8; ++j) {
                    const int s2 = 32 * ks + 16 * (j >> 2) + 4 * q + (j & 3);
                    const float cs = (j < 4) ? ca[j & 3] : cb[j & 3], ls = (j < 4) ? la[j & 3] : lb[j & 3];
                    const bool keep = dir ? (s2 >= lrow) : (s2 <= lrow);
                    m[j] = keep ? sT[2 * ks + (j >> 2)][j & 3] * __expf(cl - cs + ls) : 0.f; ds += m[j];
                }
            } else {
#pragma unroll
                for (int j = 0; j < 8; ++j) m[j] = 0.f;
            }
            if (dir) { denp1 += ds; mf1 = pack8(m); } else { denp0 += ds; mf0 = pack8(m); }
        }
#pragma unroll
        for (int half = 0; half < 2; ++half) {
            bf16x8 vf[4]; frag_tr4<true, 272>(vimg, 32 * ks, 64 * half, r, q, vf);
            if (act0) {
#pragma unroll
                for (int vt = 0; vt < 4; ++vt) num[0][4 * half + vt] = MFMA16(vf[vt], mf0, num[0][4 * half + vt]);
            }
            if (act1) {
#pragma unroll
                for (int vt = 0; vt < 4; ++vt) num[1][4 * half + vt] = MFMA16(vf[vt], mf1, num[1][4 * half + vt]);
            }
        }
        asm volatile("" ::: "memory");
    }
    float inv0 = 0.f, inv1 = 0.f;
#pragma unroll
    for (int dir = 0; dir < 2; ++dir) {
        const LAS unsigned char* Simg = dir ? Qimg : Kimg; const float e = __expf(dir ? cl1 : cl0) * SC;
        float qn = 0.f;
#pragma unroll
        for (int ks = 0; ks < 4; ++ks) {
            asm volatile("" ::: "memory");
            float qv[8]; unpack8(qfr[ks], qv);
            const f32x4 n0 = *(const LAS f32x4*)(nent + dir * 128 + 32 * ks + 8 * q), n1 = *(const LAS f32x4*)(nent + dir * 128 + 32 * ks + 8 * q + 4);
            qn += (qv[0] * n0.x + qv[1] * n0.y + qv[2] * n0.z + qv[3] * n0.w) + (qv[4] * n1.x + qv[5] * n1.y + qv[6] * n1.z + qv[7] * n1.w);
#pragma unroll
            for (int j = 0; j < 8; ++j) qv[j] *= e;
            const bf16x8 qe = pack8(qv);
#pragma unroll
            for (int vt = 0; vt < 8; ++vt) num[dir][vt] = MFMA16(frag_row(Simg, 272, 16 * vt + r, 32 * ks + 8 * q), qe, num[dir][vt]);
        }
        float denp = dir ? denp1 : denp0;
        denp += __shfl_xor(denp, 16); denp += __shfl_xor(denp, 32); qn += __shfl_xor(qn, 16); qn += __shfl_xor(qn, 32);
        const float den = denp + e * qn; const float inv = 1.0f / fmaxf(fabsf(den), 1.0f);
        if (dir) inv1 = inv; else inv0 = inv;
    }
    f32x4 hs[8];
#pragma unroll
    for (int vt = 0; vt < 8; ++vt) hs[vt] = num[0][vt] * inv0 + num[1][vt] * inv1;
    float s1 = 0.f;
#pragma unroll
    for (int vt = 0; vt < 8; ++vt) s1 += (hs[vt][0] + hs[vt][1]) + (hs[vt][2] + hs[vt][3]);
    s1 += __shfl_xor(s1, 16); s1 += __shfl_xor(s1, 32);
    const float mean = s1 * (1.f / 128.f); float s2 = 0.f;
#pragma unroll
    for (int vt = 0; vt < 8; ++vt) { hs[vt] -= mean; s2 += (hs[vt][0] * hs[vt][0] + hs[vt][1] * hs[vt][1]) + (hs[vt][2] * hs[vt][2] + hs[vt][3] * hs[vt][3]); }
    s2 += __shfl_xor(s2, 16); s2 += __shfl_xor(s2, 32);
    const float rs = 1.0f / sqrtf(s2 * (1.f / 128.f) + LN_EPS);
    const LAS float* nw = (const LAS float*)(C.lds + PAR_OFF) + 2176 + hd * 128; bf16* MIX = (bf16*)(C.ws + B_MIX) + tok * 2048 + 1536 + hd * 128;
#pragma unroll
    for (int vt = 0; vt < 8; ++vt) {
        const int v0 = 16 * vt + 4 * q; const f32x4 nv = *(const LAS f32x4*)(nw + v0); const u32x2 ow = ow8[vt];
        f32x4 o; o[0] = hs[vt][0] * rs * nv[0] * sigmoidf_(bflo(ow.x)); o[1] = hs[vt][1] * rs * nv[1] * sigmoidf_(bfhi(ow.x)); o[2] = hs[vt][2] * rs * nv[2] * sigmoidf_(bflo(ow.y)); o[3] = hs[vt][3] * rs * nv[3] * sigmoidf_(bfhi(ow.y));
        *(u32x2*)(MIX + v0) = pack4(o);
    }
    __syncthreads();
}
__device__ __forceinline__ void hg_gates_e(Ctx& C, int l, int hd, int dir, const LAS unsigned char* Qimg, LAS unsigned char* QLimg, LAS unsigned char* Kimg, LAS float* segtot, LAS float* VV) {
    const int k = C.tid & 127, seg = C.tid >> 7;
    const float oml = ((const LAS float*)(C.lds + PAR_OFF))[hd * 128 + k];
    __syncthreads();
    float run = 1.f;
#pragma unroll
    for (int i = 0; i < 16; ++i) {
        const int t = dir ? (seg * 16 + 15 - i) : (seg * 16 + i);
        const float key = oml * sigmoidf_(-bf2f(*(const LAS bf16*)(Kimg + t * 272 + k * 2)));
        run *= 1.0f - key;
        const float qv = bf2f(*(const LAS bf16*)(Qimg + t * 272 + k * 2));
        *(LAS bf16*)(Kimg + t * 272 + k * 2) = (bf16)f2bf(key * __builtin_amdgcn_rcpf(fmaxf(run, 1e-30f)));
        *(LAS bf16*)(QLimg + t * 272 + k * 2) = (bf16)f2bf(qv * run);
    }
    segtot[seg * 128 + k] = run;
    __syncthreads();
    {
        float acc = 1.f;
        if (dir == 0) { for (int J = seg - 1; J >= 0; --J) { acc *= segtot[J * 128 + k]; VV[(seg * 4 + J) * 128 + k] = acc; } }
        else { for (int J = seg + 1; J < 4; ++J) { acc *= segtot[J * 128 + k]; VV[(seg * 4 + J) * 128 + k] = acc; } }
        VV[(seg * 4 + seg) * 128 + k] = acc;
    }
    __syncthreads();
}
__device__ __forceinline__ void hgE_seq(Ctx& C0_, int l, int u0, int nu, int ustride) { UNIT_PROLOG();
    const int tid = C.tid, lane = C.lane, w = C.wave, r = lane & 15, q = lane >> 4, I = w & 3, vh = w >> 2;
    LAS unsigned char* Qimg = C.lds; LAS unsigned char* Vimg = C.lds + 17408; LAS unsigned char* QLimg = C.lds + 34816; LAS unsigned char* Kimg = C.lds + 52224; LAS unsigned char* Simg = C.lds + 69632;
    LAS float* segtot = (LAS float*)(C.lds + 104448); LAS float* VV = (LAS float*)(C.lds + 106496); LAS float* xch = (LAS float*)(C.lds + 114688);
    const unsigned vimg = lds_addr(Vimg);
    const int lrow = 16 * I + r;
    TileRegs<64, 128> tQ, tV, tF0, tF1; TileRegs<128, 128> tS0, tS1;
#define HGE_ISSUE(uu) do { const int hd_ = (uu) & 3, c_ = ((uu) >> 2) & 127, b_ = (uu) >> 9; const size_t tk_ = (size_t)b_ * SEQ + c_ * 64; \
        tile_gload(tQ, (const bf16*)(C.ws + B_HQ) + tk_ * 512 + hd_ * 128, 512, tid); tile_gload(tV, (const bf16*)(C.ws + B_HI) + tk_ * 512 + hd_ * 128, 512, tid); \
        tile_gload(tF0, (const bf16*)(C.ws + B_HFR) + tk_ * 1024 + hd_ * 128, 1024, tid); tile_gload(tF1, (const bf16*)(C.ws + B_HFR) + tk_ * 1024 + 512 + hd_ * 128, 1024, tid); \
        tile_gload(tS0, (const bf16*)(C.ws + B_STH) + (size_t)(((b_ * 128 + c_) * 2 + 0) * 4 + hd_) * 16384, 128, tid); tile_gload(tS1, (const bf16*)(C.ws + B_STH) + (size_t)(((b_ * 128 + c_) * 2 + 1) * 4 + hd_) * 16384, 128, tid); } while (0)
    HGE_ISSUE(u0);
#pragma unroll 1
    for (int iu = 0; iu < nu; ++iu) {
        const int u = u0 + iu * ustride;
        const int hd = u & 3, c = (u >> 2) & 127, b = u >> 9;
        const size_t tok0 = (size_t)b * SEQ + c * 64; const size_t tok = tok0 + lrow;
#pragma unroll
        for (int i = 0; i < 2; ++i) { const u32x4 x = tQ.v[i];
            tQ.v[i].x = pk2(siluf_(bflo(x.x)), siluf_(bfhi(x.x))); tQ.v[i].y = pk2(siluf_(bflo(x.y)), siluf_(bfhi(x.y))); tQ.v[i].z = pk2(siluf_(bflo(x.z)), siluf_(bfhi(x.z))); tQ.v[i].w = pk2(siluf_(bflo(x.w)), siluf_(bfhi(x.w))); }
        tile_sstore<64, 128, 272>(tQ, Qimg, tid); tile_sstore<64, 128, 272>(tV, Vimg, tid);
        f32x4 o[4];
#pragma unroll
        for (int vt = 0; vt < 4; ++vt) o[vt] = (f32x4){0.f, 0.f, 0.f, 0.f};
        u32x2 gw4[4];
        { const bf16* HGp = (const bf16*)(C.ws + B_HG) + tok * 512 + hd * 128;
#pragma unroll
          for (int vt = 0; vt < 4; ++vt) gw4[vt] = *(const u32x2*)(HGp + 64 * vh + 16 * vt + 4 * q); }
#pragma unroll
        for (int dir = 0; dir < 2; ++dir) {
            tile_sstore<64, 128, 272>(dir ? tF1 : tF0, Kimg, tid); tile_sstore<128, 128, 272>(dir ? tS1 : tS0, Simg, tid);
            if (dir == 1 && iu + 1 < nu) HGE_ISSUE(u + ustride);
            hg_gates_e(C, l, hd, dir, Qimg, QLimg, Kimg, segtot, VV);
            bf16x8 qd[4];
#pragma unroll
            for (int ks = 0; ks < 4; ++ks) qd[ks] = frag_row(QLimg, 272, lrow, 32 * ks + 8 * q);
            f32x4 att[4];
#pragma unroll
            for (int J = 0; J < 4; ++J) {
                att[J] = (f32x4){0.f, 0.f, 0.f, 0.f};
                const bool inr = dir ? (J >= I) : (J <= I);
                if (inr) {
#pragma unroll
                    for (int ks = 0; ks < 4; ++ks) {
                        const int k0 = 32 * ks + 8 * q;
                        bf16x8 qf = qd[ks];
                        if (J != I) { float qv[8]; unpack8(qd[ks], qv);
                            const f32x4 v0 = *(const LAS f32x4*)(VV + (I * 4 + J) * 128 + k0), v1 = *(const LAS f32x4*)(VV + (I * 4 + J) * 128 + k0 + 4);
                            qv[0] *= v0.x; qv[1] *= v0.y; qv[2] *= v0.z; qv[3] *= v0.w; qv[4] *= v1.x; qv[5] *= v1.y; qv[6] *= v1.z; qv[7] *= v1.w; qf = pack8(qv); }
                        att[J] = MFMA16(frag_row(Kimg, 272, 16 * J + r, k0), qf, att[J]);
                    }
                    if (J == I) {
#pragma unroll
                        for (int i = 0; i < 4; ++i) { const bool keep = dir ? (4 * q + i >= r) : (4 * q + i <= r); att[J][i] = keep ? att[J][i] : 0.f; }
                    }
                }
            }
#pragma unroll
            for (int k2 = 0; k2 < 2; ++k2) {
                float m[8] = {att[2 * k2][0], att[2 * k2][1], att[2 * k2][2], att[2 * k2][3], att[2 * k2 + 1][0], att[2 * k2 + 1][1], att[2 * k2 + 1][2], att[2 * k2 + 1][3]};
                const bf16x8 mf = pack8(m);
                bf16x8 vf4[4]; frag_tr4<true, 272>(vimg, 32 * k2, 64 * vh, r, q, vf4);
#pragma unroll
                for (int vt = 0; vt < 4; ++vt) o[vt] = MFMA16(vf4[vt], mf, o[vt]);
            }
#pragma unroll
            for (int ks = 0; ks < 4; ++ks) {
                const int k0 = 32 * ks + 8 * q;
                float qv[8]; unpack8(qd[ks], qv);
                const f32x4 v0 = *(const LAS f32x4*)(VV + (I * 4 + I) * 128 + k0), v1 = *(const LAS f32x4*)(VV + (I * 4 + I) * 128 + k0 + 4);
                qv[0] *= v0.x; qv[1] *= v0.y; qv[2] *= v0.z; qv[3] *= v0.w; qv[4] *= v1.x; qv[5] *= v1.y; qv[6] *= v1.z; qv[7] *= v1.w;
                const bf16x8 qh = pack8(qv);
#pragma unroll
                for (int vt = 0; vt < 4; ++vt) o[vt] = MFMA16(frag_row(Simg, 272, 64 * vh + 16 * vt + r, k0), qh, o[vt]);
            }
            __syncthreads();
        }
        float ss = 0.f;
#pragma unroll
        for (int vt = 0; vt < 4; ++vt) ss += (o[vt][0] * o[vt][0] + o[vt][1] * o[vt][1]) + (o[vt][2] * o[vt][2] + o[vt][3] * o[vt][3]);
        ss += __shfl_xor(ss, 16); ss += __shfl_xor(ss, 32);
        if (q == 0) xch[vh * 64 + lrow] = ss;
        __syncthreads();
        const float rs = 1.0f / sqrtf((xch[lrow] + xch[64 + lrow]) * (1.f / 128.f) + RMS_EPS);
        const LAS float* nw = (const LAS float*)(C.lds + PAR_OFF) + 1664 + hd * 128; bf16* MIX = (bf16*)(C.ws + B_MIX) + tok * 2048 + 1024 + hd * 128;
#pragma unroll
        for (int vt = 0; vt < 4; ++vt) {
            const int v0 = 64 * vh + 16 * vt + 4 * q; const f32x4 nv = *(const LAS f32x4*)(nw + v0); const u32x2 gw = gw4[vt];
            f32x4 v; v[0] = o[vt][0] * rs * nv[0] * siluf_(bflo(gw.x)); v[1] = o[vt][1] * rs * nv[1] * siluf_(bfhi(gw.x)); v[2] = o[vt][2] * rs * nv[2] * siluf_(bflo(gw.y)); v[3] = o[vt][3] * rs * nv[3] * siluf_(bfhi(gw.y));
            *(u32x2*)(MIX + v0) = pack4(v);
        }
        __syncthreads();
    }
#undef HGE_ISSUE
}
__device__ __forceinline__ void mixE_phase(Ctx& C, int l) {
    int f, n;
    const int rot = (C.blk >> 3) % 3;
    mix_params(C, l, true);
#pragma unroll 1
    for (int k3 = 0; k3 < 3; ++k3) {
        int ty = k3 + rot; if (ty >= 3) ty -= 3;
        if (ty == 0) { if (FAST_SSD) { deal_range(C.blk, C.G, 0, 256, f, n); for (int i = 0; i < n; ++i) ssdE_unit(C, l, f + i * C.G); } }
        else if (ty == 1) { if (FAST_ML) { deal_range(C.blk, C.G, 256, 768, f, n); for (int i = 0; i < n; ++i) mlE_unit(C, l, f + i * C.G); } }
        else { if (FAST_HG) { deal_range(C.blk, C.G, 768, 1792, f, n); if (n) hgE_seq(C, l, f, n, C.G); } }
    }
}

constexpr int PH_PER_LAYER = 11, NPHASES = 1 + DEPTH * PH_PER_LAYER;
__global__ void __launch_bounds__(NTHR, 2) fwd_kernel(Args args) {
    extern __shared__ __attribute__((aligned(16))) unsigned char lds_raw[];
    Ctx C;
    C.lds = (LAS unsigned char*)lds_raw; C.misc = (volatile LAS unsigned*)(C.lds + MISC_OFF);
    C.ws = args.ws; C.in.lds = C.lds; C.out = args.out;
    C.tid = threadIdx.x; C.lane = C.tid & 63; C.wave = __builtin_amdgcn_readfirstlane(C.tid >> 6); C.G = gridDim.x; C.blk = blockIdx.x;
    if (C.tid < 64) C.misc[C.tid] = 0u;
    if (C.tid < 31) { const unsigned long long p = C.tid < 29 ? (unsigned long long)args.in[C.tid] : (C.tid == 29 ? (unsigned long long)args.out : (unsigned long long)args.ws);
        *(LAS u32x2*)(C.lds + PTAB_OFF + 8 * C.tid) = (u32x2){(unsigned)p, (unsigned)(p >> 32)}; }
    __syncthreads();
    const int lo = args.ph_lo, hi = args.ph_hi;
#if MK_ONE_LAUNCH
    XcdBarrier bar = xcd_barrier_post((unsigned*)(C.ws + WS_CTL) + CW_BAR, C.misc + 32);
#define GRID_BAR() do { XcdBarrier b2_ = bar; b2_.bar = (unsigned*)C.in[30] + CW_BAR; asm volatile("" : "+s"(b2_.x)); xcd_barrier(b2_); } while (0)
#else
#define GRID_BAR() do { } while (0)
#endif
#define IN(k) (lo <= (k) && (k) < hi)
#if PROFILE_A || PROFILE_B
#define STAMP(i) do { int l2_; asm volatile("v_mbcnt_lo_u32_b32 %0, -1, 0\n\tv_mbcnt_hi_u32_b32 %0, -1, %0" : "=v"(l2_)); if (l2_ == 0 && C.wave == 0) ((volatile LAS unsigned long long*)(C.lds + TS_OFF))[i] = __builtin_amdgcn_s_memrealtime(); } while (0)
#define SEAM(k) do { GRID_BAR(); STAMP((k) + 1); } while (0)
#else
#define STAMP(i) do { } while (0)
#define SEAM(k) do { if (IN((k) + 1)) GRID_BAR(); } while (0)
#endif
#define LAUNDER() do { __syncthreads(); C.out = (float*)C.in[29]; C.ws = (unsigned char*)C.in[30]; int ln_; asm volatile("v_mbcnt_lo_u32_b32 %0, -1, 0\n\tv_mbcnt_hi_u32_b32 %0, -1, %0" : "=v"(ln_)); C.lane = ln_; C.tid = C.wave * 64 + ln_; asm volatile("" : "+s"(C.blk), "+s"(C.G)); } while (0)

    STAMP(0);
    if (IN(0)) { LAUNDER();
        ln_phase<0, 1>(C, C.in[0], C.in[1], C.in[2], nullptr, 0);
        __syncthreads();
        wconv_layer(C, 0);
        SEAM(0);
    }
    for (int l = 0; l < DEPTH; ++l) {
        const int pb = 1 + l * PH_PER_LAYER; const bool moe = (l & 1) != 0; const int lm = l >> 1;
        const int dff = moe ? DFF_E : DFF_D;
        if (IN(pb + 0)) { LAUNDER();
            pg8::GOrder S; S.init(C.ws + WS_HBF, C.ws + WS_WIN, D, T / 256, NMAIN / 256, C.G, C.blk, 0, nullptr);
            pg8::EpiProj E{C.ws};
            pg8::gemm_phase<pg8::EpiProj, pg8::GOrder>(C.lds, D, D, S, E, C.tid);
            SEAM(pb + 0);
        }
        if (IN(pb + 1)) { LAUNDER(); conv_phase(C, l); SEAM(pb + 1); }
        if (IN(pb + 2)) { LAUNDER(); if (!(FAST_SSD && FAST_HG && FAST_ML)) naive_mixers(C, l); __syncthreads(); mixC_phase(C, l); SEAM(pb + 2); }
        if (IN(pb + 3)) { LAUNDER(); scan_phase(C); SEAM(pb + 3); }
        if (IN(pb + 4)) { LAUNDER(); if (!(FAST_SSD && FAST_HG && FAST_ML)) naive_combine(C, l); __syncthreads(); mixE_phase(C, l); SEAM(pb + 4); }
        if (IN(pb + 5)) { LAUNDER();
            pg8::GOrder S; S.init(C.ws + B_MIX, C.ws + WS_WOUT, DMIX, T / 256, D / 256, C.G, C.blk, 0, nullptr);
            pg8::EpiBf16Res E{(bf16*)(C.ws + B_Y), (const bf16*)(C.ws + WS_HBF), D};
            pg8::gemm_phase<pg8::EpiBf16Res, pg8::GOrder>(C.lds, DMIX, DMIX, S, E, C.tid);
            SEAM(pb + 5);
        }
        if (IN(pb + 6)) { LAUNDER();
            if (moe) ln_phase<1, 2>(C, nullptr, C.in[18] + l * D, C.in[19] + l * D, nullptr, l);
            else ln_phase<1, 0>(C, nullptr, C.in[18] + l * D, C.in[19] + l * D, nullptr, l);
            SEAM(pb + 6);
        }
        if (IN(pb + 7) && (moe || PROFILE_A || PROFILE_B)) { LAUNDER(); if (moe) moe_dispatch(C, lm); SEAM(pb + 7); }
        if (IN(pb + 8)) { LAUNDER();
            __syncthreads();
            const int nblk = moe_cum_table(C, lm, moe);
            pg8::GOrder S; S.init(moe ? C.ws + B_XS : C.ws + WS_HBF, C.ws + WS_W13, D, nblk, 2 * dff / 256, C.G, C.blk, (size_t)2 * dff * D * 2, (const LAS int*)(C.lds + MISC_OFF));
            pg8::EpiSwiglu E{(bf16*)(C.ws + B_HID), dff};
            pg8::gemm_phase<pg8::EpiSwiglu, pg8::GOrder>(C.lds, D, D, S, E, C.tid);
            SEAM(pb + 8);
        }
        if (IN(pb + 9)) { LAUNDER();
            __syncthreads();
            const int nblk = moe_cum_table(C, lm, moe);
            const int nfull = nblk < 128 ? nblk : 128;
            pg8::GOrder S; S.init(C.ws + B_HID, C.ws + WS_W2, dff, nfull, D / 256, C.G, C.blk, (size_t)D * dff * 2, (const LAS int*)(C.lds + MISC_OFF));
            pg8::EpiBf16Res E{moe ? (bf16*)(C.ws + B_YE) : (bf16*)(C.ws + B_Y), moe ? nullptr : (const bf16*)(C.ws + WS_HBF), D};
            pg8::gemm_phase<pg8::EpiBf16Res, pg8::GOrder>(C.lds, dff, dff, S, E, C.tid);
            if (nblk > 128) {
                __syncthreads();
                pg8::TailOrder S2; S2.init(C.ws + B_HID, C.ws + WS_W2, dff, nblk - 128, C.G, C.blk, (size_t)D * dff * 2, (const LAS int*)(C.lds + MISC_OFF));
                pg8::EpiF32 E2{(float*)(C.ws + B_PART), D};
                pg8::gemm_phase<pg8::EpiF32, pg8::TailOrder>(C.lds, 512, dff, S2, E2, C.tid);
            }
            SEAM(pb + 9);
        }
        if (IN(pb + 10)) { LAUNDER();
            float* dst = (l == DEPTH - 1) ? C.out : nullptr;
            const float* g = C.in[20] + l * D; const float* b = C.in[21] + l * D;
            if (l == DEPTH - 1) { if (moe) ln_phase<3, 0>(C, nullptr, g, b, dst, l); else ln_phase<2, 0>(C, nullptr, g, b, dst, l); }
            else { if (moe) ln_phase<3, 1>(C, nullptr, g, b, dst, l + 1); else ln_phase<2, 1>(C, nullptr, g, b, dst, l + 1);
                __syncthreads(); wconv_layer(C, l + 1); }
            SEAM(pb + 10);
        }
    }
#if PROFILE_A || PROFILE_B
    {
        int l3_; asm volatile("v_mbcnt_lo_u32_b32 %0, -1, 0\n\tv_mbcnt_hi_u32_b32 %0, -1, %0" : "=v"(l3_));
        if (l3_ == 0 && C.wave == 0 && __builtin_amdgcn_readfirstlane(C.blk) == 0) {
            volatile LAS unsigned long long* ts = (volatile LAS unsigned long long*)(C.lds + TS_OFF);
            unsigned long long dsum = 0;
            for (int p = 0; p < NPHASES; ++p) { const int cls = (p == 0) ? 0 : 1 + (p - 1) % PH_PER_LAYER; if ((PROFILE_A >> cls) & 1) dsum += ts[p + 1] - ts[p]; }
            const unsigned long long t0 = __builtin_amdgcn_s_memrealtime();
            while (__builtin_amdgcn_s_memrealtime() - t0 < dsum) __builtin_amdgcn_s_sleep(8);
        }
    }
#endif
#undef IN
#undef SEAM
}

extern "C" void kernel_launch(void* const* d_in, const int* in_sizes, int n_in, void* d_out, int out_size, void* d_ws, size_t ws_size, hipStream_t stream) {
    static int grid = 0;
    if (grid == 0) {
        if (n_in != 29 || out_size != T * D || ws_size < WS_END) { fprintf(stderr, "kernel_launch: unexpected shapes (n_in %d out %d ws %zu need %zu)\n", n_in, out_size, ws_size, (size_t)WS_END); grid = -1; return; }
        int dev = 0, cus = 0, per_cu = 0;
        if (hipGetDevice(&dev) != hipSuccess || hipDeviceGetAttribute(&cus, hipDeviceAttributeMultiprocessorCount, dev) != hipSuccess) { grid = -1; return; }
        if (hipFuncSetAttribute((const void*)fwd_kernel, hipFuncAttributeMaxDynamicSharedMemorySize, LDS_BYTES) != hipSuccess) { grid = -1; return; }
        if (hipOccupancyMaxActiveBlocksPerMultiprocessor(&per_cu, (const void*)fwd_kernel, NTHR, LDS_BYTES) != hipSuccess || per_cu < 1) fprintf(stderr, "kernel_launch: occupancy query says %d\n", per_cu);
        (void)hipGetLastError();
        grid = cus;
    }
    if (grid < 0) return;
    (void)hipMemsetAsync((char*)d_ws + WS_CTL, 0, CTL_ZERO_BYTES, stream);
    Args a{};
    for (int i = 0; i < 29; ++i) a.in[i] = (const float*)d_in[i];
    a.out = (float*)d_out; a.ws = (unsigned char*)d_ws;
#if MK_ONE_LAUNCH
    a.ph_lo = 0; a.ph_hi = NPHASES;
    hipLaunchKernelGGL(fwd_kernel, dim3(grid), dim3(NTHR), LDS_BYTES, stream, a);
#else
    for (int p = 0; p < NPHASES; ++p) {
        if (p >= 1) { const int k = (p - 1) % PH_PER_LAYER, l = (p - 1) / PH_PER_LAYER; if (k == 7 && !(l & 1)) continue; }
        a.ph_lo = p; a.ph_hi = p + 1;
        hipLaunchKernelGGL(fwd_kernel, dim3(grid), dim3(NTHR), LDS_BYTES, stream, a);
    }
#endif
}
```
